# Optimizing an MI355X kernel written in HIP

```python
import math
import jax, jax.numpy as jnp
from jax import lax
import numpy as np

D_MODEL = 1024
BATCH = 4
SEQ = 8192
DEPTH = 4
DEC_BATCH = 32
DEC_SEQ = 16
PAST_LEN = 4096

CHUNK = 64
N_MIXERS = 4
N_LAYERS_A = len(range(0, DEPTH, N_MIXERS))
N_LAYERS_B = len(range(1, DEPTH, N_MIXERS))
N_LAYERS_C = len(range(2, DEPTH, N_MIXERS))
N_LAYERS_D = len(range(3, DEPTH, N_MIXERS))
GMLP_CHUNK = 128
GMLP_HALF = 3 * D_MODEL
GMLP_GROUPS = 8
GMLP_GROUP_W = GMLP_HALF // GMLP_GROUPS
DIFF_HEADS = 8
DIFF_DK = D_MODEL // (2 * DIFF_HEADS)
DIFF_DV = 2 * DIFF_DK
Q_BLOCK = 128
RET_HEADS = 4
RET_DK = D_MODEL // RET_HEADS
RET_DV = 2 * D_MODEL // RET_HEADS
HG_EXPAND = 128
HG_HEADS = D_MODEL // HG_EXPAND
HG_DK = HG_EXPAND
HG_DV = D_MODEL // HG_HEADS
FFN_HIDDEN = ((8 * D_MODEL + 3 * 256 - 1) // (3 * 256)) * 256
EPS = 1e-6
NEG_INF = -1e30
F32 = jnp.float32

kernel_name = 'hybrid_streaming_encoder_step'


def rmsnorm(x, g):
    xf = x.astype(F32)
    y = xf * lax.rsqrt(jnp.mean(xf * xf, axis=-1, keepdims=True) + EPS)
    return (y * g.astype(F32)).astype(x.dtype)


def rms_unit(x):
    xf = x.astype(F32)
    return xf * lax.rsqrt(jnp.mean(xf * xf, axis=-1, keepdims=True) + EPS)


def layernorm(x, g, b):
    xf = x.astype(F32)
    mu = jnp.mean(xf, axis=-1, keepdims=True)
    xc = xf - mu
    var = jnp.mean(xc * xc, axis=-1, keepdims=True)
    return (xc * lax.rsqrt(var + EPS) * g.astype(F32) + b.astype(F32)).astype(x.dtype)


def ada_mod(c, w, b):
    m = jax.nn.silu(c) @ w + b
    return jnp.split(m[:, None, :], 6, axis=-1)


def modulate(x, g, shift, scale):
    return rmsnorm(x, g) * (1.0 + scale) + shift


def swiglu(h, w_in, w_out):
    gate, up = jnp.split(h @ w_in, 2, axis=-1)
    return (jax.nn.silu(gate) * up) @ w_out


def gmlp_mix(h, w_in, ln_g, ln_b, w_s, b_s, w_out):
    B_, S_, _ = h.shape
    z = jax.nn.gelu(h @ w_in, approximate=False)
    u, v = jnp.split(z, 2, axis=-1)
    v = layernorm(v, ln_g, ln_b)
    T = min(S_, GMLP_CHUNK)
    vb = v.reshape(B_, S_ // T, T, GMLP_GROUPS, GMLP_GROUP_W)
    w = jnp.tril(w_s[:, :T, :T])
    mixed = jnp.einsum('gts,bnsgc->bntgc', w, vb) + b_s[:, :T].T[None, None, :, :, None]
    out = u * mixed.reshape(B_, S_, GMLP_HALF)
    return out @ w_out, v


def diff_project(h, w_in):
    B_, S_, _ = h.shape
    q, k, v = jnp.split(h @ w_in, [D_MODEL, 2 * D_MODEL], axis=-1)
    return (q.reshape(B_, S_, 2 * DIFF_HEADS, DIFF_DK),
            k.reshape(B_, S_, 2 * DIFF_HEADS, DIFF_DK),
            v.reshape(B_, S_, DIFF_HEADS, DIFF_DV))


def diff_lambda_value(lam, lam_init):
    lf = lam.astype(F32)
    return jnp.exp(jnp.sum(lf[0] * lf[1])) - jnp.exp(jnp.sum(lf[2] * lf[3])) + lam_init


def diff_weights(s, lam):
    p = jax.nn.softmax(s, axis=-1)
    B_, _, T, K = p.shape
    p = p.reshape(B_, DIFF_HEADS, 2, T, K)
    return p[:, :, 0] - lam * p[:, :, 1]


def diff_out(o, subln_g, lam_init, w_out):
    o = rmsnorm(o, subln_g) * (1.0 - lam_init)
    return o.reshape(o.shape[0], o.shape[1], DIFF_HEADS * DIFF_DV) @ w_out


def diff_attn_prompt(h, w_in, lam_p, subln_g, w_out, lam_init):
    B_, S_, _ = h.shape
    q, k, v = diff_project(h, w_in)
    lam = diff_lambda_value(lam_p, lam_init)
    scale = DIFF_DK ** -0.5
    n_blk = S_ // Q_BLOCK
    key_chunk = jnp.arange(S_) // CHUNK
    q_blocks = q.reshape(B_, n_blk, Q_BLOCK, 2 * DIFF_HEADS, DIFF_DK).swapaxes(0, 1)

    def one_block(args):
        q_blk, blk = args
        q_chunk = (blk * Q_BLOCK + jnp.arange(Q_BLOCK)) // CHUNK
        s = jnp.einsum('bthd,bshd->bhts', q_blk, k).astype(F32) * scale
        s = jnp.where(key_chunk[None, :] <= q_chunk[:, None], s, NEG_INF)
        a = diff_weights(s, lam).astype(v.dtype)
        return jnp.einsum('bhts,bshv->bthv', a, v)

    o = lax.map(one_block, (q_blocks, jnp.arange(n_blk)))
    o = o.swapaxes(0, 1).reshape(B_, S_, DIFF_HEADS, DIFF_DV)
    return diff_out(o, subln_g, lam_init, w_out), k, v


def diff_attn_sample(h, cache_k, cache_v, w_in, lam_p, subln_g, w_out, lam_init):
    B_, L, _ = h.shape
    P = cache_k.shape[1]
    q, k, v = diff_project(h, w_in)
    lam = diff_lambda_value(lam_p, lam_init)
    scale = DIFF_DK ** -0.5
    s_past = jnp.einsum('bthd,bshd->bhts', q, cache_k)
    s_new = jnp.einsum('bthd,bshd->bhts', q, k)
    s = jnp.concatenate([s_past, s_new], axis=-1).astype(F32) * scale
    q_chunk = (P + jnp.arange(L)) // CHUNK
    key_chunk = jnp.arange(P + L) // CHUNK
    s = jnp.where(key_chunk[None, :] <= q_chunk[:, None], s, NEG_INF)
    a = diff_weights(s, lam).astype(v.dtype)
    o = (jnp.einsum('bhts,bshv->bthv', a[..., :P], cache_v)
         + jnp.einsum('bhts,bshv->bthv', a[..., P:], v))
    return diff_out(o, subln_g, lam_init, w_out), k, v


def ret_log_gamma():
    return jnp.log(1.0 - 2.0 ** (-5.0 - jnp.arange(RET_HEADS, dtype=F32)))


def rotate_every_two(x):
    x1 = x[..., ::2]
    x2 = x[..., 1::2]
    return jnp.stack([-x2, x1], axis=-1).reshape(x.shape)


def xpos_rotate(x, pos):
    inv = 1.0 / (10000.0 ** jnp.linspace(0.0, 1.0, RET_DK // 2, dtype=F32))
    ang = pos.astype(F32)[:, None] * jnp.repeat(inv, 2)[None, :]
    sin = jnp.sin(ang)[None, :, None, :]
    cos = jnp.cos(ang)[None, :, None, :]
    xf = x.astype(F32)
    return xf * cos + rotate_every_two(xf) * sin


def retention_project(h, w_in, pos):
    B_, S_, _ = h.shape
    q, k, v, g = jnp.split(h @ w_in, [D_MODEL, 2 * D_MODEL, 4 * D_MODEL], axis=-1)
    q = xpos_rotate(q.reshape(B_, S_, RET_HEADS, RET_DK), pos)
    k = xpos_rotate(k.reshape(B_, S_, RET_HEADS, RET_DK), pos) * (RET_DK ** -0.5)
    v = v.reshape(B_, S_, RET_HEADS, RET_DV).astype(F32)
    return q, k, v, g


def retention_block(q, k, v, state, log_gamma):
    L = q.shape[1]
    t = jnp.arange(L, dtype=F32)
    diff = t[:, None] - t[None, :]
    decay = jnp.where(diff >= 0, jnp.exp(log_gamma[:, None, None] * jnp.maximum(diff, 0.0)), 0.0)
    scores = jnp.einsum('bthd,bshd->bhts', q, k) * decay[None]
    o = jnp.einsum('bhts,bshv->bthv', scores, v)
    cross = jnp.exp(log_gamma[None, :] * (t[:, None] + 1.0))
    o = o + jnp.einsum('bthd,bhdv->bthv', q, state) * cross[None, :, :, None]
    k_dec = k * jnp.exp(log_gamma[None, :] * (L - 1.0 - t[:, None]))[None, :, :, None]
    new_state = (jnp.exp(log_gamma * L)[None, :, None, None] * state
                 + jnp.einsum('bshd,bshv->bhdv', k_dec, v))
    return o, new_state


def retention_output(o, g, w_out):
    B_, S_ = o.shape[:2]
    o = rms_unit(o).reshape(B_, S_, 2 * D_MODEL) * jax.nn.silu(g.astype(F32))
    return o.astype(g.dtype) @ w_out


def retention_prompt(h, w_in, w_out):
    B_, S_, _ = h.shape
    q, k, v, g = retention_project(h, w_in, jnp.arange(S_))
    lg = ret_log_gamma()
    n = S_ // CHUNK

    def to_blocks(a):
        return a.reshape(B_, n, CHUNK, *a.shape[2:]).swapaxes(0, 1)

    def step(state, blk):
        o, state = retention_block(blk[0], blk[1], blk[2], state, lg)
        return state, o

    state0 = jnp.zeros((B_, RET_HEADS, RET_DK, RET_DV), F32)
    state, o = lax.scan(step, state0, (to_blocks(q), to_blocks(k), to_blocks(v)))
    o = o.swapaxes(0, 1).reshape(B_, S_, RET_HEADS, RET_DV)
    return retention_output(o, g, w_out), state.astype(h.dtype)


def retention_sample(h, state, w_in, w_out):
    B_, L, _ = h.shape
    q, k, v, g = retention_project(h, w_in, PAST_LEN + jnp.arange(L))
    o, new_state = retention_block(q, k, v, state.astype(F32), ret_log_gamma())
    return retention_output(o, g, w_out), new_state.astype(state.dtype)


def hgrn_project(h, w_in, lb):
    B_, S_, _ = h.shape
    q, f, i, g = jnp.split(h @ w_in, 4, axis=-1)
    lbf = lb.astype(F32)
    logf = jnp.logaddexp(jnp.log(lbf), jnp.log1p(-lbf) + jax.nn.log_sigmoid(f.astype(F32)))
    k = -jnp.expm1(logf)
    shp = (B_, S_, HG_HEADS, HG_DK)
    return (jax.nn.silu(q.astype(F32)).reshape(shp), k.reshape(shp),
            i.astype(F32).reshape(B_, S_, HG_HEADS, HG_DV), logf.reshape(shp), g)


def gla_block(q, k, v, logf, state):
    L = q.shape[1]
    b = jnp.cumsum(logf, axis=1)
    q_dec = q * jnp.exp(b)
    k_inv = k * jnp.exp(-b)
    causal = jnp.arange(L)[:, None] >= jnp.arange(L)[None, :]
    scores = jnp.where(causal, jnp.einsum('bthd,bshd->bhts', q_dec, k_inv), 0.0)
    o = jnp.einsum('bhts,bshv->bthv', scores, v) + jnp.einsum('bthd,bhdv->bthv', q_dec, state)
    b_last = b[:, -1]
    k_end = k * jnp.exp(b_last[:, None] - b)
    new_state = jnp.exp(b_last)[..., None] * state + jnp.einsum('bshd,bshv->bhdv', k_end, v)
    return o, new_state


def hgrn_output(o, g, norm_g, w_out):
    B_, S_ = o.shape[:2]
    o = rmsnorm(o, norm_g.reshape(HG_HEADS, HG_DV))
    o = o.reshape(B_, S_, D_MODEL) * jax.nn.silu(g.astype(F32))
    return o.astype(g.dtype) @ w_out


def hgrn_prompt(h, w_in, norm_g, w_out, lb):
    B_, S_, _ = h.shape
    q, k, v, logf, g = hgrn_project(h, w_in, lb)
    n = S_ // CHUNK

    def to_blocks(a):
        return a.reshape(B_, n, CHUNK, *a.shape[2:]).swapaxes(0, 1)

    def step(state, blk):
        o, state = gla_block(blk[0], blk[1], blk[2], blk[3], state)
        return state, o

    state0 = jnp.zeros((B_, HG_HEADS, HG_DK, HG_DV), F32)
    state, o = lax.scan(step, state0, (to_blocks(q), to_blocks(k), to_blocks(v), to_blocks(logf)))
    o = o.swapaxes(0, 1).reshape(B_, S_, HG_HEADS, HG_DV)
    return hgrn_output(o, g, norm_g, w_out), state.astype(h.dtype)


def hgrn_sample(h, state, w_in, norm_g, w_out, lb):
    q, k, v, logf, g = hgrn_project(h, w_in, lb)
    o, new_state = gla_block(q, k, v, logf, state.astype(F32))
    return hgrn_output(o, g, norm_g, w_out), new_state.astype(state.dtype)


def setup_inputs(seed: int = 0) -> dict:
    key = jax.random.key(seed)
    keys = iter(jax.random.split(key, 32))

    def nrm(shape, scale=1.0):
        return jax.random.normal(next(keys), shape, F32) * scale

    D = D_MODEL
    F = FFN_HIDDEN
    return {
        'x_prompt': nrm((BATCH, SEQ, D)),
        'x_sample': nrm((DEC_BATCH, DEC_SEQ, D)),
        'cache_k_diff': nrm((N_LAYERS_B, DEC_BATCH, PAST_LEN, 2 * DIFF_HEADS, DIFF_DK)),
        'cache_v_diff': nrm((N_LAYERS_B, DEC_BATCH, PAST_LEN, DIFF_HEADS, DIFF_DV)),
        'state_retention': nrm((N_LAYERS_C, DEC_BATCH, RET_HEADS, RET_DK, RET_DV), 0.5),
        'state_hgrn': nrm((N_LAYERS_D, DEC_BATCH, HG_HEADS, HG_DK, HG_DV), 0.3),
        'c_prompt': nrm((BATCH, D)),
        'c_sample': nrm((DEC_BATCH, D)),
        'w_ada': nrm((DEPTH, D, 6 * D), 0.5 * D ** -0.5),
        'b_ada': nrm((DEPTH, 6 * D), 0.01),
        'norm_gains': 1.0 + nrm((DEPTH, 4, D), 0.05),
        'gmlp_w_in': nrm((N_LAYERS_A, D, 2 * GMLP_HALF), D ** -0.5),
        'gmlp_ln_g': 1.0 + nrm((N_LAYERS_A, GMLP_HALF), 0.05),
        'gmlp_ln_b': nrm((N_LAYERS_A, GMLP_HALF), 0.02),
        'gmlp_w_s': nrm((N_LAYERS_A, GMLP_GROUPS, GMLP_CHUNK, GMLP_CHUNK), GMLP_CHUNK ** -0.5),
        'gmlp_b_s': 1.0 + nrm((N_LAYERS_A, GMLP_GROUPS, GMLP_CHUNK), 0.05),
        'gmlp_w_out': nrm((N_LAYERS_A, GMLP_HALF, D), GMLP_HALF ** -0.5),
        'diff_w_in': nrm((N_LAYERS_B, D, 3 * D), D ** -0.5),
        'diff_lambda': nrm((N_LAYERS_B, 4, DIFF_DK), 0.1),
        'diff_subln': 1.0 + nrm((N_LAYERS_B, DIFF_DV), 0.05),
        'diff_w_out': nrm((N_LAYERS_B, D, D), D ** -0.5),
        'ret_w_in': nrm((N_LAYERS_C, D, 6 * D), D ** -0.5),
        'ret_w_out': nrm((N_LAYERS_C, 2 * D, D), (2 * D) ** -0.5),
        'hgrn_w_in': nrm((N_LAYERS_D, D, 4 * D), D ** -0.5),
        'hgrn_norm': 1.0 + nrm((N_LAYERS_D, D), 0.05),
        'hgrn_w_out': nrm((N_LAYERS_D, D, D), D ** -0.5),
        'hgrn_lower_bounds': nrm((DEPTH, D), 0.1),
        'ffn_w_in': nrm((DEPTH, D, 2 * F), D ** -0.5),
        'ffn_w_out': nrm((DEPTH, F, D), F ** -0.5),
    }


def reference(x_prompt, x_sample, cache_k_diff, cache_v_diff, state_retention, state_hgrn,
              c_prompt, c_sample, w_ada, b_ada, norm_gains,
              gmlp_w_in, gmlp_ln_g, gmlp_ln_b, gmlp_w_s, gmlp_b_s, gmlp_w_out,
              diff_w_in, diff_lambda, diff_subln, diff_w_out,
              ret_w_in, ret_w_out,
              hgrn_w_in, hgrn_norm, hgrn_w_out, hgrn_lower_bounds,
              ffn_w_in, ffn_w_out):
    lb_p = jax.nn.softmax(hgrn_lower_bounds.astype(F32), axis=0)
    lower = jnp.cumsum(lb_p, axis=0) - lb_p[0]

    yp, ys = x_prompt, x_sample
    gmlp_v_s = []
    kd_p, vd_p, kd_s, vd_s = [], [], [], []
    ret_p, ret_s, hg_p, hg_s = [], [], [], []
    for i in range(DEPTH):
        kind, j = i % N_MIXERS, i // N_MIXERS
        mp = ada_mod(c_prompt, w_ada[i], b_ada[i])
        ms = ada_mod(c_sample, w_ada[i], b_ada[i])
        hp = modulate(yp, norm_gains[i, 0], mp[0], mp[1])
        hs = modulate(ys, norm_gains[i, 0], ms[0], ms[1])
        if kind == 0:
            op, _ = gmlp_mix(hp, gmlp_w_in[j], gmlp_ln_g[j], gmlp_ln_b[j], gmlp_w_s[j], gmlp_b_s[j], gmlp_w_out[j])
            os_, v_rows = gmlp_mix(hs, gmlp_w_in[j], gmlp_ln_g[j], gmlp_ln_b[j], gmlp_w_s[j], gmlp_b_s[j], gmlp_w_out[j])
            gmlp_v_s.append(v_rows)
        elif kind == 1:
            lam_init = 0.8 - 0.6 * math.exp(-0.3 * i)
            op, k_new, v_new = diff_attn_prompt(hp, diff_w_in[j], diff_lambda[j], diff_subln[j], diff_w_out[j], lam_init)
            kd_p.append(k_new)
            vd_p.append(v_new)
            os_, k_new, v_new = diff_attn_sample(hs, cache_k_diff[j], cache_v_diff[j], diff_w_in[j], diff_lambda[j],
                                                 diff_subln[j], diff_w_out[j], lam_init)
            kd_s.append(k_new)
            vd_s.append(v_new)
        elif kind == 2:
            op, st = retention_prompt(hp, ret_w_in[j], ret_w_out[j])
            ret_p.append(st)
            os_, st = retention_sample(hs, state_retention[j], ret_w_in[j], ret_w_out[j])
            ret_s.append(st)
        else:
            op, st = hgrn_prompt(hp, hgrn_w_in[j], hgrn_norm[j], hgrn_w_out[j], lower[i])
            hg_p.append(st)
            os_, st = hgrn_sample(hs, state_hgrn[j], hgrn_w_in[j], hgrn_norm[j], hgrn_w_out[j], lower[i])
            hg_s.append(st)
        yp = yp + mp[2] * rmsnorm(op, norm_gains[i, 1])
        ys = ys + ms[2] * rmsnorm(os_, norm_gains[i, 1])
        hp = modulate(yp, norm_gains[i, 2], mp[3], mp[4])
        hs = modulate(ys, norm_gains[i, 2], ms[3], ms[4])
        yp = yp + mp[5] * rmsnorm(swiglu(hp, ffn_w_in[i], ffn_w_out[i]), norm_gains[i, 3])
        ys = ys + ms[5] * rmsnorm(swiglu(hs, ffn_w_in[i], ffn_w_out[i]), norm_gains[i, 3])

    return (yp, ys, jnp.stack(gmlp_v_s), jnp.stack(kd_p), jnp.stack(vd_p), jnp.stack(kd_s), jnp.stack(vd_s),
            jnp.stack(ret_p), jnp.stack(ret_s), jnp.stack(hg_p), jnp.stack(hg_s))
```

```cpp
#include <hip/hip_runtime.h>
#include <cstdio>
#include <cstdint>
__device__ __forceinline__ int fresh_tid() { int t = threadIdx.x; asm volatile("" : "+v"(t)); return t; }
namespace pg8 {
#define PG8_LAS __attribute__((address_space(3)))
typedef unsigned short bf16_t;
typedef short bf16x8 __attribute__((ext_vector_type(8)));
typedef float f32x4 __attribute__((ext_vector_type(4)));
typedef unsigned u32x4 __attribute__((ext_vector_type(4)));
constexpr int BM = 256, BK = 64, HALF = 128, HTB = HALF * BK * 2  , STAGE_BYTES = 8 * HTB, NXCD = 8, WGM = 8;

__host__ __device__ __forceinline__ int lds_byte(int r, int c) { const int st = (r >> 4) * 2 + (c >> 5), rr = r & 15, cc = c & 31, ob = rr * 64 + cc * 2; return st * 1024 + (ob ^ (((ob >> 9) & 1) << 5)); }
__host__ __device__ __forceinline__ void stage_rc(int b, int& R, int& C) { const int st = b / 1024, sb = b % 1024, swz = sb ^ (((sb >> 9) & 1) << 5); R = (st >> 1) * 16 + swz / 64; C = (st & 1) * 32 + (swz % 64) / 2; }
__host__ __device__ __forceinline__ int perm32(int rho) { const int n = rho >> 4, i = rho & 15; return 8 * (i >> 2) + 4 * n + (i & 3); }

struct Unit { int pm, pn; };
struct Gemm { const bf16_t* A; const bf16_t* Bt; int M, N, K; };

struct StaticOrder {
    int nM, nN, nwg, G, c;
    __host__ __device__ void init(int M, int N, int G_, int c_) { nM = M / BM; nN = N / BM; nwg = nM * nN; G = G_; c = c_; }
    __host__ __device__ bool next(int i, Unit& u) const {
        const long L = (long)i * G + c; if (L >= nwg) return false;
        int wgid = (int)L; { const int q = nwg / NXCD, r = nwg % NXCD, xcd = wgid % NXCD, off = wgid / NXCD; wgid = (xcd < r ? xcd * (q + 1) : r * (q + 1) + (xcd - r) * q) + off; }
        const int nig = WGM * nN, gid = wgid / nig, fm = gid * WGM, gsz = (nM - fm) < WGM ? (nM - fm) : WGM;
        u.pm = fm + ((wgid % nig) % gsz); u.pn = (wgid % nig) / gsz; return true;
    }
    __device__ __forceinline__ void a_ready(const Unit&) const {}
    __device__ __forceinline__ void done(const Unit&) const {}
};

__device__ __forceinline__ unsigned cvt_pk_bf16(float lo, float hi) { unsigned r; asm volatile("v_cvt_pk_bf16_f32 %0, %1, %2" : "=v"(r) : "v"(lo), "v"(hi)); return r; }
typedef float f32x2 __attribute__((ext_vector_type(2)));
__device__ __forceinline__ f32x2 gelu_pk(f32x2 v) {
    const f32x2 av = __builtin_elementwise_abs(v), d = av * 0.2316418882f + 1.0f;
    f32x2 t; t.x = __builtin_amdgcn_rcpf(d.x); t.y = __builtin_amdgcn_rcpf(d.y);
    f32x2 q = t * 0.5307027145f + (-0.7265760135f); q = q * t + 0.7107068705f; q = q * t + (-0.142248368f); q = q * t + 0.127414796f; q = q * t;
    const f32x2 s = (v * v) * (-0.72134752044f);
    f32x2 e; e.x = __builtin_amdgcn_exp2f(s.x); e.y = __builtin_amdgcn_exp2f(s.y);
    const f32x2 m = v * (q * e), r = v - m;
    f32x2 o; o.x = v.x < 0.f ? m.x : r.x; o.y = v.y < 0.f ? m.y : r.y; return o;
}
template <class Epi, class Sched, bool ALIGN_EPI = false, bool SP2 = false>
__device__ __forceinline__ void gemm_phase(PG8_LAS unsigned char* lds, const Gemm g, const Sched& S, const Epi& E) {
    const int tid = fresh_tid(), wid = __builtin_amdgcn_readfirstlane(tid >> 6), lane = tid & 63, wr = wid >> 2, wc = wid & 3, fr = lane & 15, fq = lane >> 4;
    const int K = g.K, nt = K / BK;
    unsigned voffA[2], voffB[2];
#pragma unroll
    for (int i = 0; i < 2; ++i) { int R, C; stage_rc(tid * 16 + i * 8192, R, C); const int Rb = Epi::PERM ? ((R & ~31) + perm32(R & 31)) : R;
        voffA[i] = (unsigned)(R * K + C) * 2u; voffB[i] = (unsigned)(Rb * K + C) * 2u; }
    const size_t kstep = (size_t)(BK * 2);
    const size_t hstep = (size_t)HALF * K * 2;
    const size_t tstep = 2 * hstep;
    const unsigned ldsw = (unsigned)wid * 1024u;
    const int aoff = lds_byte(wr * 64 + fr, fq * 8), boff = lds_byte(wc * 32 + fr, fq * 8);
#define PG8_SA(b, h) (((b) * 2 + (h)) * HTB)
#define PG8_SB(b, h) ((4 + (b) * 2 + (h)) * HTB)
#define PG8_STAGE(bufoff, gbase, voff) do { _Pragma("unroll") for (int _i = 0; _i < 2; ++_i) \
        __builtin_amdgcn_global_load_lds((const unsigned*)((const char*)(gbase) + (voff)[_i]), (PG8_LAS unsigned*)(lds + (bufoff) + ldsw + _i * 8192), 16, 0, 0); } while (0)
#define PG8_LDA(dst, b, h) do { _Pragma("unroll") for (int m = 0; m < 4; ++m) _Pragma("unroll") for (int k = 0; k < 2; ++k) dst[m][k] = *(const PG8_LAS bf16x8*)(lds + PG8_SA(b, h) + aoff + m * 2048 + k * 1024); } while (0)
#define PG8_LDB(dst, b, h) do { _Pragma("unroll") for (int n = 0; n < 2; ++n) _Pragma("unroll") for (int k = 0; k < 2; ++k) dst[n][k] = *(const PG8_LAS bf16x8*)(lds + PG8_SB(b, h) + boff + n * 2048 + k * 1024); } while (0)
#define PG8_MMA(ai, bj, At, Bt) do { __builtin_amdgcn_s_setprio(1); _Pragma("unroll") for (int m = 0; m < 4; ++m) _Pragma("unroll") for (int n = 0; n < 2; ++n) _Pragma("unroll") for (int k = 0; k < 2; ++k) \
        acc[ai][bj][m][n] = __builtin_amdgcn_mfma_f32_16x16x32_bf16(Bt[n][k], At[m][k], acc[ai][bj][m][n], 0, 0, 0); __builtin_amdgcn_s_setprio(0); } while (0)
#define PG8_WAIT_V(n) asm volatile("s_waitcnt vmcnt(" #n ")" ::: "memory")
#define PG8_WAIT_L(n) asm volatile("s_waitcnt lgkmcnt(" #n ")" ::: "memory")
#define PG8_BAR __builtin_amdgcn_s_barrier()
#define PG8_SCHED __builtin_amdgcn_sched_barrier(0)
    Unit cur, nxt; int ui = 0;
    if (!S.next(0, cur)) return;
    f32x4 acc[2][2][4][2];
#pragma unroll
    for (int a = 0; a < 2; ++a)
#pragma unroll
        for (int b = 0; b < 2; ++b)
#pragma unroll
            for (int m = 0; m < 4; ++m)
#pragma unroll
                for (int n = 0; n < 2; ++n) acc[a][b][m][n] = (f32x4){0.f, 0.f, 0.f, 0.f};
    bf16x8 At[4][2], B0[2][2], B1[2][2];
    const char* cA = (const char*)g.A + (size_t)cur.pm * tstep; const char* cB = (const char*)g.Bt + (size_t)cur.pn * tstep;
    S.a_ready(cur);
    if constexpr (SP2) {
        PG8_STAGE(PG8_SB(0, 0), cB, voffB); PG8_STAGE(PG8_SB(0, 1), cB + hstep, voffB); PG8_STAGE(PG8_SA(0, 0), cA, voffA); PG8_STAGE(PG8_SA(0, 1), cA + hstep, voffA);
        if (wr == 1) PG8_BAR;
        PG8_WAIT_V(2); PG8_BAR;
        PG8_STAGE(PG8_SB(1, 0), cB + kstep, voffB); PG8_STAGE(PG8_SA(1, 0), cA + kstep, voffA); PG8_STAGE(PG8_SB(1, 1), cB + hstep + kstep, voffB);
        PG8_WAIT_V(6); PG8_BAR;
    } else {
        PG8_STAGE(PG8_SB(0, 0), cB, voffB); PG8_STAGE(PG8_SA(0, 0), cA, voffA); PG8_STAGE(PG8_SB(0, 1), cB + hstep, voffB); PG8_STAGE(PG8_SA(0, 1), cA + hstep, voffA);
        if (wr == 1) PG8_BAR;
        PG8_WAIT_V(4); PG8_BAR;
        PG8_STAGE(PG8_SB(1, 0), cB + kstep, voffB); PG8_STAGE(PG8_SA(1, 0), cA + kstep, voffA); PG8_STAGE(PG8_SB(1, 1), cB + hstep + kstep, voffB);
        PG8_WAIT_V(6); PG8_BAR;
    }
    for (;;) {
        const bool has_next = S.next(ui + 1, nxt);
        const char* nA = has_next ? (const char*)g.A + (size_t)nxt.pm * tstep : cA; const char* nB = has_next ? (const char*)g.Bt + (size_t)nxt.pn * tstep : cB;
        for (int t = 0; t < nt; t += 2) {
            const bool last = (t == nt - 2);
            const char* a1 = cA + (size_t)(t + 1) * kstep;
            const char* a2 = last ? nA : cA + (size_t)(t + 2) * kstep; const char* b2 = last ? nB : cB + (size_t)(t + 2) * kstep;
            const char* a3 = a2 + kstep; const char* b3 = b2 + kstep;
            if (last && has_next) S.a_ready(nxt);
            if constexpr (SP2) {
            PG8_LDB(B0, 0, 0); PG8_LDB(B1, 0, 1); PG8_SCHED; PG8_LDA(At, 0, 0); PG8_STAGE(PG8_SA(1, 1), a1 + hstep, voffA);
            PG8_WAIT_V(8); PG8_WAIT_L(0); PG8_BAR; PG8_MMA(0, 0, At, B0); PG8_MMA(0, 1, At, B1); PG8_BAR; PG8_SCHED;
            PG8_LDA(At, 0, 1); PG8_STAGE(PG8_SB(0, 0), b2, voffB); PG8_STAGE(PG8_SB(0, 1), b2 + hstep, voffB); PG8_STAGE(PG8_SA(0, 0), a2, voffA);
            PG8_WAIT_V(8); PG8_WAIT_L(0); PG8_BAR; PG8_MMA(1, 0, At, B0); PG8_MMA(1, 1, At, B1); PG8_BAR; PG8_SCHED;
            PG8_LDB(B0, 1, 0); PG8_LDB(B1, 1, 1); PG8_SCHED; PG8_LDA(At, 1, 0); PG8_STAGE(PG8_SA(0, 1), a2 + hstep, voffA);
            PG8_WAIT_V(8); PG8_WAIT_L(0); PG8_BAR; PG8_MMA(0, 0, At, B0); PG8_MMA(0, 1, At, B1); PG8_BAR; PG8_SCHED;
            PG8_LDA(At, 1, 1); PG8_STAGE(PG8_SB(1, 0), b3, voffB); PG8_STAGE(PG8_SB(1, 1), b3 + hstep, voffB); PG8_STAGE(PG8_SA(1, 0), a3, voffA);
            PG8_WAIT_V(8); PG8_WAIT_L(0); PG8_BAR; PG8_MMA(1, 0, At, B0); PG8_MMA(1, 1, At, B1); PG8_BAR; PG8_SCHED;
            } else {
            PG8_LDB(B0, 0, 0); PG8_SCHED; PG8_LDA(At, 0, 0); PG8_STAGE(PG8_SA(1, 1), a1 + hstep, voffA);
            PG8_WAIT_L(8); PG8_BAR; PG8_WAIT_L(0); PG8_MMA(0, 0, At, B0); PG8_BAR; PG8_SCHED;
            PG8_LDB(B1, 0, 1); PG8_STAGE(PG8_SB(0, 0), b2, voffB);
            PG8_BAR; PG8_WAIT_L(0); PG8_MMA(0, 1, At, B1); PG8_BAR;
            PG8_LDA(At, 0, 1); PG8_STAGE(PG8_SA(0, 0), a2, voffA);
            PG8_BAR; PG8_WAIT_L(0); PG8_MMA(1, 0, At, B0); PG8_BAR; PG8_SCHED;
            PG8_STAGE(PG8_SB(0, 1), b2 + hstep, voffB);
            PG8_WAIT_V(6); PG8_BAR; PG8_MMA(1, 1, At, B1); PG8_BAR;
            PG8_LDB(B0, 1, 0); PG8_SCHED; PG8_LDA(At, 1, 0); PG8_STAGE(PG8_SA(0, 1), a2 + hstep, voffA);
            PG8_WAIT_L(8); PG8_BAR; PG8_WAIT_L(0); PG8_MMA(0, 0, At, B0); PG8_BAR; PG8_SCHED;
            PG8_LDB(B1, 1, 1); PG8_STAGE(PG8_SB(1, 0), b3, voffB);
            PG8_BAR; PG8_WAIT_L(0); PG8_MMA(0, 1, At, B1); PG8_BAR;
            PG8_LDA(At, 1, 1); PG8_STAGE(PG8_SA(1, 0), a3, voffA);
            PG8_BAR; PG8_WAIT_L(0); PG8_MMA(1, 0, At, B0); PG8_BAR; PG8_SCHED;
            PG8_STAGE(PG8_SB(1, 1), b3 + hstep, voffB);
            PG8_WAIT_V(6); PG8_BAR; PG8_MMA(1, 1, At, B1); PG8_BAR;
            }
        }
        if constexpr (ALIGN_EPI) { if (wr == 0) PG8_BAR; }
        if constexpr (!Epi::AFTER_DRAIN) { E(acc, cur, wr, wc, fr, fq); S.done(cur); }
        if (!has_next) break;
#pragma unroll
        for (int a = 0; a < 2; ++a)
#pragma unroll
            for (int b = 0; b < 2; ++b)
#pragma unroll
                for (int m = 0; m < 4; ++m)
#pragma unroll
                    for (int n = 0; n < 2; ++n) acc[a][b][m][n] = (f32x4){0.f, 0.f, 0.f, 0.f};
        cur = nxt; cA = nA; cB = nB; ++ui;
        if constexpr (ALIGN_EPI) { if (wr == 1) PG8_BAR; }
    }
    PG8_WAIT_V(0);
    if constexpr (!ALIGN_EPI) { if (wr == 0) PG8_BAR; }
    PG8_BAR;
    if constexpr (Epi::AFTER_DRAIN) { E.fused(acc, cur, wr, wc, fr, fq, lds, wid, lane); S.done(cur); }
#undef PG8_SA
#undef PG8_SB
#undef PG8_STAGE
#undef PG8_LDA
#undef PG8_LDB
#undef PG8_MMA
#undef PG8_WAIT_V
#undef PG8_WAIT_L
#undef PG8_BAR
#undef PG8_SCHED
}
}
#include <hip/hip_bf16.h>
#include <cmath>
namespace attn_body {
using bf16=__hip_bfloat16;
using bf16x8=__attribute__((ext_vector_type(8)))short;
using s16x4=__attribute__((ext_vector_type(4)))short;
using f32x16=__attribute__((ext_vector_type(16)))float;
using u32x4=__attribute__((ext_vector_type(4)))unsigned;
constexpr int BATCH=4,NVH=32,SEQ=8192,D=64,DM=1024,OPITCH=2048;
constexpr int NW=8,QBLK=32,QB=QBLK*NW,KVBLK=64,NQB=SEQ/QB;
constexpr int ATTN_PITCH=DM, ATTN_UNIT_ROWS=QB;
__device__ __forceinline__ int crow(int r,int hi){return (r&3)+8*(r>>2)+4*hi;}
#define SBAR() __builtin_amdgcn_sched_barrier(0)
__device__ __forceinline__ void cmask(f32x16&p0,f32x16&p1,int jb,int qrel,int hi){
  const float NEG=-INFINITY; (void)hi;
  if(jb>(qrel>>6)){
  #pragma unroll
  for(int r=0;r<16;++r){p0[r]=NEG;p1[r]=NEG;}}
}


constexpr int NSLOT=3, SLOTB=8192;
constexpr int LDS_K=0, LDS_V=NSLOT*SLOTB, LDS_WS=2*NSLOT*SLOTB, LDS_OST=LDS_WS+NW*64*4, LDS_BYTES=LDS_OST+NW*4096;
constexpr float C2=0.125f*1.4426950408889634f;
__device__ __forceinline__ void glds16(const void*gsrc,unsigned lds_dst){unsigned keep;
  asm volatile("s_mov_b32 %0, m0\n\ts_mov_b32 m0, %2\n\ts_nop 0\n\tglobal_load_lds_dwordx4 %1, off\n\ts_mov_b32 m0, %0":"=&s"(keep):"v"(gsrc),"s"(lds_dst):"memory");}
__device__ __forceinline__ float max3f(float a,float b,float c){float r;asm("v_max3_f32 %0, %1, %2, %3":"=v"(r):"v"(a),"v"(b),"v"(c));return r;}
__device__ __forceinline__ float max2f(float a,float b){float r;asm("v_max_f32_e32 %0, %1, %2":"=v"(r):"v"(a),"v"(b));return r;}
__device__ __forceinline__ float fadd_s(float a,float b){float r;asm("v_add_f32_e32 %0, %1, %2":"=v"(r):"v"(a),"v"(b));return r;}
__device__ __forceinline__ float fsub_s(float a,float b){float r;asm("v_sub_f32_e32 %0, %1, %2":"=v"(r):"v"(a),"v"(b));return r;}
typedef float f32x2_t __attribute__((ext_vector_type(2))); typedef __bf16 bf16x2_t __attribute__((ext_vector_type(2)));
__device__ __forceinline__ unsigned cvtpk_s(float lo,float hi){f32x2_t v={lo,hi};bf16x2_t b=__builtin_convertvector(v,bf16x2_t);return __builtin_bit_cast(unsigned,b);}
#define WAIT_BAR(N) asm volatile("s_waitcnt vmcnt(" #N ") lgkmcnt(0)\n\ts_barrier":::"memory")

__device__ __forceinline__ void qkt(f32x16&p0,f32x16&p1,const char*Kslot,const bf16x8*qr,const f32x16&negm,int r32,int hi){
  const char*kb=Kslot+hi*1024+r32*16;
  #pragma unroll
  for(int d0=0;d0<4;++d0){
    const bf16x8 b0=*reinterpret_cast<const bf16x8*>(kb+d0*2048);
    const bf16x8 b1=*reinterpret_cast<const bf16x8*>(kb+d0*2048+512);
    if(d0==0){p0=__builtin_amdgcn_mfma_f32_32x32x16_bf16(b0,qr[0],negm,0,0,0);p1=__builtin_amdgcn_mfma_f32_32x32x16_bf16(b1,qr[0],negm,0,0,0);}
    else{p0=__builtin_amdgcn_mfma_f32_32x32x16_bf16(b0,qr[d0],p0,0,0,0);p1=__builtin_amdgcn_mfma_f32_32x32x16_bf16(b1,qr[d0],p1,0,0,0);}}
}
typedef __attribute__((address_space(3))) const char* lds_cptr;
typedef short v4i16_t __attribute__((ext_vector_type(4)));
__device__ __forceinline__ void kload8(bf16x8*kf,lds_cptr kp){
  kf[0]=*(const __attribute__((address_space(3))) bf16x8*)(kp);      kf[1]=*(const __attribute__((address_space(3))) bf16x8*)(kp+512);
  kf[2]=*(const __attribute__((address_space(3))) bf16x8*)(kp+2048); kf[3]=*(const __attribute__((address_space(3))) bf16x8*)(kp+2560);
  kf[4]=*(const __attribute__((address_space(3))) bf16x8*)(kp+4096); kf[5]=*(const __attribute__((address_space(3))) bf16x8*)(kp+4608);
  kf[6]=*(const __attribute__((address_space(3))) bf16x8*)(kp+6144); kf[7]=*(const __attribute__((address_space(3))) bf16x8*)(kp+6656);
}
__device__ __forceinline__ void kload2(bf16x8*kf,lds_cptr kp,int j){ kf[2*j]=*(const __attribute__((address_space(3))) bf16x8*)(kp+j*2048); kf[2*j+1]=*(const __attribute__((address_space(3))) bf16x8*)(kp+j*2048+512); }
__device__ __forceinline__ s16x4 vtr(lds_cptr p){ return __builtin_bit_cast(s16x4,__builtin_amdgcn_ds_read_tr16_b64_v4i16((__attribute__((address_space(3))) v4i16_t*)p)); }
__device__ __forceinline__ float rowmax(const f32x16&p0,const f32x16&p1){
  float a=max3f(p0[0],p0[1],p1[0]),b=max3f(p0[2],p0[3],p1[1]);a=max3f(a,p1[2],p1[3]);
  #pragma unroll
  for(int r=4;r<16;r+=4){a=max3f(a,p0[r],p0[r+1]);b=max3f(b,p0[r+2],p0[r+3]);a=max3f(a,p1[r],p1[r+1]);b=max3f(b,p1[r+2],p1[r+3]);}
  const float m=max2f(a,b);
  auto rr=__builtin_amdgcn_permlane32_swap(__float_as_uint(m),__float_as_uint(m),false,false);
  return max2f(__uint_as_float(rr[0]),__uint_as_float(rr[1]));
}
__device__ __forceinline__ void pv(f32x16*o,int vb,bf16x8 pa0,bf16x8 pa1,bf16x8 pa2,bf16x8 pa3){
  #pragma unroll
  for(int d0=0;d0<2;++d0){s16x4 lo[4],hi[4];
    #pragma unroll
    for(int ks=0;ks<4;++ks){
      asm volatile("ds_read_b64_tr_b16 %0,%1 offset:%c2":"=&v"(lo[ks]):"v"(vb),"i"(d0*4096+ks*1024):"memory");
      asm volatile("ds_read_b64_tr_b16 %0,%1 offset:%c2":"=&v"(hi[ks]):"v"(vb),"i"(d0*4096+ks*1024+512):"memory");}
    asm volatile("s_waitcnt lgkmcnt(0)":::"memory");SBAR();
    #define PK(k) (bf16x8){lo[k][0],lo[k][1],lo[k][2],lo[k][3],hi[k][0],hi[k][1],hi[k][2],hi[k][3]}
    o[d0]=__builtin_amdgcn_mfma_f32_32x32x16_bf16(pa0,PK(0),o[d0],0,0,0);
    o[d0]=__builtin_amdgcn_mfma_f32_32x32x16_bf16(pa1,PK(1),o[d0],0,0,0);
    o[d0]=__builtin_amdgcn_mfma_f32_32x32x16_bf16(pa2,PK(2),o[d0],0,0,0);
    o[d0]=__builtin_amdgcn_mfma_f32_32x32x16_bf16(pa3,PK(3),o[d0],0,0,0);
    #undef PK
  }
}

#ifndef ATTN_STORE16
#define ATTN_STORE16(p,v) (*(u32x4*)(p)=(v))
#endif
template<int THRL> __device__ __forceinline__ void attn_unit(int b,int qoff,int koff,int voff,int ooff,int qb,const bf16*Q,const bf16*__restrict__ K,const bf16*__restrict__ V,bf16*O,char*shm){
  const int tid=fresh_tid(),lane=tid&63,r32=lane&31,hi=lane>>5; const int wid=__builtin_amdgcn_readfirstlane(tid>>6);
  const long rowbase=(long)b*SEQ; const int q0=qb*QB;
  const bf16*Qw=Q+(rowbase+q0+wid*QBLK)*DM+qoff;
  const bf16*Kh=K+rowbase*DM+koff,*Vh=V+rowbase*DM+voff;
  const unsigned lds0=(unsigned)(uintptr_t)shm;
  float*wsf=(float*)(shm+LDS_WS)+wid*64;
  const bf16*ksrc=Kh+(long)lane*DM+wid*8;
  const bf16*vsrc=Vh+(long)(16*(wid&3)+(lane>>2))*DM+(wid>>2)*32+(lane&3)*8;
  const unsigned kdst=lds0+LDS_K+wid*1024, vdst=lds0+LDS_V+wid*1024;
  #define DMA_K(t,slot) glds16(ksrc+(long)(t)*KVBLK*DM,(unsigned)__builtin_amdgcn_readfirstlane(kdst+(slot)))
  #define DMA_V(t,slot) glds16(vsrc+(long)(t)*KVBLK*DM,(unsigned)__builtin_amdgcn_readfirstlane(vdst+(slot)))
  const int vb0=(int)(lds0+LDS_V)+((lane>>4)&1)*32+(lane&3)*8+(4*hi+((lane&15)>>2))*64;
  const char*Kbase=shm+LDS_K; bf16x8 kf[8];
  const lds_cptr shm3=(lds_cptr)shm; const lds_cptr kp0=shm3+LDS_K+hi*1024+r32*16; const lds_cptr vp0=shm3+LDS_V+((lane>>4)&1)*32+(lane&3)*8+(4*hi+((lane&15)>>2))*64;
  const int NT=(q0+QB)/KVBLK;
  DMA_K(0,0);DMA_V(0,0);DMA_K(1,SLOTB);
  bf16x8 qr[4];
  #pragma unroll
  for(int d0=0;d0<4;++d0)qr[d0]=*reinterpret_cast<const bf16x8*>(&Qw[(long)r32*DM+d0*16+hi*8]);
  float mhat=0.f,l_reg=0.f;f32x16 o[2];o[0]=f32x16{};o[1]=f32x16{};f32x16 negm=f32x16{};asm volatile("":"+v"(negm));
  const int qrel=wid*QBLK+r32;
  #define CMASK(P0,P1,t) do{int jb_=(t)-(NT-4); if(jb_>=0)cmask(P0,P1,jb_,qrel,hi);}while(0)
  bool resc=false;
  #define START(P0,P1) do{ const float rm=rowmax(P0,P1); resc=false; \
    { const float dl=rm; mhat=fadd_s(mhat,dl); \
      _Pragma("unroll") for(int r=0;r<16;++r){P0[r]=fsub_s(P0[r],dl);P1[r]=fsub_s(P1[r],dl);} \
      _Pragma("unroll") for(int r=0;r<16;++r)negm[r]=-mhat; asm volatile("":"+v"(negm)); } \
    _Pragma("unroll") for(int r=0;r<16;++r)P0[r]=__builtin_amdgcn_exp2f(P0[r]); }while(0)
  #define RESC() do{ if(resc){ asm volatile("s_waitcnt lgkmcnt(0)":::"memory"); \
      _Pragma("unroll") for(int d_=0;d_<2;++d_) _Pragma("unroll") for(int r=0;r<16;++r)o[d_][r]*=wsf[crow(r,hi)]; } }while(0)
  f32x16 pA0,pA1,pB0,pB1;
  int sl_prev=0,sl_cur=0,sl_next=SLOTB;
  #define ROT() do{sl_prev=sl_cur;sl_cur=sl_next;sl_next=(sl_next==(NSLOT-1)*SLOTB)?0:sl_next+SLOTB;}while(0)
  DMA_K(2,2*SLOTB);
  WAIT_BAR(3);
  qkt(pA0,pA1,Kbase,qr,negm,r32,hi);asm volatile("s_nop 15\n\ts_nop 7":"+v"(pA0),"+v"(pA1));CMASK(pA0,pA1,0);
  START(pA0,pA1);
  _Pragma("unroll") for(int r=0;r<16;++r)pA1[r]=__builtin_amdgcn_exp2f(pA1[r]);
  WAIT_BAR(0);
  DMA_K(3,0);DMA_V(1,SLOTB);
  ROT();
  kload8(kf,kp0+sl_cur);
  WAIT_BAR(2);
  s16x4 vlo[8],vhi[8]; u32x4 pw0,pw1,pw2,pw3;
  #define PKW(P,B) cvtpk_s(P[B],P[B+1])
  #define PAF(k) __builtin_bit_cast(bf16x8,pw##k)
  #define VFR(i) (bf16x8){vlo[i][0],vlo[i][1],vlo[i][2],vlo[i][3],vhi[i][0],vhi[i][1],vhi[i][2],vhi[i][3]}
  #define PIN(x) asm volatile("":"+v"(x))
  #define MX3(a,b,c) __builtin_fmaxf(__builtin_fmaxf((a),(b)),(c))
  #define GAPA(MF,A0,A1,A2,A3,W0,W1,PW) do{ MF; sacc+=A0; sacc+=A1; sacc+=A2; sacc+=A3; PIN(sacc); W0; W1; PIN(PW); SBAR(); }while(0)
  #define EX(v) __builtin_amdgcn_exp2f(v)
  #define GAPB(MF,X,B) do{ MF; X[B]=EX(X[B]); X[B+1]=EX(X[B+1]); X[B+2]=EX(X[B+2]); X[B+3]=EX(X[B+3]); PIN(X); SBAR(); }while(0)
  #define VRD(i) do{ vlo[i]=vtr(vp_+(((i)>>2)*4096+((i)&3)*1024)); vhi[i]=vtr(vp_+(((i)>>2)*4096+((i)&3)*1024+512)); }while(0)
  #define KRD(G,j) do{ if(G){ kload2(kf,kp0+sl_next,j); SBAR(); } }while(0)
  #define STEP(C0,C1,P0,P1,t,GK,GV,GL) do{ SBAR(); \
    const lds_cptr vp_=vp0+sl_prev; \
    VRD(0); SBAR(); float sacc=(P0[0]+P0[1]); \
    GAPA(C0=__builtin_amdgcn_mfma_f32_32x32x16_bf16(kf[0],qr[0],negm,0,0,0), P0[2],P0[3],P0[4],P0[5],     pw0[0]=PKW(P0,0), pw0[1]=PKW(P0,2), pw0); \
    VRD(4); SBAR(); GAPA(C1=__builtin_amdgcn_mfma_f32_32x32x16_bf16(kf[1],qr[0],negm,0,0,0), P0[6],P0[7],P0[8],P0[9],     pw0[2]=PKW(P0,4), pw0[3]=PKW(P0,6), pw0); \
    VRD(1); SBAR(); GAPA(C0=__builtin_amdgcn_mfma_f32_32x32x16_bf16(kf[2],qr[1],C0,0,0,0),   P0[10],P0[11],P0[12],P0[13], pw1[0]=PKW(P0,8), pw1[1]=PKW(P0,10), pw1); \
    VRD(5); SBAR(); GAPA(C1=__builtin_amdgcn_mfma_f32_32x32x16_bf16(kf[3],qr[1],C1,0,0,0),   P0[14],P0[15],P1[0],P1[1],   pw1[2]=PKW(P0,12),pw1[3]=PKW(P0,14), pw1); \
    VRD(2); SBAR(); GAPA(C0=__builtin_amdgcn_mfma_f32_32x32x16_bf16(kf[4],qr[2],C0,0,0,0),   P1[2],P1[3],P1[4],P1[5],     pw2[0]=PKW(P1,0), pw2[1]=PKW(P1,2), pw2); \
    VRD(6); SBAR(); GAPA(C1=__builtin_amdgcn_mfma_f32_32x32x16_bf16(kf[5],qr[2],C1,0,0,0),   P1[6],P1[7],P1[8],P1[9],     pw2[2]=PKW(P1,4), pw2[3]=PKW(P1,6), pw2); \
    VRD(3); SBAR(); GAPA(C0=__builtin_amdgcn_mfma_f32_32x32x16_bf16(kf[6],qr[3],C0,0,0,0),   P1[10],P1[11],P1[12],P1[13], pw3[0]=PKW(P1,8), pw3[1]=PKW(P1,10), pw3); \
    VRD(7); SBAR(); GAPA(C1=__builtin_amdgcn_mfma_f32_32x32x16_bf16(kf[7],qr[3],C1,0,0,0),   P1[14],P1[15],0.f,0.f,       pw3[2]=PKW(P1,12),pw3[3]=PKW(P1,14), pw3); \
    l_reg+=sacc; \
    if(GK){DMA_K((t)+3,sl_cur);} if(GV){DMA_V((t)+1,sl_next);} \
    CMASK(C0,C1,t); \
    { float a=MX3(C0[0],C0[1],C1[0]),b=MX3(C0[2],C0[3],C1[1]); a=MX3(a,C1[2],C1[3]); \
      _Pragma("unroll") for(int r=4;r<16;r+=4){a=MX3(a,C0[r],C0[r+1]);b=MX3(b,C0[r+2],C0[r+3]);a=MX3(a,C1[r],C1[r+1]);b=MX3(b,C1[r+2],C1[r+3]);} \
      float rm=__builtin_fmaxf(a,b); { auto rr=__builtin_amdgcn_permlane32_swap(__float_as_uint(rm),__float_as_uint(rm),false,false); rm=__builtin_fmaxf(__uint_as_float(rr[0]),__uint_as_float(rr[1])); } \
      resc=false; \
      if(__builtin_expect(__any(rm>(float)THRL),0)){ const float dl=__builtin_fmaxf(rm,0.f); mhat+=dl; \
        _Pragma("unroll") for(int r=0;r<16;++r){C0[r]-=dl;C1[r]-=dl;} \
        _Pragma("unroll") for(int r=0;r<16;++r)negm[r]=-mhat; asm volatile("":"+v"(negm)); \
        const float f=__builtin_amdgcn_exp2f(-dl); l_reg*=f; if(hi==0)wsf[r32]=f; resc=true; } } \
    SBAR(); \
    GAPB(o[0]=__builtin_amdgcn_mfma_f32_32x32x16_bf16(PAF(0),VFR(0),o[0],0,0,0), C0,0); \
    GAPB(o[1]=__builtin_amdgcn_mfma_f32_32x32x16_bf16(PAF(0),VFR(4),o[1],0,0,0), C0,4); \
    KRD(GL,0); GAPB(o[0]=__builtin_amdgcn_mfma_f32_32x32x16_bf16(PAF(1),VFR(1),o[0],0,0,0), C0,8); \
    KRD(GL,1); GAPB(o[1]=__builtin_amdgcn_mfma_f32_32x32x16_bf16(PAF(1),VFR(5),o[1],0,0,0), C0,12); \
    KRD(GL,2); GAPB(o[0]=__builtin_amdgcn_mfma_f32_32x32x16_bf16(PAF(2),VFR(2),o[0],0,0,0), C1,0); \
    KRD(GL,3); GAPB(o[1]=__builtin_amdgcn_mfma_f32_32x32x16_bf16(PAF(2),VFR(6),o[1],0,0,0), C1,4); \
    GAPB(o[0]=__builtin_amdgcn_mfma_f32_32x32x16_bf16(PAF(3),VFR(3),o[0],0,0,0), C1,8); \
    GAPB(o[1]=__builtin_amdgcn_mfma_f32_32x32x16_bf16(PAF(3),VFR(7),o[1],0,0,0), C1,12); \
    }while(0)
  int t=1;
  #undef CMASK
  #define CMASK(P0,P1,t) do{}while(0)
  for(;t+5<NT;t+=2){
    STEP(pB0,pB1,pA0,pA1,t,true,true,true);     WAIT_BAR(2); RESC(); ROT();
    STEP(pA0,pA1,pB0,pB1,t+1,true,true,true);   WAIT_BAR(2); RESC(); ROT();
  }
  #undef CMASK
  #define CMASK(P0,P1,t) do{int jb_=(t)-(NT-4); if(jb_>=0)cmask(P0,P1,jb_,qrel,hi);}while(0)
  #define ENDW(tt) do{ if((tt)+3<NT){WAIT_BAR(2);} else if((tt)+2<NT){WAIT_BAR(1);} else {WAIT_BAR(0);} }while(0)
  for(;t+1<NT;t+=2){
    STEP(pB0,pB1,pA0,pA1,t,(t+3<NT),(t+1<NT),(t+1<NT));       ENDW(t);   RESC(); ROT();
    STEP(pA0,pA1,pB0,pB1,t+1,(t+4<NT),(t+2<NT),(t+2<NT));     ENDW(t+1); RESC(); ROT();
  }
  STEP(pB0,pB1,pA0,pA1,NT-1,false,false,false); RESC();
  { float sacc=pB0[0]+pB0[1]; _Pragma("unroll") for(int r=2;r<16;++r)sacc+=pB0[r]; _Pragma("unroll") for(int r=0;r<16;++r)sacc+=pB1[r]; l_reg+=sacc;
    pw0=(u32x4){PKW(pB0,0),PKW(pB0,2),PKW(pB0,4),PKW(pB0,6)};pw1=(u32x4){PKW(pB0,8),PKW(pB0,10),PKW(pB0,12),PKW(pB0,14)};pw2=(u32x4){PKW(pB1,0),PKW(pB1,2),PKW(pB1,4),PKW(pB1,6)};pw3=(u32x4){PKW(pB1,8),PKW(pB1,10),PKW(pB1,12),PKW(pB1,14)};
    SBAR(); pv(o,vb0+sl_cur,PAF(0),PAF(1),PAF(2),PAF(3)); }
  #undef PKW
  #undef PAF
  #undef VFR
  #undef PIN
  #undef MX3
  #undef GAPA
  #undef GAPB
  #undef EX
  #undef VRD
  #undef KRD
  #undef STEP
  #undef ENDW
  {auto rr=__builtin_amdgcn_permlane32_swap(__float_as_uint(l_reg),__float_as_uint(l_reg),false,false);l_reg=__uint_as_float(rr[0])+__uint_as_float(rr[1]);}
  if(hi==0)wsf[32+r32]=l_reg;asm volatile("s_waitcnt lgkmcnt(0)":::"memory");
  float rli[16];
  #pragma unroll
  for(int r=0;r<16;++r)rli[r]=__builtin_amdgcn_rcpf(wsf[32+crow(r,hi)]);
  bf16*Ow=O+(rowbase+q0+wid*QBLK)*OPITCH+ooff;
  { bf16*stg=(bf16*)(shm+LDS_OST)+wid*2048;
    #pragma unroll
    for(int r=0;r<16;++r){const int orow=crow(r,hi);
      #pragma unroll
      for(int d0=0;d0<2;++d0)stg[orow*64+d0*32+r32]=__float2bfloat16(o[d0][r]*rli[r]);}
    asm volatile("s_waitcnt lgkmcnt(0)":::"memory");
    #pragma unroll
    for(int i=0;i<4;++i){const int row=i*8+(lane>>3),ch=lane&7; const u32x4 v=*(const u32x4*)(stg+row*64+ch*8); ATTN_STORE16(Ow+(long)row*OPITCH+ch*8,v);} }
  asm volatile("s_waitcnt lgkmcnt(0)\n\ts_barrier":::"memory");
  #undef DMA_K
  #undef DMA_V
  #undef CMASK
  #undef START
  #undef RESC
  #undef ROT
}
constexpr int ATTN_LDS_BYTES=LDS_BYTES;
struct AttnTensors { const bf16* Q; const bf16* K; const bf16* V; bf16* O; };
struct AttnUnit { int bh; int qb; };
struct StaticOrder {
  int vcu;
  __device__ __forceinline__ explicit StaticOrder(int grid,int block):vcu((block%8)*(grid/8)+block/8){}
  __device__ __forceinline__ bool next(int i,AttnUnit&u)const{ if(i>=16)return false; const int s=vcu&7,j=i&3; u.bh=(i>>2)*32+(vcu>>3); u.qb=(j==0)?s:(j==1)?15-s:(j==2)?16+s:31-s; return true; }
};
template<class Sched,int THRL=8> __device__ __forceinline__ void attn_phase(char*lds,const AttnTensors&T,const Sched&S){
  AttnUnit u;
  for(int i=0;S.next(i,u);++i){ const int b=u.bh>>5,vh=u.bh&31,h=vh>>2,sh=(vh>>1)&1,half=vh&1;
    attn_unit<THRL>(b,(2*h+sh)*64,(2*h+sh)*64,h*128+half*64,vh*64,u.qb,T.Q,T.K,T.V,T.O,lds); }
}
#undef SBAR
#undef WAIT_BAR
}
constexpr int NWAVES = 8;
constexpr int DM_ = 1024, MP = 32768, MS = 512, MT = MP + MS, SEQ_ = 8192, PAST = 4096;
constexpr int FFH = 2816, GH = 3072;
constexpr float EPS_ = 1e-6f;
constexpr float LAM_INIT = 0.35550906f;
constexpr size_t MiB = 1u << 20;
constexpr size_t WS_CTL = 0, CTL_ZERO_BYTES = 1 * MiB;
constexpr size_t WS_STATS = 640 * 1024;
constexpr size_t WS_MOD = 1 * MiB;
constexpr size_t WS_TAB = 5 * MiB;
constexpr size_t WS_LB = 13 * MiB;
constexpr size_t WS_W = 16 * MiB;
constexpr size_t W_GIN = WS_W, W_GOUT = W_GIN + 12 * MiB, W_DIN = W_GOUT + 6 * MiB, W_DOUT = W_DIN + 6 * MiB, W_RIN = W_DOUT + 2 * MiB, W_ROUT = W_RIN + 12 * MiB,
                 W_HIN = W_ROUT + 4 * MiB, W_HOUT = W_HIN + 8 * MiB, W_FIN = W_HOUT + 2 * MiB, W_FOUT = W_FIN + 44 * MiB, W_END = W_FOUT + 22 * MiB;
constexpr size_t FIN_STRIDE = 11 * MiB, FOUT_STRIDE = (size_t)1024 * 2816 * 2;
constexpr size_t WS_H = 144 * MiB;
constexpr size_t WS_F = 209 * MiB;
constexpr size_t WS_BIG = 274 * MiB;
constexpr size_t WS_B2 = 664 * MiB;
constexpr size_t WS_B3 = 859 * MiB;
constexpr size_t WS_LF = 989 * MiB;
constexpr size_t WS_QD = 1119 * MiB, WS_KI = 1184 * MiB, WS_KE = 1249 * MiB;
constexpr size_t WS_EB = 1314 * MiB;
constexpr size_t WS_END = 1320 * MiB;
static_assert(W_END <= WS_H && WS_STATS + (size_t)MT * 8 <= CTL_ZERO_BYTES, "ws map");
constexpr int CW_TMO = 0, CW_BAR = 4096;
constexpr int RING_BYTES = 131072, LDSCTL_OFF = RING_BYTES, MISC_OFF = LDSCTL_OFF + 320, LDS_BYTES = 147456;
constexpr size_t O_YP = 0, O_YS = 33554432, O_GV = 34078720, O_KDP = 35651584, O_VDP = 69206016, O_KDS = 102760448, O_VDS = 103284736,
                 O_RSP = 103809024, O_RSS = 105906176, O_HSP = 122683392, O_HSS = 123207680, O_END = 127401984;
#define GAS __attribute__((address_space(1)))
#define LAS __attribute__((address_space(3)))
typedef unsigned short bf16;
typedef unsigned v4u __attribute__((ext_vector_type(4)));
typedef float f32x4 __attribute__((ext_vector_type(4)));
typedef short bf16x8 __attribute__((ext_vector_type(8)));
typedef GAS unsigned gu32;
typedef GAS unsigned long long gu64;
#define RLX_AGENT __ATOMIC_RELAXED, __HIP_MEMORY_SCOPE_AGENT
#define LDS_WAIT() asm volatile("s_waitcnt lgkmcnt(0)" ::: "memory")
#define VM_WAIT() asm volatile("s_waitcnt vmcnt(0)" ::: "memory")
__device__ __forceinline__ unsigned long long rt() { return __builtin_amdgcn_s_memrealtime(); }
__device__ __forceinline__ unsigned f2bf(float f) { unsigned u = __builtin_bit_cast(unsigned, f); return (u + 0x7fffu + ((u >> 16) & 1u)) >> 16; }
__device__ __forceinline__ unsigned pk2(float lo, float hi) { return f2bf(lo) | (f2bf(hi) << 16); }

#define XB_TMO      128
#define XB_XCNT(j)  (256  + 64 * (j))
#define XB_XSUB(j)  (1280 + 64 * (j))
#define XB_XGEN(j)  (2304 + 64 * (j))
#define XB_TOP      3328
#define XB_TOPGEN   3392
#define XCD_BAR_WORDS 3456
#define XB_SPIN_CAP (1u << 18)

__device__ __forceinline__ unsigned xb_ld(unsigned* p)              { return __hip_atomic_load(p, __ATOMIC_RELAXED, __HIP_MEMORY_SCOPE_AGENT); }
__device__ __forceinline__ unsigned xb_add(unsigned* p, unsigned v) { return __hip_atomic_fetch_add(p, v, __ATOMIC_RELAXED, __HIP_MEMORY_SCOPE_AGENT); }
__device__ __forceinline__ unsigned xb_xcc_id() { return (unsigned)__builtin_amdgcn_s_getreg((3 << 11) | 20) & 0xFu; }
#define XB_SPIN(cond, bar) do { unsigned _sp = 0; while (cond) { __builtin_amdgcn_s_sleep(1); \
    if ((++_sp & 255u) == 0u) { if (xb_ld(&(bar)[XB_TMO])) break; if (_sp > XB_SPIN_CAP) { atomicAdd(&(bar)[XB_TMO], 1u); break; } } } } while (0)

struct XcdBarrier {
    unsigned* bar; unsigned x;
    volatile LAS unsigned* st;
};

__device__ __forceinline__ XcdBarrier xcd_barrier_post(unsigned* bar, volatile LAS unsigned* st) {
    XcdBarrier b; b.bar = bar; b.x = xb_xcc_id(); b.st = st;
    if (threadIdx.x == 0) (void)xb_add(&bar[XB_XCNT(b.x)], 1u);
    return b;
}
__device__ __forceinline__ void xcd_barrier_complete(unsigned* bar, unsigned x, unsigned& nloc, unsigned& nx) {
    const unsigned G = gridDim.x * gridDim.y * gridDim.z;
    unsigned sum, cnt, mine, sp = 0u;
    for (;;) {
        sum = 0u; cnt = 0u; mine = 0u;
#pragma unroll
        for (unsigned j = 0; j < 16; ++j) { const unsigned c = xb_ld(&bar[XB_XCNT(j)]); sum += c; cnt += (c > 0u) ? 1u : 0u; mine = (j == x) ? c : mine; }
        if (sum == G) break;
        __builtin_amdgcn_s_sleep(1);
        if ((++sp & 255u) == 0u) { if (xb_ld(&bar[XB_TMO])) break; if (sp > XB_SPIN_CAP) { atomicAdd(&bar[XB_TMO], 1u); break; } }
    }
    nloc = mine > 0u ? mine : 1u; nx = cnt > 0u ? cnt : 1u;
}

__device__ __forceinline__ void xcd_barrier(const XcdBarrier& b) {
    asm volatile("s_waitcnt vmcnt(0)" ::: "memory");
    __syncthreads();
    if (threadIdx.x == 0) {
        unsigned* bar = b.bar;
        __builtin_amdgcn_s_waitcnt(0);
        unsigned nloc = b.st[0], nx = b.st[1];
        if (nloc == 0u) { xcd_barrier_complete(bar, b.x, nloc, nx); b.st[0] = nloc; b.st[1] = nx; }
        const unsigned old = xb_add(&bar[XB_XSUB(b.x)], 1u);
        const unsigned gen = old / nloc;
        if (old + 1u == (gen + 1u) * nloc) {
            __builtin_amdgcn_fence(__ATOMIC_RELEASE, "agent");
            asm volatile("s_waitcnt vmcnt(0)" ::: "memory");
            const unsigned og = xb_add(&bar[XB_TOP], 1u);
            const unsigned tg = og / nx;
            if (og + 1u == (tg + 1u) * nx) xb_add(&bar[XB_TOPGEN], 1u);
            else XB_SPIN(xb_ld(&bar[XB_TOPGEN]) == tg, bar);
            __builtin_amdgcn_fence(__ATOMIC_ACQUIRE, "agent");
            xb_add(&bar[XB_XGEN(b.x)], 1u);
            asm volatile("s_waitcnt vmcnt(0)" ::: "memory");
        } else {
            XB_SPIN(xb_ld(&bar[XB_XGEN(b.x)]) == gen, bar);
            __builtin_amdgcn_fence(__ATOMIC_ACQUIRE, "agent");
            asm volatile("s_waitcnt vmcnt(0)" ::: "memory");
        }
    }
    __syncthreads();
}
typedef short s16x4 __attribute__((ext_vector_type(4)));
typedef unsigned u32x2 __attribute__((ext_vector_type(2)));
typedef unsigned u32x4 __attribute__((ext_vector_type(4)));
typedef LAS unsigned char* lptr;
__device__ __forceinline__ float bflo(unsigned w) { return __uint_as_float(w << 16); }
__device__ __forceinline__ float bfhi(unsigned w) { return __uint_as_float(w & 0xffff0000u); }
__device__ __forceinline__ unsigned pkbf(float lo, float hi) { return pg8::cvt_pk_bf16(lo, hi); }
__device__ __forceinline__ float wave_sum(float v) {
#pragma unroll
    for (int o = 1; o < 64; o <<= 1) v += __shfl_xor(v, o);
    return v;
}
__device__ __forceinline__ float siluf(float x) { return x * __builtin_amdgcn_rcpf(1.0f + __expf(-x)); }
__device__ __forceinline__ int sid_of_row(int row) { return row < MP ? (row >> 13) : 4 + ((row - MP) >> 4); }
__device__ __forceinline__ f32x4 mma32(bf16x8 a, bf16x8 b, f32x4 c) { return __builtin_amdgcn_mfma_f32_16x16x32_bf16(a, b, c, 0, 0, 0); }
__device__ __forceinline__ f32x4 mma16(s16x4 a, s16x4 b, f32x4 c) { return __builtin_amdgcn_mfma_f32_16x16x16bf16_1k(a, b, c, 0, 0, 0); }
__device__ __forceinline__ bf16x8 frag_row(lptr base, int pitch, int x0, int k0, int lane) {
    return *(const LAS bf16x8*)(base + (x0 + (lane & 15)) * pitch + (k0 + 8 * (lane >> 4)) * 2);
}
typedef short v4i16_t __attribute__((ext_vector_type(4)));
__device__ __forceinline__ bf16x8 frag_tr(lptr base, int pitch, int k0, int x0, int lane) {
    const int g = lane >> 4, i = lane & 15, q = i >> 2, p = i & 3;
    lptr a = base + (k0 + 8 * g + q) * pitch + (x0 + 4 * p) * 2;
    const s16x4 lo = __builtin_bit_cast(s16x4, __builtin_amdgcn_ds_read_tr16_b64_v4i16((LAS v4i16_t*)a));
    const s16x4 hi = __builtin_bit_cast(s16x4, __builtin_amdgcn_ds_read_tr16_b64_v4i16((LAS v4i16_t*)(a + 4 * pitch)));
    return (bf16x8){lo[0], lo[1], lo[2], lo[3], hi[0], hi[1], hi[2], hi[3]};
}

struct Ctx { int tid, lane, wave, vcu, G, gw, NGW; lptr lds; };

__device__ __forceinline__ Ctx mk_ctx(lptr lds) {
    Ctx C; C.lds = lds; C.tid = fresh_tid(); C.lane = C.tid & 63; C.wave = __builtin_amdgcn_readfirstlane(C.tid >> 6);
    int G = gridDim.x, bx = blockIdx.x; asm volatile("" : "+s"(G), "+s"(bx));
    C.G = G; C.vcu = (G % 8 == 0) ? (bx % 8) * (G / 8) + bx / 8 : bx; C.gw = C.vcu * NWAVES + C.wave; C.NGW = G * NWAVES; return C;
}
__device__ __forceinline__ void p0_transpose_item(const float* W, int K, int N, bf16* WT, int mode, LAS float* scr, int item, int lane) {
    const int nblk = N / 32, kb = item / nblk, nb = item % nblk, k0 = 64 * kb, n0 = 32 * nb;
    int d0 = n0;
    if (mode == 1) { d0 = (n0 < FFH) ? ((n0 >> 7) * 256 + (n0 & 127)) : (((n0 - FFH) >> 7) * 256 + 128 + ((n0 - FFH) & 127)); }
#pragma unroll 8
    for (int i = 0; i < 32; ++i) { const int kk = 2 * i + (lane >> 5); scr[kk * 33 + (lane & 31)] = W[(size_t)(k0 + kk) * N + n0 + (lane & 31)]; }
    LDS_WAIT(); asm volatile("" ::: "memory");
    const int c = lane & 7;
#pragma unroll
    for (int j = 0; j < 4; ++j) { const int n = (lane >> 3) + 8 * j; const LAS float* s = scr + (8 * c) * 33 + n;
        v4u o; o.x = pk2(s[0 * 33], s[1 * 33]); o.y = pk2(s[2 * 33], s[3 * 33]); o.z = pk2(s[4 * 33], s[5 * 33]); o.w = pk2(s[6 * 33], s[7 * 33]);
        *(GAS v4u*)(WT + (size_t)(d0 + n) * K + k0 + 8 * c) = o; }
    LDS_WAIT(); asm volatile("" ::: "memory");
}
__device__ __forceinline__ void p0_transpose(const Ctx& C, const float* W, int K, int N, bf16* WT, int mode) {
    LAS float* scr = (LAS float*)(C.lds + C.wave * 16384);
    const int nitems = (K / 64) * (N / 32);
    for (int it = C.gw; it < nitems; it += C.NGW) p0_transpose_item(W, K, N, WT, mode, scr, it, C.lane);
}
__device__ __forceinline__ void p0_adaln(const Ctx& C, const float* cp, const float* cs, const float* w_ada, const float* b_ada, float* mod) {
    LAS float* sl = (LAS float*)C.lds;
    LAS float* red = (LAS float*)(C.lds + 81920);
    for (int u = C.vcu; u < 768; u += C.G) {
        const int half = u & 1, cb = (u >> 1) % 96, l = (u >> 1) / 96, sid0 = half * 18;
        __syncthreads();
        for (int idx = C.tid; idx < 18 * 1024; idx += 512) { const int i = idx >> 10, k = idx & 1023, sid = sid0 + i;
            const float cv = sid < 4 ? cp[sid * 1024 + k] : cs[(sid - 4) * 1024 + k]; sl[k * 20 + i] = siluf(cv); }
        __syncthreads();
        const int c = C.tid & 63, kg = C.wave, col = cb * 64 + c;
        float acc[18];
#pragma unroll
        for (int i = 0; i < 18; ++i) acc[i] = 0.f;
        const float* wp = w_ada + ((size_t)l * 1024 + kg * 128) * 6144 + col;
#pragma unroll 4
        for (int kk = 0; kk < 128; ++kk) { const float w = wp[(size_t)kk * 6144]; const LAS float* s = sl + (kg * 128 + kk) * 20;
            const f32x4 a = *(const LAS f32x4*)s, b = *(const LAS f32x4*)(s + 4), cc = *(const LAS f32x4*)(s + 8), d = *(const LAS f32x4*)(s + 12); const float e0 = s[16], e1 = s[17];
            acc[0] += a[0] * w; acc[1] += a[1] * w; acc[2] += a[2] * w; acc[3] += a[3] * w; acc[4] += b[0] * w; acc[5] += b[1] * w; acc[6] += b[2] * w; acc[7] += b[3] * w;
            acc[8] += cc[0] * w; acc[9] += cc[1] * w; acc[10] += cc[2] * w; acc[11] += cc[3] * w; acc[12] += d[0] * w; acc[13] += d[1] * w; acc[14] += d[2] * w; acc[15] += d[3] * w;
            acc[16] += e0 * w; acc[17] += e1 * w; }
#pragma unroll
        for (int i = 0; i < 18; ++i) red[(kg * 18 + i) * 64 + c] = acc[i];
        __syncthreads();
        for (int idx = C.tid; idx < 18 * 64; idx += 512) { const int i = idx >> 6, cc = idx & 63; float s = 0.f;
#pragma unroll
            for (int g = 0; g < 8; ++g) s += red[(g * 18 + i) * 64 + cc];
            const int colo = cb * 64 + cc; mod[((size_t)l * 36 + sid0 + i) * 6144 + colo] = s + b_ada[l * 6144 + colo]; }
    }
    __syncthreads();
}
__device__ __forceinline__ void p0_tables(const Ctx& C, float* tab, float* lb, const float* hlb) {
    const int gt = C.vcu * 512 + C.tid, NT = C.G * 512;
    for (int idx = gt; idx < 8192 * 128; idx += NT) { const int pos = idx >> 7, i = idx & 127;
        const double inv = exp(-9.210340371976184 * ((double)i / 127.0)); const double ang = (double)pos * inv;
        double sn, cs; sincos(ang, &sn, &cs); tab[2 * (size_t)idx] = (float)cs; tab[2 * (size_t)idx + 1] = (float)sn; }
    for (int c = gt; c < 1024; c += NT) { const float a0 = hlb[c], a1 = hlb[1024 + c], a2 = hlb[2048 + c], a3 = hlb[3072 + c];
        const float mx = fmaxf(fmaxf(a0, a1), fmaxf(a2, a3)); const float e0 = expf(a0 - mx), e1 = expf(a1 - mx), e2 = expf(a2 - mx), e3 = expf(a3 - mx);
        lb[c] = (e1 + e2 + e3) / (e0 + e1 + e2 + e3); }
}

template <bool HAS_F, bool HAS_H>
__device__ __forceinline__ void resnorm_phase(const Ctx& C, const float* xp, const float* xs, const bf16* Fb, float* xout, const float* mod,
                                              const float* gpost, int mgate, bf16* Hb, const float* gpre, int mshift, int mscale) {
    for (int m = C.gw; m < MT; m += C.NGW) {
        const int sid = sid_of_row(m); const float* mrow = mod + (size_t)sid * 6144;
        const GAS f32x4* xr = (const GAS f32x4*)(m < MP ? xp + (size_t)m * DM_ : xs + (size_t)(m - MP) * DM_) + C.lane;
        f32x4 v[4];
#pragma unroll
        for (int j = 0; j < 4; ++j) v[j] = xr[64 * j];
        if (HAS_F) {
            const GAS u32x2* fr = (const GAS u32x2*)(Fb + (size_t)m * DM_) + C.lane; f32x4 f[4]; float ss = 0.f;
#pragma unroll
            for (int j = 0; j < 4; ++j) { const u32x2 w = fr[64 * j]; f[j] = (f32x4){bflo(w.x), bfhi(w.x), bflo(w.y), bfhi(w.y)}; ss += (f[j].x * f[j].x + f[j].y * f[j].y) + (f[j].z * f[j].z + f[j].w * f[j].w); }
            const float rstd = 1.0f / sqrtf(wave_sum(ss) * (1.0f / DM_) + EPS_);
            GAS f32x4* xo = (GAS f32x4*)(xout + (size_t)m * DM_) + C.lane;
#pragma unroll
            for (int j = 0; j < 4; ++j) { const f32x4 g = *((const GAS f32x4*)gpost + C.lane + 64 * j), gt = *((const GAS f32x4*)(mrow + mgate) + C.lane + 64 * j);
                v[j] = v[j] + gt * (f[j] * rstd * g); xo[64 * j] = v[j]; }
        }
        if (HAS_H) {
            float ss = 0.f;
#pragma unroll
            for (int j = 0; j < 4; ++j) ss += (v[j].x * v[j].x + v[j].y * v[j].y) + (v[j].z * v[j].z + v[j].w * v[j].w);
            const float rstd = 1.0f / sqrtf(wave_sum(ss) * (1.0f / DM_) + EPS_);
            GAS u32x2* ho = (GAS u32x2*)(Hb + (size_t)m * DM_) + C.lane;
#pragma unroll
            for (int j = 0; j < 4; ++j) { const f32x4 g = *((const GAS f32x4*)gpre + C.lane + 64 * j), sc = *((const GAS f32x4*)(mrow + mscale) + C.lane + 64 * j), sh = *((const GAS f32x4*)(mrow + mshift) + C.lane + 64 * j);
                const f32x4 h = v[j] * rstd * g * (sc + 1.0f) + sh; u32x2 w; w.x = pkbf(h.x, h.y); w.y = pkbf(h.z, h.w); ho[64 * j] = w; }
        }
    }
}
#define EPI_LOOP_ROWS for (int ai = 0; ai < 2; ++ai) _Pragma("unroll") for (int m = 0; m < 4; ++m)
__device__ __forceinline__ u32x4 pack8(f32x4 a, f32x4 b) { u32x4 w; w.x = pkbf(a[0], a[1]); w.y = pkbf(a[2], a[3]); w.z = pkbf(b[0], b[1]); w.w = pkbf(b[2], b[3]); return w; }
typedef pg8::f32x2 f32x2;
__device__ __forceinline__ f32x4 gelu4(f32x4 v) { const f32x2 a = pg8::gelu_pk((f32x2){v[0], v[1]}), b = pg8::gelu_pk((f32x2){v[2], v[3]}); return (f32x4){a.x, a.y, b.x, b.y}; }
__device__ __forceinline__ f32x4 silu4(f32x4 v) { return (f32x4){siluf(v[0]), siluf(v[1]), siluf(v[2]), siluf(v[3])}; }

struct EpiPlain {
    static constexpr bool PERM = true, AFTER_DRAIN = false;
    bf16* O; int ldc;
    __device__ __forceinline__ void operator()(const f32x4 (&acc)[2][2][4][2], const pg8::Unit& u, int wr, int wc, int fr, int fq) const {
        const int row0 = u.pm * 256 + wr * 64 + fr, col0 = u.pn * 256 + wc * 32 + 8 * fq;
#pragma unroll
        EPI_LOOP_ROWS { bf16* rowp = O + (size_t)(row0 + ai * 128 + m * 16) * ldc + col0;
#pragma unroll
            for (int bj = 0; bj < 2; ++bj) *(u32x4*)(rowp + bj * 128) = pack8(acc[ai][bj][m][0], acc[ai][bj][m][1]); }
    }
};
struct EpiGelu {
    static constexpr bool PERM = true, AFTER_DRAIN = false;
    bf16* Z; float* stats;
    __device__ __forceinline__ void operator()(const f32x4 (&acc)[2][2][4][2], const pg8::Unit& u, int wr, int wc, int fr, int fq) const {
        const int row0 = u.pm * 256 + wr * 64 + fr, col0 = u.pn * 256 + wc * 32 + 8 * fq; const bool isv = u.pn >= 12;
#pragma unroll
        EPI_LOOP_ROWS { const int row = row0 + ai * 128 + m * 16; bf16* rowp = Z + (size_t)row * 6144 + col0; float s = 0.f, q = 0.f;
#pragma unroll
            for (int bj = 0; bj < 2; ++bj) { const f32x4 a = gelu4(acc[ai][bj][m][0]), b = gelu4(acc[ai][bj][m][1]); *(u32x4*)(rowp + bj * 128) = pack8(a, b);
                s += (a[0] + a[1]) + (a[2] + a[3]) + (b[0] + b[1]) + (b[2] + b[3]);
                q += (a[0] * a[0] + a[1] * a[1]) + (a[2] * a[2] + a[3] * a[3]) + (b[0] * b[0] + b[1] * b[1]) + (b[2] * b[2] + b[3] * b[3]); }
            if (isv) { s += __shfl_xor(s, 16); s += __shfl_xor(s, 32); q += __shfl_xor(q, 16); q += __shfl_xor(q, 32);
                if (fq == 0) { atomicAdd(stats + 2 * row, s); atomicAdd(stats + 2 * row + 1, q); } } }
    }
};
struct EpiSwiglu {
    static constexpr bool PERM = true, AFTER_DRAIN = false;
    bf16* O;
    __device__ __forceinline__ void operator()(const f32x4 (&acc)[2][2][4][2], const pg8::Unit& u, int wr, int wc, int fr, int fq) const {
        const int row0 = u.pm * 256 + wr * 64 + fr, col0 = u.pn * 128 + wc * 32 + 8 * fq;
#pragma unroll
        EPI_LOOP_ROWS { bf16* rowp = O + (size_t)(row0 + ai * 128 + m * 16) * FFH + col0;
            *(u32x4*)rowp = pack8(silu4(acc[ai][0][m][0]) * acc[ai][1][m][0], silu4(acc[ai][0][m][1]) * acc[ai][1][m][1]); }
    }
};
struct EpiDiff {
    static constexpr bool PERM = true, AFTER_DRAIN = false;
    bf16* Qb; float* kp; float* ks; float c2;
    __device__ __forceinline__ void operator()(const f32x4 (&acc)[2][2][4][2], const pg8::Unit& u, int wr, int wc, int fr, int fq) const {
        const int row0 = u.pm * 256 + wr * 64 + fr, t = u.pn >> 2, col0 = (u.pn & 3) * 256 + wc * 32 + 8 * fq;
        bf16* ob = Qb + (size_t)t * MT * DM_; const float sc = t == 0 ? c2 : 1.0f;
#pragma unroll
        EPI_LOOP_ROWS { const int row = row0 + ai * 128 + m * 16; bf16* rowp = ob + (size_t)row * DM_ + col0;
            float* fo = row < MP ? kp + (size_t)row * DM_ + (size_t)(t == 2 ? (O_VDP - O_KDP) : 0) : ks + (size_t)(row - MP) * DM_ + (size_t)(t == 2 ? (O_VDS - O_KDS) : 0);
#pragma unroll
            for (int bj = 0; bj < 2; ++bj) { const f32x4 a = acc[ai][bj][m][0] * sc, b = acc[ai][bj][m][1] * sc; *(u32x4*)(rowp + bj * 128) = pack8(a, b);
                if (t != 0) { *(f32x4*)(fo + col0 + bj * 128) = a; *(f32x4*)(fo + col0 + bj * 128 + 4) = b; } } }
    }
};
struct EpiRet {
    static constexpr bool PERM = true, AFTER_DRAIN = false;
    bf16* O; const float* tab;
    __device__ __forceinline__ void operator()(const f32x4 (&acc)[2][2][4][2], const pg8::Unit& u, int wr, int wc, int fr, int fq) const {
        const int row0 = u.pm * 256 + wr * 64 + fr, col0 = u.pn * 256 + wc * 32 + 8 * fq; const int t = u.pn < 4 ? 0 : (u.pn < 8 ? 1 : (u.pn < 16 ? 2 : 3));
#pragma unroll
        EPI_LOOP_ROWS { const int row = row0 + ai * 128 + m * 16; bf16* rowp = O + (size_t)row * 6144 + col0;
            const int pos = row < MP ? (row & 8191) : PAST + ((row - MP) & 15);
#pragma unroll
            for (int bj = 0; bj < 2; ++bj) { f32x4 a = acc[ai][bj][m][0], b = acc[ai][bj][m][1];
                if (t <= 1) { const int cl = (col0 + bj * 128) & 255; const float* tp = tab + ((size_t)pos * 128 + (cl >> 1)) * 2; const f32x4 t0 = *(const f32x4*)tp, t1 = *(const f32x4*)(tp + 4);
                    const float sc = t == 1 ? 0.0625f : 1.0f;
                    a = (f32x4){a[0] * t0[0] - a[1] * t0[1], a[1] * t0[0] + a[0] * t0[1], a[2] * t0[2] - a[3] * t0[3], a[3] * t0[2] + a[2] * t0[3]} * sc;
                    b = (f32x4){b[0] * t1[0] - b[1] * t1[1], b[1] * t1[0] + b[0] * t1[1], b[2] * t1[2] - b[3] * t1[3], b[3] * t1[2] + b[2] * t1[3]} * sc; }
                else if (t == 3) { a = silu4(a); b = silu4(b); }
                *(u32x4*)(rowp + bj * 128) = pack8(a, b); } }
    }
};
struct EpiHgrn {
    static constexpr bool PERM = true, AFTER_DRAIN = false;
    bf16* O; float* LF; const float* lb;
    __device__ __forceinline__ void operator()(const f32x4 (&acc)[2][2][4][2], const pg8::Unit& u, int wr, int wc, int fr, int fq) const {
        const int row0 = u.pm * 256 + wr * 64 + fr, col0 = u.pn * 256 + wc * 32 + 8 * fq, t = u.pn >> 2;
#pragma unroll
        EPI_LOOP_ROWS { const int row = row0 + ai * 128 + m * 16; bf16* rowp = O + (size_t)row * 4096 + col0;
#pragma unroll
            for (int bj = 0; bj < 2; ++bj) { f32x4 a = acc[ai][bj][m][0], b = acc[ai][bj][m][1];
                if (t == 0 || t == 3) { a = silu4(a); b = silu4(b); }
                else if (t == 1) { const int cl = col0 + bj * 128 - 1024; const f32x4 l0 = *(const f32x4*)(lb + cl), l1 = *(const f32x4*)(lb + cl + 4); f32x4 la, lbv;
#pragma unroll
                    for (int j = 0; j < 4; ++j) { const float k0 = (1.0f - l0[j]) * __builtin_amdgcn_rcpf(1.0f + __expf(a[j])), k1 = (1.0f - l1[j]) * __builtin_amdgcn_rcpf(1.0f + __expf(b[j]));
                        la[j] = log1pf(-k0); lbv[j] = log1pf(-k1); a[j] = k0; b[j] = k1; }
                    float* lf = LF + (size_t)row * DM_ + cl; *(f32x4*)lf = la; *(f32x4*)(lf + 4) = lbv; }
                *(u32x4*)(rowp + bj * 128) = pack8(a, b); } }
    }
};
__device__ __forceinline__ void gmlp_gate_phase(const Ctx& C, const bf16* Z, const float* stats, const float* lng, const float* lnb, const float* w_s, const float* b_s, bf16* GO, float* gv_out) {
    constexpr int PW = 272;
    lptr Wl = C.lds, Vl = C.lds + 34816, Ml = C.lds + 69632; LAS float* st = (LAS float*)(C.lds + 104448); LAS float* bl = st + 256;
    const int lane = C.lane, w = C.wave, fq = lane >> 4, ln = lane & 15;
    for (int u = C.vcu; u < 260 * 24; u += C.G) {
        const int ch = u / 24, cb = u - ch * 24, g = cb / 3, c0 = cb * 128, r0 = ch * 128; const bool smp = ch >= 256;
        __syncthreads();
        for (int idx = C.tid; idx < 2048; idx += 512) { const int t = idx >> 4, s8 = (idx & 15) * 8; f32x4 a = {0.f, 0.f, 0.f, 0.f}, b = a; int lim;
            if (!smp) { const float* wp = w_s + ((size_t)g * 128 + t) * 128 + s8; a = *(const f32x4*)wp; b = *(const f32x4*)(wp + 4); lim = t - s8; }
            else { const int tl = t & 15, sl8 = s8 & 15; lim = -1; if ((t >> 4) == (s8 >> 4)) { const float* wp = w_s + ((size_t)g * 128 + tl) * 128 + sl8; a = *(const f32x4*)wp; b = *(const f32x4*)(wp + 4); lim = tl - sl8; } }
#pragma unroll
            for (int j = 0; j < 4; ++j) { if (j > lim) a[j] = 0.f; if (j + 4 > lim) b[j] = 0.f; }
            *(LAS u32x4*)(Wl + t * PW + s8 * 2) = pack8(a, b); }
        if (C.tid < 128) { const int row = r0 + C.tid; const float s = stats[2 * row], q = stats[2 * row + 1]; const float mu = s * (1.0f / GH), var = q * (1.0f / GH) - mu * mu;
            st[2 * C.tid] = mu; st[2 * C.tid + 1] = 1.0f / sqrtf(fmaxf(var, 0.f) + EPS_); bl[C.tid] = b_s[g * 128 + (smp ? (C.tid & 15) : C.tid)]; }
        __syncthreads();
        for (int idx = C.tid; idx < 2048; idx += 512) { const int s = idx >> 4, c8 = (idx & 15) * 8; const u32x4 zv = *(const u32x4*)(Z + (size_t)(r0 + s) * 6144 + GH + c0 + c8);
            const f32x4 g0 = *(const f32x4*)(lng + c0 + c8), g1 = *(const f32x4*)(lng + c0 + c8 + 4), b0 = *(const f32x4*)(lnb + c0 + c8), b1 = *(const f32x4*)(lnb + c0 + c8 + 4);
            const float mu = st[2 * s], rs = st[2 * s + 1];
            f32x4 a = {bflo(zv.x), bfhi(zv.x), bflo(zv.y), bfhi(zv.y)}, b = {bflo(zv.z), bfhi(zv.z), bflo(zv.w), bfhi(zv.w)};
            a = (a - mu) * rs * g0 + b0; b = (b - mu) * rs * g1 + b1;
            *(LAS u32x4*)(Vl + s * PW + c8 * 2) = pack8(a, b);
            if (smp) { float* go = gv_out + (size_t)(r0 + s - MP) * GH + c0 + c8; *(f32x4*)go = a; *(f32x4*)(go + 4) = b; } }
        __syncthreads();
        f32x4 acc[8];
#pragma unroll
        for (int nt = 0; nt < 8; ++nt) acc[nt] = (f32x4){0.f, 0.f, 0.f, 0.f};
#pragma unroll
        for (int ks = 0; ks < 4; ++ks) if (32 * ks <= 16 * w + 15) { const bf16x8 A = frag_row(Wl, PW, 16 * w, 32 * ks, lane);
#pragma unroll
            for (int nt = 0; nt < 8; ++nt) { const bf16x8 B = frag_tr(Vl, PW, 32 * ks, 16 * nt, lane); acc[nt] = mma32(A, B, acc[nt]); } }
#pragma unroll
        for (int nt = 0; nt < 8; ++nt)
#pragma unroll
            for (int i = 0; i < 4; ++i) { const int t = 16 * w + 4 * fq + i; *(LAS bf16*)(Ml + t * PW + (16 * nt + ln) * 2) = (bf16)f2bf(acc[nt][i] + bl[t]); }
        __syncthreads();
        for (int idx = C.tid; idx < 2048; idx += 512) { const int t = idx >> 4, c8 = (idx & 15) * 8; const u32x4 uv = *(const u32x4*)(Z + (size_t)(r0 + t) * 6144 + c0 + c8), mv = *(const LAS u32x4*)(Ml + t * PW + c8 * 2);
            u32x4 o; o.x = pkbf(bflo(uv.x) * bflo(mv.x), bfhi(uv.x) * bfhi(mv.x)); o.y = pkbf(bflo(uv.y) * bflo(mv.y), bfhi(uv.y) * bfhi(mv.y));
            o.z = pkbf(bflo(uv.z) * bflo(mv.z), bfhi(uv.z) * bfhi(mv.z)); o.w = pkbf(bflo(uv.w) * bflo(mv.w), bfhi(uv.w) * bfhi(mv.w));
            *(u32x4*)(GO + (size_t)(r0 + t) * GH + c0 + c8) = o; }
    }
    __syncthreads();
}

__device__ __forceinline__ float diff_lambda(const float* lamp, int lane) {
    const float p1 = lamp[lane] * lamp[64 + lane], p2 = lamp[128 + lane] * lamp[192 + lane];
    return expf(wave_sum(p1)) - expf(wave_sum(p2)) + LAM_INIT;
}
__device__ __forceinline__ void diff_combine_phase(const Ctx& C, const bf16* O4, const float* lamp, const float* subln, bf16* A2) {
    const float lam = diff_lambda(lamp, C.lane); const int lane = C.lane, h = lane >> 3, sub = lane & 7, half = sub >> 2, d0 = (sub & 3) * 16, dv0 = sub * 16;
    float gsc[16];
#pragma unroll
    for (int j = 0; j < 16; ++j) gsc[j] = subln[dv0 + j] * (1.0f - LAM_INIT);
    for (int m = C.gw; m < MP; m += C.NGW) {
        const bf16* p0 = O4 + (size_t)m * 2048 + (4 * h + half) * 64 + d0; const u32x4 a0 = *(const u32x4*)p0, a1 = *(const u32x4*)(p0 + 8), b0 = *(const u32x4*)(p0 + 128), b1 = *(const u32x4*)(p0 + 136);
        float o[16]; const unsigned aw[8] = {a0.x, a0.y, a0.z, a0.w, a1.x, a1.y, a1.z, a1.w}, bw[8] = {b0.x, b0.y, b0.z, b0.w, b1.x, b1.y, b1.z, b1.w}; float ss = 0.f;
#pragma unroll
        for (int j = 0; j < 8; ++j) { o[2 * j] = bflo(aw[j]) - lam * bflo(bw[j]); o[2 * j + 1] = bfhi(aw[j]) - lam * bfhi(bw[j]); ss += o[2 * j] * o[2 * j] + o[2 * j + 1] * o[2 * j + 1]; }
        ss += __shfl_xor(ss, 1); ss += __shfl_xor(ss, 2); ss += __shfl_xor(ss, 4);
        const float rstd = 1.0f / sqrtf(ss * (1.0f / 128.0f) + EPS_);
        u32x4 w0, w1; w0.x = pkbf(o[0] * rstd * gsc[0], o[1] * rstd * gsc[1]); w0.y = pkbf(o[2] * rstd * gsc[2], o[3] * rstd * gsc[3]); w0.z = pkbf(o[4] * rstd * gsc[4], o[5] * rstd * gsc[5]); w0.w = pkbf(o[6] * rstd * gsc[6], o[7] * rstd * gsc[7]);
        w1.x = pkbf(o[8] * rstd * gsc[8], o[9] * rstd * gsc[9]); w1.y = pkbf(o[10] * rstd * gsc[10], o[11] * rstd * gsc[11]); w1.z = pkbf(o[12] * rstd * gsc[12], o[13] * rstd * gsc[13]); w1.w = pkbf(o[14] * rstd * gsc[14], o[15] * rstd * gsc[15]);
        bf16* op = A2 + (size_t)m * DM_ + h * 128 + dv0; *(u32x4*)op = w0; *(u32x4*)(op + 8) = w1;
    }
}

__device__ __forceinline__ void diff_sample_phase(const Ctx& C, const bf16* Qb, const float* ck, const float* cv, const float* kds, const float* vds, const float* lamp, const float* subln, bf16* A2) {
    constexpr int PK = 272, PV = 136, KBUF = 64 * PK, VBUF = 128 * PV;
    lptr Kl0 = C.lds, Vt0 = C.lds + 2 * KBUF;
    LAS float* Om = (LAS float*)C.lds; LAS float* ml = (LAS float*)(C.lds + 65536);
    const float lam = diff_lambda(lamp, C.lane);
    const int lane = C.lane, fq = lane >> 4, ln = lane & 15, s = C.wave & 1, kt = C.wave >> 1, key = C.tid >> 3, part = C.tid & 7;
    for (int u = C.vcu; u < 256; u += C.G) {
        const int sb = u >> 3, h = u & 7;
        const bf16* qp = Qb + (size_t)(MP + 16 * sb + ln) * DM_ + (2 * h + s) * 64 + 8 * fq;
        const bf16x8 qf0 = *(const bf16x8*)qp, qf1 = *(const bf16x8*)(qp + 32);
        float mrun = -INFINITY, lrun = 0.f; f32x4 o[8];
#pragma unroll
        for (int dt = 0; dt < 8; ++dt) o[dt] = (f32x4){0.f, 0.f, 0.f, 0.f};
        f32x4 kr[4], vr[4];
#define DS_LOAD(T) do { const float* kp_; const float* vp_; bool ok_ = true; \
            if ((T) < 64) { kp_ = ck + ((size_t)(sb * PAST + 64 * (T) + key) * 16 + 2 * h) * 64 + 16 * part; vp_ = cv + ((size_t)(sb * PAST + 64 * (T) + key) * 8 + h) * 128 + 16 * part; } \
            else { ok_ = key < 16; kp_ = kds + ((size_t)(sb * 16 + (key & 15)) * 16 + 2 * h) * 64 + 16 * part; vp_ = vds + ((size_t)(sb * 16 + (key & 15)) * 8 + h) * 128 + 16 * part; } \
            _Pragma("unroll") for (int i_ = 0; i_ < 4; ++i_) { kr[i_] = ok_ ? *(const f32x4*)(kp_ + 4 * i_) : (f32x4){0.f, 0.f, 0.f, 0.f}; vr[i_] = ok_ ? *(const f32x4*)(vp_ + 4 * i_) : (f32x4){0.f, 0.f, 0.f, 0.f}; } } while (0)
        DS_LOAD(0);
        __syncthreads();
        for (int T = 0; T <= 64; ++T) {
            lptr Kl = Kl0 + (T & 1) * KBUF, Vt = Vt0 + (T & 1) * VBUF;
            *(LAS u32x4*)(Kl + key * PK + part * 32) = pack8(kr[0], kr[1]); *(LAS u32x4*)(Kl + key * PK + part * 32 + 16) = pack8(kr[2], kr[3]);
#pragma unroll
            for (int i = 0; i < 4; ++i)
#pragma unroll
                for (int j = 0; j < 4; ++j) *(LAS bf16*)(Vt + (16 * part + 4 * i + j) * PV + key * 2) = (bf16)f2bf(vr[i][j]);
            __syncthreads();
            if (T < 64) DS_LOAD(T + 1);
            if (T < 64 || kt == 0) {
                f32x4 sc = {0.f, 0.f, 0.f, 0.f};
                sc = mma32(frag_row(Kl, PK, 16 * kt, s * 64, lane), qf0, sc); sc = mma32(frag_row(Kl, PK, 16 * kt, s * 64 + 32, lane), qf1, sc);
                float mx = fmaxf(fmaxf(sc[0], sc[1]), fmaxf(sc[2], sc[3])); mx = fmaxf(mx, __shfl_xor(mx, 16)); mx = fmaxf(mx, __shfl_xor(mx, 32));
                const float mn = fmaxf(mrun, mx), alpha = exp2f(mrun - mn); mrun = mn;
                const float p0 = exp2f(sc[0] - mn), p1 = exp2f(sc[1] - mn), p2 = exp2f(sc[2] - mn), p3 = exp2f(sc[3] - mn);
                lrun = lrun * alpha + ((p0 + p1) + (p2 + p3));
                const u32x2 pw = {pkbf(p0, p1), pkbf(p2, p3)}; const s16x4 P = __builtin_bit_cast(s16x4, pw);
#pragma unroll
                for (int dt = 0; dt < 8; ++dt) { const s16x4 A = *(const LAS s16x4*)(Vt + (16 * dt + ln) * PV + (16 * kt + 4 * fq) * 2); o[dt] = mma16(A, P, o[dt] * alpha); }
            }
        }
#undef DS_LOAD
        lrun += __shfl_xor(lrun, 16); lrun += __shfl_xor(lrun, 32);
        __syncthreads();
        if (fq == 0) { ml[C.wave * 16 + ln] = mrun; ml[128 + C.wave * 16 + ln] = lrun; }
#pragma unroll
        for (int dt = 0; dt < 8; ++dt) *(LAS f32x4*)(Om + (C.wave * 16 + ln) * 128 + 16 * dt + 4 * fq) = o[dt];
        __syncthreads();
        { const int q = C.tid >> 5, dv4 = (C.tid & 31) * 4; f32x4 os[2];
#pragma unroll
            for (int ss = 0; ss < 2; ++ss) { float M = -INFINITY;
#pragma unroll
                for (int k = 0; k < 4; ++k) M = fmaxf(M, ml[(2 * k + ss) * 16 + q]);
                float Ls = 0.f; f32x4 a = {0.f, 0.f, 0.f, 0.f};
#pragma unroll
                for (int k = 0; k < 4; ++k) { const int wv = 2 * k + ss; const float e = exp2f(ml[wv * 16 + q] - M); Ls += ml[128 + wv * 16 + q] * e; a = a + *(const LAS f32x4*)(Om + (wv * 16 + q) * 128 + dv4) * e; }
                os[ss] = a * (1.0f / Ls); }
            const f32x4 od = os[0] - os[1] * lam; float ssq = (od[0] * od[0] + od[1] * od[1]) + (od[2] * od[2] + od[3] * od[3]);
#pragma unroll
            for (int x = 1; x < 32; x <<= 1) ssq += __shfl_xor(ssq, x);
            const float rstd = 1.0f / sqrtf(ssq * (1.0f / 128.0f) + EPS_) * (1.0f - LAM_INIT); const f32x4 g = *(const f32x4*)(subln + dv4);
            u32x2 wv2; wv2.x = pkbf(od[0] * rstd * g[0], od[1] * rstd * g[1]); wv2.y = pkbf(od[2] * rstd * g[2], od[3] * rstd * g[3]);
            *(u32x2*)(A2 + (size_t)(MP + 16 * sb + q) * DM_ + h * 128 + dv4) = wv2; }
        __syncthreads();
    }
}
__device__ __forceinline__ void ret_scan_phase(const Ctx& C, const bf16* BIG, const float* st_in, bf16* Or, float* st_out_p, float* st_out_s) {
    constexpr int PQ = 528, PVV = 80, PP = 144;
    lptr Ql = C.lds, Kl = Ql + 64 * PQ, Vl = Kl + 64 * PQ, Vd = Vl + 64 * PVV, Pl = Vd + 64 * PVV, Sl = Pl + 64 * PP;
    const int lane = C.lane, w = C.wave, fq = lane >> 4, ln = lane & 15, tid = C.tid;
    for (int u = C.vcu; u < 256 + 2048; u += C.G) {
        int h, j, row0, nsteps, L; const float* sin_ = nullptr; float* sout;
        if (u < 256) { const int b = u >> 6; h = (u >> 4) & 3; j = u & 15; row0 = b * SEQ_; nsteps = 128; L = 64; sout = st_out_p + ((size_t)(b * 4 + h) * 256) * 512 + 32 * j; }
        else { const int su = u - 256, sb = su >> 6; h = (su >> 4) & 3; j = su & 15; row0 = MP + 16 * sb; nsteps = 1; L = 16; sin_ = st_in + ((size_t)(sb * 4 + h) * 256) * 512 + 32 * j; sout = st_out_s + ((size_t)(sb * 4 + h) * 256) * 512 + 32 * j; }
        const float lg2 = log2f(1.0f - exp2f(-5.0f - (float)h)), gL = exp2f(lg2 * (float)L);
        f32x4 st[2][2];
#pragma unroll
        for (int dt = 0; dt < 2; ++dt)
#pragma unroll
            for (int vt = 0; vt < 2; ++vt)
#pragma unroll
                for (int i = 0; i < 4; ++i) st[dt][vt][i] = sin_ ? sin_[(size_t)(16 * (2 * w + dt) + 4 * fq + i) * 512 + 16 * vt + ln] : 0.f;
        u32x4 qr[4], kr[4], vr;
#define RET_LOAD(n) do { const int rb_ = row0 + 64 * (n); \
            _Pragma("unroll") for (int i_ = 0; i_ < 4; ++i_) { const int idx_ = tid + 512 * i_, t_ = idx_ >> 5, c_ = idx_ & 31; \
                if (t_ < L) { const bf16* p_ = BIG + (size_t)(rb_ + t_) * 6144 + h * 256 + c_ * 8; qr[i_] = *(const u32x4*)p_; kr[i_] = *(const u32x4*)(p_ + 1024); } \
                else { qr[i_] = (u32x4){0u, 0u, 0u, 0u}; kr[i_] = (u32x4){0u, 0u, 0u, 0u}; } } \
            if (tid < 256) { const int t_ = tid >> 2, c_ = tid & 3; vr = t_ < L ? *(const u32x4*)(BIG + (size_t)(rb_ + t_) * 6144 + 2048 + h * 512 + 32 * j + c_ * 8) : (u32x4){0u, 0u, 0u, 0u}; } } while (0)
        RET_LOAD(0);
        for (int n = 0; n < nsteps; ++n) {
            __syncthreads();
#pragma unroll
            for (int i = 0; i < 4; ++i) { const int idx = tid + 512 * i, t = idx >> 5, c = idx & 31; *(LAS u32x4*)(Ql + t * PQ + c * 16) = qr[i]; *(LAS u32x4*)(Kl + t * PQ + c * 16) = kr[i]; }
            if (tid < 256) { const int t = tid >> 2, c = tid & 3; *(LAS u32x4*)(Vl + t * PVV + c * 16) = vr; const float f = t < L ? exp2f(lg2 * (float)(L - 1 - t)) : 0.f;
                u32x4 d; d.x = pkbf(bflo(vr.x) * f, bfhi(vr.x) * f); d.y = pkbf(bflo(vr.y) * f, bfhi(vr.y) * f); d.z = pkbf(bflo(vr.z) * f, bfhi(vr.z) * f); d.w = pkbf(bflo(vr.w) * f, bfhi(vr.w) * f);
                *(LAS u32x4*)(Vd + t * PVV + c * 16) = d; }
            __syncthreads();
            if (n + 1 < nsteps) RET_LOAD(n + 1);
            { const int ti = w >> 1, si0 = 2 * (w & 1); f32x4 a0 = {0.f, 0.f, 0.f, 0.f}, a1 = a0;
#pragma unroll
                for (int ks = 0; ks < 8; ++ks) { const bf16x8 B = frag_row(Ql, PQ, 16 * ti, 32 * ks, lane);
                    a0 = mma32(frag_row(Kl, PQ, 16 * si0, 32 * ks, lane), B, a0); a1 = mma32(frag_row(Kl, PQ, 16 * si0 + 16, 32 * ks, lane), B, a1); }
                const int t = 16 * ti + ln;
#pragma unroll
                for (int x = 0; x < 2; ++x) { const f32x4 a = x ? a1 : a0; const int sb0 = 16 * (si0 + x) + 4 * fq; float p[4];
#pragma unroll
                    for (int i = 0; i < 4; ++i) { const int dd = t - (sb0 + i); p[i] = dd >= 0 ? a[i] * exp2f(lg2 * (float)dd) : 0.f; }
                    const u32x2 pw = {pkbf(p[0], p[1]), pkbf(p[2], p[3])}; *(LAS u32x2*)(Pl + t * PP + sb0 * 2) = pw; } }
#pragma unroll
            for (int dt = 0; dt < 2; ++dt)
#pragma unroll
                for (int vt = 0; vt < 2; ++vt) { const u32x2 sw = {pkbf(st[dt][vt][0], st[dt][vt][1]), pkbf(st[dt][vt][2], st[dt][vt][3])}; *(LAS u32x2*)(Sl + (16 * vt + ln) * PQ + (16 * (2 * w + dt) + 4 * fq) * 2) = sw; }
            __syncthreads();
            { const int vi = w & 1, ti = w >> 1; f32x4 oi = {0.f, 0.f, 0.f, 0.f}, oc = oi;
#pragma unroll
                for (int ks = 0; ks < 2; ++ks) if (32 * ks <= 16 * ti + 15) oi = mma32(frag_tr(Vl, PVV, 32 * ks, 16 * vi, lane), frag_row(Pl, PP, 16 * ti, 32 * ks, lane), oi);
#pragma unroll
                for (int ks = 0; ks < 8; ++ks) oc = mma32(frag_row(Sl, PQ, 16 * vi, 32 * ks, lane), frag_row(Ql, PQ, 16 * ti, 32 * ks, lane), oc);
                const int t = 16 * ti + ln; const float cr = exp2f(lg2 * (float)(t + 1));
                if (t < L) { const u32x2 ow = {pkbf(oi[0] + oc[0] * cr, oi[1] + oc[1] * cr), pkbf(oi[2] + oc[2] * cr, oi[3] + oc[3] * cr)};
                    *(u32x2*)(Or + (size_t)(row0 + 64 * n + t) * 2048 + h * 512 + 32 * j + 16 * vi + 4 * fq) = ow; } }
#pragma unroll
            for (int dt = 0; dt < 2; ++dt)
#pragma unroll
                for (int vt = 0; vt < 2; ++vt) { f32x4 a = st[dt][vt] * gL;
#pragma unroll
                    for (int ks = 0; ks < 2; ++ks) a = mma32(frag_tr(Kl, PQ, 32 * ks, 16 * (2 * w + dt), lane), frag_tr(Vd, PVV, 32 * ks, 16 * vt, lane), a);
                    st[dt][vt] = a; }
        }
#undef RET_LOAD
#pragma unroll
        for (int dt = 0; dt < 2; ++dt)
#pragma unroll
            for (int vt = 0; vt < 2; ++vt)
#pragma unroll
                for (int i = 0; i < 4; ++i) sout[(size_t)(16 * (2 * w + dt) + 4 * fq + i) * 512 + 16 * vt + ln] = st[dt][vt][i];
    }
    __syncthreads();
}
__device__ __forceinline__ void ret_post_phase(const Ctx& C, const bf16* Or, const bf16* BIG, bf16* A3) {
    const int lane = C.lane, h = lane >> 4, c0 = h * 512 + (lane & 15) * 32;
    for (int m = C.gw; m < MT; m += C.NGW) {
        const u32x4* op = (const u32x4*)(Or + (size_t)m * 2048 + c0); const u32x4* gp = (const u32x4*)(BIG + (size_t)m * 6144 + 4096 + c0);
        u32x4 ov[4], gv[4]; float ss = 0.f;
#pragma unroll
        for (int i = 0; i < 4; ++i) { ov[i] = op[i]; gv[i] = gp[i]; }
#pragma unroll
        for (int i = 0; i < 4; ++i) { const unsigned ww[4] = {ov[i].x, ov[i].y, ov[i].z, ov[i].w};
#pragma unroll
            for (int k = 0; k < 4; ++k) { const float a = bflo(ww[k]), b = bfhi(ww[k]); ss += a * a + b * b; } }
        ss += __shfl_xor(ss, 1); ss += __shfl_xor(ss, 2); ss += __shfl_xor(ss, 4); ss += __shfl_xor(ss, 8);
        const float rstd = 1.0f / sqrtf(ss * (1.0f / 512.0f) + EPS_);
        u32x4* ap = (u32x4*)(A3 + (size_t)m * 2048 + c0);
#pragma unroll
        for (int i = 0; i < 4; ++i) { const unsigned ww[4] = {ov[i].x, ov[i].y, ov[i].z, ov[i].w}, gg[4] = {gv[i].x, gv[i].y, gv[i].z, gv[i].w}; unsigned r[4];
#pragma unroll
            for (int k = 0; k < 4; ++k) r[k] = pkbf(bflo(ww[k]) * rstd * bflo(gg[k]), bfhi(ww[k]) * rstd * bfhi(gg[k]));
            ap[i] = (u32x4){r[0], r[1], r[2], r[3]}; }
    }
}

__device__ __forceinline__ void hgrn_prep_phase(const Ctx& C, const bf16* HB, const float* LF, bf16* QD, bf16* KI, bf16* KE, float* EB) {
    for (int u = C.vcu; u < 544 * 2; u += C.G) {
        const int cidx = u >> 1, col = (u & 1) * 512 + C.tid; const int r0 = cidx < 512 ? 64 * cidx : MP + 16 * (cidx - 512), L = cidx < 512 ? 64 : 16;
        const float* lp = LF + (size_t)r0 * DM_ + col; float bl = 0.f;
#pragma unroll 8
        for (int t = 0; t < L; ++t) bl += lp[(size_t)t * DM_];
        EB[(size_t)cidx * DM_ + col] = __expf(bl);
        float b = 0.f;
#pragma unroll 4
        for (int t = 0; t < L; ++t) { b += lp[(size_t)t * DM_]; const size_t r = (size_t)(r0 + t);
            const float q = __uint_as_float((unsigned)HB[r * 4096 + col] << 16), k = __uint_as_float((unsigned)HB[r * 4096 + 1024 + col] << 16);
            QD[r * DM_ + col] = (bf16)f2bf(q * __expf(b)); KI[r * DM_ + col] = (bf16)f2bf(k * __expf(-b)); KE[r * DM_ + col] = (bf16)f2bf(k * __expf(bl - b)); }
    }
}
__device__ __forceinline__ void hgrn_scan_phase(const Ctx& C, const bf16* QD, const bf16* KI, const bf16* KE, const bf16* HB, const float* EB, const float* st_in, bf16* Oh, float* st_out_p, float* st_out_s) {
    constexpr int PQ = 272, PVV = 48, PP = 144;
    lptr Ql = C.lds, KIl = Ql + 64 * PQ, KEl = KIl + 64 * PQ, Vl = KEl + 64 * PQ, Pl = Vl + 64 * PVV, Sl = Pl + 64 * PP; LAS float* EBl = (LAS float*)(Sl + 16 * PQ);
    const int lane = C.lane, w = C.wave, fq = lane >> 4, ln = lane & 15, tid = C.tid;
    for (int u = C.vcu; u < 256 + 2048; u += C.G) {
        int h, j, row0, nsteps, L, ch0; const float* sin_ = nullptr; float* sout;
        if (u < 256) { const int b = u >> 6; h = (u >> 3) & 7; j = u & 7; row0 = b * SEQ_; nsteps = 128; L = 64; ch0 = b * 128; sout = st_out_p + ((size_t)(b * 8 + h) * 128) * 128 + 16 * j; }
        else { const int su = u - 256, sb = su >> 6; h = (su >> 3) & 7; j = su & 7; row0 = MP + 16 * sb; nsteps = 1; L = 16; ch0 = 512 + sb; sin_ = st_in + ((size_t)(sb * 8 + h) * 128) * 128 + 16 * j; sout = st_out_s + ((size_t)(sb * 8 + h) * 128) * 128 + 16 * j; }
        f32x4 st;
#pragma unroll
        for (int i = 0; i < 4; ++i) st[i] = sin_ ? sin_[(size_t)(16 * w + 4 * fq + i) * 128 + ln] : 0.f;
        u32x4 qr[2], kir[2], ker[2], vr; float ebr = 0.f;
#define HG_LOAD(n) do { const int rb_ = row0 + 64 * (n); \
            _Pragma("unroll") for (int i_ = 0; i_ < 2; ++i_) { const int idx_ = tid + 512 * i_, t_ = idx_ >> 4, c_ = idx_ & 15; \
                if (t_ < L) { const size_t o_ = (size_t)(rb_ + t_) * DM_ + h * 128 + c_ * 8; qr[i_] = *(const u32x4*)(QD + o_); kir[i_] = *(const u32x4*)(KI + o_); ker[i_] = *(const u32x4*)(KE + o_); } \
                else { qr[i_] = (u32x4){0u, 0u, 0u, 0u}; kir[i_] = qr[i_]; ker[i_] = qr[i_]; } } \
            if (tid < 128) { const int t_ = tid >> 1, c_ = tid & 1; vr = t_ < L ? *(const u32x4*)(HB + (size_t)(rb_ + t_) * 4096 + 2048 + h * 128 + 16 * j + c_ * 8) : (u32x4){0u, 0u, 0u, 0u}; } \
            if (tid >= 128 && tid < 256) ebr = EB[(size_t)(ch0 + (n)) * DM_ + h * 128 + (tid - 128)]; } while (0)
        HG_LOAD(0);
        for (int n = 0; n < nsteps; ++n) {
            __syncthreads();
#pragma unroll
            for (int i = 0; i < 2; ++i) { const int idx = tid + 512 * i, t = idx >> 4, c = idx & 15; *(LAS u32x4*)(Ql + t * PQ + c * 16) = qr[i]; *(LAS u32x4*)(KIl + t * PQ + c * 16) = kir[i]; *(LAS u32x4*)(KEl + t * PQ + c * 16) = ker[i]; }
            if (tid < 128) { const int t = tid >> 1, c = tid & 1; *(LAS u32x4*)(Vl + t * PVV + c * 16) = vr; }
            if (tid >= 128 && tid < 256) EBl[tid - 128] = ebr;
            __syncthreads();
            if (n + 1 < nsteps) HG_LOAD(n + 1);
            { const int ti = w >> 1, si0 = 2 * (w & 1); f32x4 a0 = {0.f, 0.f, 0.f, 0.f}, a1 = a0;
#pragma unroll
                for (int ks = 0; ks < 4; ++ks) { const bf16x8 B = frag_row(Ql, PQ, 16 * ti, 32 * ks, lane);
                    a0 = mma32(frag_row(KIl, PQ, 16 * si0, 32 * ks, lane), B, a0); a1 = mma32(frag_row(KIl, PQ, 16 * si0 + 16, 32 * ks, lane), B, a1); }
                const int t = 16 * ti + ln;
#pragma unroll
                for (int x = 0; x < 2; ++x) { const f32x4 a = x ? a1 : a0; const int sb0 = 16 * (si0 + x) + 4 * fq; float p[4];
#pragma unroll
                    for (int i = 0; i < 4; ++i) p[i] = (t >= sb0 + i) ? a[i] : 0.f;
                    const u32x2 pw = {pkbf(p[0], p[1]), pkbf(p[2], p[3])}; *(LAS u32x2*)(Pl + t * PP + sb0 * 2) = pw; } }
            { const u32x2 sw = {pkbf(st[0], st[1]), pkbf(st[2], st[3])}; *(LAS u32x2*)(Sl + ln * PQ + (16 * w + 4 * fq) * 2) = sw; }
            __syncthreads();
            if (w < 4) { const int ti = w; f32x4 o = {0.f, 0.f, 0.f, 0.f};
#pragma unroll
                for (int ks = 0; ks < 2; ++ks) if (32 * ks <= 16 * ti + 15) o = mma32(frag_tr(Vl, PVV, 32 * ks, 0, lane), frag_row(Pl, PP, 16 * ti, 32 * ks, lane), o);
#pragma unroll
                for (int ks = 0; ks < 4; ++ks) o = mma32(frag_row(Sl, PQ, 0, 32 * ks, lane), frag_row(Ql, PQ, 16 * ti, 32 * ks, lane), o);
                const int t = 16 * ti + ln;
                if (t < L) { const u32x2 ow = {pkbf(o[0], o[1]), pkbf(o[2], o[3])}; *(u32x2*)(Oh + (size_t)(row0 + 64 * n + t) * DM_ + h * 128 + 16 * j + 4 * fq) = ow; } }
            { f32x4 a; const f32x4 e = *(const LAS f32x4*)(EBl + 16 * w + 4 * fq); a = st * e;
#pragma unroll
                for (int ks = 0; ks < 2; ++ks) a = mma32(frag_tr(KEl, PQ, 32 * ks, 16 * w, lane), frag_tr(Vl, PVV, 32 * ks, 0, lane), a);
                st = a; }
        }
#undef HG_LOAD
#pragma unroll
        for (int i = 0; i < 4; ++i) sout[(size_t)(16 * w + 4 * fq + i) * 128 + ln] = st[i];
    }
    __syncthreads();
}
__device__ __forceinline__ void hgrn_post_phase(const Ctx& C, const bf16* Oh, const bf16* HB, const float* ng, bf16* A4) {
    const int lane = C.lane, c0 = lane * 16; float g[16];
#pragma unroll
    for (int j = 0; j < 16; ++j) g[j] = ng[c0 + j];
    for (int m = C.gw; m < MT; m += C.NGW) {
        const u32x4* op = (const u32x4*)(Oh + (size_t)m * DM_ + c0); const u32x4* gp = (const u32x4*)(HB + (size_t)m * 4096 + 3072 + c0);
        const u32x4 o0 = op[0], o1 = op[1], g0 = gp[0], g1 = gp[1]; const unsigned ow[8] = {o0.x, o0.y, o0.z, o0.w, o1.x, o1.y, o1.z, o1.w}, gw8[8] = {g0.x, g0.y, g0.z, g0.w, g1.x, g1.y, g1.z, g1.w};
        float ss = 0.f;
#pragma unroll
        for (int k = 0; k < 8; ++k) { const float a = bflo(ow[k]), b = bfhi(ow[k]); ss += a * a + b * b; }
        ss += __shfl_xor(ss, 1); ss += __shfl_xor(ss, 2); ss += __shfl_xor(ss, 4);
        const float rstd = 1.0f / sqrtf(ss * (1.0f / 128.0f) + EPS_); unsigned r[8];
#pragma unroll
        for (int k = 0; k < 8; ++k) r[k] = pkbf(bflo(ow[k]) * rstd * g[2 * k] * bflo(gw8[k]), bfhi(ow[k]) * rstd * g[2 * k + 1] * bfhi(gw8[k]));
        u32x4* ap = (u32x4*)(A4 + (size_t)m * DM_ + c0); ap[0] = (u32x4){r[0], r[1], r[2], r[3]}; ap[1] = (u32x4){r[4], r[5], r[6], r[7]};
    }
}
constexpr int N_PHASES = 34;
struct Args { const float* in[29]; float* outp; unsigned char* wsp; int ph_lo, ph_hi, li, pad; };
typedef __attribute__((address_space(4))) const Args* kargs_t;
__device__ __forceinline__ kargs_t KA() { kargs_t p = (kargs_t)__builtin_amdgcn_kernarg_segment_ptr(); asm volatile("" : "+s"(p)); return p; }
__global__ void __launch_bounds__(NWAVES * 64, 2) hybrid_fwd(Args args) {
    extern __shared__ __attribute__((aligned(16))) unsigned char lds[];
    Ctx C = mk_ctx((lptr)lds);
    gu32* ctl = (gu32*)(KA()->wsp + WS_CTL);
    for (int u = C.tid; u < (LDS_BYTES - LDSCTL_OFF) / 4; u += NWAVES * 64) ((LAS unsigned*)(C.lds + LDSCTL_OFF))[u] = 0u;
    __syncthreads();
    const int lo = KA()->ph_lo, hi = KA()->ph_hi;
    XcdBarrier bar; bar.bar = (unsigned*)(ctl + CW_BAR) + KA()->li * XCD_BAR_WORDS; bar.x = 0; bar.st = nullptr;
    if (hi - lo > 1) bar = xcd_barrier_post((unsigned*)(ctl + CW_BAR) + KA()->li * XCD_BAR_WORDS, (volatile LAS unsigned*)(C.lds + MISC_OFF) + 8);
#define IN_(i) (KA()->in[i])
#define OUT_ (KA()->outp)
#define WS_ (KA()->wsp)
#define x_p IN_(0)
#define x_s IN_(1)
#define cache_k IN_(2)
#define cache_v IN_(3)
#define st_ret IN_(4)
#define st_hg IN_(5)
#define ngain IN_(10)
#define out OUT_
#define ws WS_
#define stats ((float*)(WS_ + WS_STATS))
#define mod ((float*)(WS_ + WS_MOD))
#define tab ((float*)(WS_ + WS_TAB))
#define lbw ((float*)(WS_ + WS_LB))
#define Hb ((bf16*)(WS_ + WS_H))
#define Fb ((bf16*)(WS_ + WS_F))
#define BIG ((bf16*)(WS_ + WS_BIG))
#define B2 ((bf16*)(WS_ + WS_B2))
#define B3 ((bf16*)(WS_ + WS_B3))
#define LF ((float*)(WS_ + WS_LF))
#define QD ((bf16*)(WS_ + WS_QD))
#define KI ((bf16*)(WS_ + WS_KI))
#define KE ((bf16*)(WS_ + WS_KE))
#define EB ((float*)(WS_ + WS_EB))
#define Qb BIG
#define Kb (BIG + (size_t)MT * DM_)
#define Vb (BIG + (size_t)2 * MT * DM_)
    int pid = 0;
#define PH_ON (lo <= pid && pid < hi && ((C = mk_ctx((lptr)lds)), true))
#define PH_DONE do { if (lo <= pid && pid + 1 < hi) xcd_barrier(bar); ++pid; } while (0)
#define GEMM_PHASE(EPI, Aptr, Wptr, NN, KK, Eobj) do { pg8::Gemm g_{(const pg8::bf16_t*)(Aptr), (const pg8::bf16_t*)(Wptr), MT, (NN), (KK)}; pg8::StaticOrder S_; S_.init(MT, (NN), C.G, (int)blockIdx.x); \
        pg8::gemm_phase<EPI, pg8::StaticOrder, true, true>(C.lds, g_, S_, Eobj); } while (0)

    if (PH_ON) {
        p0_adaln(C, IN_(6), IN_(7), IN_(8), IN_(9), mod);
        p0_tables(C, tab, lbw, IN_(26));
        p0_transpose(C, IN_(11), 1024, 6144, (bf16*)(ws + W_GIN), 0);
        p0_transpose(C, IN_(16), 3072, 1024, (bf16*)(ws + W_GOUT), 0);
        p0_transpose(C, IN_(17), 1024, 3072, (bf16*)(ws + W_DIN), 0);
        p0_transpose(C, IN_(20), 1024, 1024, (bf16*)(ws + W_DOUT), 0);
        p0_transpose(C, IN_(21), 1024, 6144, (bf16*)(ws + W_RIN), 0);
        p0_transpose(C, IN_(22), 2048, 1024, (bf16*)(ws + W_ROUT), 0);
        p0_transpose(C, IN_(23), 1024, 4096, (bf16*)(ws + W_HIN), 0);
        p0_transpose(C, IN_(25), 1024, 1024, (bf16*)(ws + W_HOUT), 0);
        for (int l = 0; l < 4; ++l) {
            p0_transpose(C, IN_(27) + (size_t)l * 1024 * 5632, 1024, 5632, (bf16*)(ws + W_FIN + l * FIN_STRIDE), 1);
            p0_transpose(C, IN_(28) + (size_t)l * 2816 * 1024, 2816, 1024, (bf16*)(ws + W_FOUT + l * FOUT_STRIDE), 0);
        }
    }
    PH_DONE;
    if (PH_ON) resnorm_phase<false, true>(C, x_p, x_s, nullptr, nullptr, mod, nullptr, 0, Hb, ngain, 0, 1024);
    PH_DONE;

    for (int l = 0; l < 4; ++l) {
        const int ngo = l * 4096; const int mbase = l * 36 * 6144;
        if (l == 0) {
            if (PH_ON) { EpiGelu E{BIG, stats}; GEMM_PHASE(EpiGelu, Hb, ws + W_GIN, 6144, 1024, E); }
            PH_DONE;
            if (PH_ON) gmlp_gate_phase(C, BIG, stats, IN_(12), IN_(13), IN_(14), IN_(15), B2, out + O_GV);
            PH_DONE;
        } else if (l == 1) {
            if (PH_ON) { EpiDiff E{Qb, out + O_KDP, out + O_KDS, attn_body::C2}; GEMM_PHASE(EpiDiff, Hb, ws + W_DIN, 3072, 1024, E); }
            PH_DONE;
            if (PH_ON) {
                const attn_body::AttnTensors AT{(const attn_body::bf16*)Qb, (const attn_body::bf16*)Kb, (const attn_body::bf16*)Vb, (attn_body::bf16*)B2};
                const attn_body::StaticOrder S((int)C.G, (int)blockIdx.x);
                attn_body::attn_phase<attn_body::StaticOrder>((char*)lds, AT, S);
                __syncthreads();
                diff_sample_phase(C, Qb, cache_k, cache_v, out + O_KDS, out + O_VDS, IN_(18), IN_(19), B3);
            }
            PH_DONE;
            if (PH_ON) diff_combine_phase(C, B2, IN_(18), IN_(19), B3);
            PH_DONE;
        } else if (l == 2) {
            if (PH_ON) { EpiRet E{BIG, tab}; GEMM_PHASE(EpiRet, Hb, ws + W_RIN, 6144, 1024, E); }
            PH_DONE;
            if (PH_ON) ret_scan_phase(C, BIG, st_ret, B2, out + O_RSP, out + O_RSS);
            PH_DONE;
            if (PH_ON) ret_post_phase(C, B2, BIG, B3);
            PH_DONE;
        } else {
            if (PH_ON) { EpiHgrn E{BIG, LF, lbw}; GEMM_PHASE(EpiHgrn, Hb, ws + W_HIN, 4096, 1024, E); }
            PH_DONE;
            if (PH_ON) hgrn_prep_phase(C, BIG, LF, QD, KI, KE, EB);
            PH_DONE;
            if (PH_ON) hgrn_scan_phase(C, QD, KI, KE, BIG, EB, st_hg, B2, out + O_HSP, out + O_HSS);
            PH_DONE;
            if (PH_ON) hgrn_post_phase(C, B2, BIG, IN_(24), B3);
            PH_DONE;
        }
        if (PH_ON) { const bf16* Am = l == 0 ? B2 : B3; const size_t wo = l == 0 ? W_GOUT : (l == 1 ? W_DOUT : (l == 2 ? W_ROUT : W_HOUT)); const int Km = l == 0 ? 3072 : (l == 2 ? 2048 : 1024);
            EpiPlain E{Fb, DM_}; GEMM_PHASE(EpiPlain, Am, ws + wo, 1024, Km, E); }
        PH_DONE;
        if (PH_ON) resnorm_phase<true, true>(C, l == 0 ? x_p : out + O_YP, l == 0 ? x_s : out + O_YS, Fb, out, mod, ngain + ngo + 1024, mbase + 2 * 1024, Hb, ngain + ngo + 2048, mbase + 3 * 1024, mbase + 4 * 1024);
        PH_DONE;
        if (PH_ON) { EpiSwiglu E{B2}; GEMM_PHASE(EpiSwiglu, Hb, ws + W_FIN + l * FIN_STRIDE, 5632, 1024, E); }
        PH_DONE;
        if (PH_ON) { EpiPlain E{Fb, DM_}; GEMM_PHASE(EpiPlain, B2, ws + W_FOUT + l * FOUT_STRIDE, 1024, FFH, E); }
        PH_DONE;
        if (l < 3) { if (PH_ON) resnorm_phase<true, true>(C, out + O_YP, out + O_YS, Fb, out, mod, ngain + ngo + 3072, mbase + 5 * 1024, Hb, ngain + ngo + 4096, mbase + 36 * 6144, mbase + 36 * 6144 + 1024); }
        else { if (PH_ON) resnorm_phase<true, false>(C, out + O_YP, out + O_YS, Fb, out, mod, ngain + ngo + 3072, mbase + 5 * 1024, nullptr, nullptr, 0, 0); }
        PH_DONE;
    }
#undef PH_ON
#undef PH_DONE
#undef GEMM_PHASE
#undef x_p
#undef x_s
#undef cache_k
#undef cache_v
#undef st_ret
#undef st_hg
#undef ngain
#undef out
#undef ws
#undef stats
#undef mod
#undef tab
#undef lbw
#undef Hb
#undef Fb
#undef BIG
#undef B2
#undef B3
#undef LF
#undef QD
#undef KI
#undef KE
#undef EB
#undef Qb
#undef Kb
#undef Vb
}

#ifndef MK_SPLIT
#define MK_SPLIT 1
#endif
extern "C" void kernel_launch(void* const* d_in, const int* in_sizes, int n_in, void* d_out, int out_size, void* d_ws, size_t ws_size, hipStream_t stream) {
    static int grid = 0;
    if (grid == 0) {
        if (n_in != 29 || (size_t)out_size != O_END || ws_size < WS_END) { fprintf(stderr, "kernel_launch: unexpected shapes (n_in %d out %d ws %zu); nothing launched\n", n_in, out_size, ws_size); grid = -1; return; }
        int dev = 0, cus = 0, per_cu = 0;
        if (hipGetDevice(&dev) != hipSuccess || hipDeviceGetAttribute(&cus, hipDeviceAttributeMultiprocessorCount, dev) != hipSuccess) { grid = -1; return; }
        if (hipFuncSetAttribute((const void*)hybrid_fwd, hipFuncAttributeMaxDynamicSharedMemorySize, LDS_BYTES) != hipSuccess) { fprintf(stderr, "kernel_launch: hipFuncSetAttribute failed\n"); grid = -1; return; }
        if (hipOccupancyMaxActiveBlocksPerMultiprocessor(&per_cu, (const void*)hybrid_fwd, NWAVES * 64, LDS_BYTES) != hipSuccess || per_cu < 1) { fprintf(stderr, "kernel_launch: occupancy query reports %d blocks per CU\n", per_cu); }
        (void)hipGetLastError();
        grid = cus;
        if (grid != 256) { fprintf(stderr, "kernel_launch: built for 256 CUs, device has %d; nothing launched\n", cus); grid = -1; return; }
    }
    if (grid < 0) return;
    if (hipMemsetAsync((char*)d_ws + WS_CTL, 0, CTL_ZERO_BYTES, stream) != hipSuccess) return;
    Args a{};
    for (int i = 0; i < 29; ++i) a.in[i] = (const float*)d_in[i];
    a.outp = (float*)d_out; a.wsp = (unsigned char*)d_ws; a.pad = 0;
#if MK_SPLIT
    for (int p = 0; p < N_PHASES; ++p) { a.ph_lo = p; a.ph_hi = p + 1; a.li = 0; hipLaunchKernelGGL(hybrid_fwd, dim3(grid), dim3(NWAVES * 64), LDS_BYTES, stream, a); }
#else
    a.ph_lo = 0; a.ph_hi = N_PHASES; a.li = 0;
    hipLaunchKernelGGL(hybrid_fwd, dim3(grid), dim3(NWAVES * 64), LDS_BYTES, stream, a);
#endif
}
```

```cpp
#include <hip/hip_runtime.h>
#include <cstdio>
#include <cstdint>
__device__ __forceinline__ int fresh_tid(int wave_sgpr) { int w = wave_sgpr; asm volatile("" : "+s"(w)); int l; asm volatile("v_mbcnt_lo_u32_b32 %0, -1, 0\n\tv_mbcnt_hi_u32_b32 %0, -1, %0" : "=v"(l)); return w * 64 + l; }
namespace pg8 {
#define PG8_LAS __attribute__((address_space(3)))
typedef unsigned short bf16_t;
typedef short bf16x8 __attribute__((ext_vector_type(8)));
typedef float f32x4 __attribute__((ext_vector_type(4)));
typedef unsigned u32x4 __attribute__((ext_vector_type(4)));
constexpr int BM = 256, BK = 64, HALF = 128, HTB = HALF * BK * 2  , STAGE_BYTES = 8 * HTB, NXCD = 8, WGM = 8;

__host__ __device__ __forceinline__ int lds_byte(int r, int c) { const int st = (r >> 4) * 2 + (c >> 5), rr = r & 15, cc = c & 31, ob = rr * 64 + cc * 2; return st * 1024 + (ob ^ (((ob >> 9) & 1) << 5)); }
__host__ __device__ __forceinline__ void stage_rc(int b, int& R, int& C) { const int st = b / 1024, sb = b % 1024, swz = sb ^ (((sb >> 9) & 1) << 5); R = (st >> 1) * 16 + swz / 64; C = (st & 1) * 32 + (swz % 64) / 2; }
__host__ __device__ __forceinline__ int perm32(int rho) { const int n = rho >> 4, i = rho & 15; return 8 * (i >> 2) + 4 * n + (i & 3); }

struct Unit { int pm, pn, kb, nt; };
struct Gemm { const bf16_t* A; const bf16_t* Bt; int M, N, K, nt; };

struct StaticOrder {
    int nM, nN, nwg, G, c;
    __host__ __device__ void init(int M, int N, int G_, int c_) { nM = M / BM; nN = N / BM; nwg = nM * nN; G = G_; c = c_; }
    __host__ __device__ bool next(int i, Unit& u) const {
        const long L = (long)i * G + c; if (L >= nwg) return false;
        int wgid = (int)L; { const int q = nwg / NXCD, r = nwg % NXCD, xcd = wgid % NXCD, off = wgid / NXCD; wgid = (xcd < r ? xcd * (q + 1) : r * (q + 1) + (xcd - r) * q) + off; }
        const int nig = WGM * nN, gid = wgid / nig, fm = gid * WGM, gsz = (nM - fm) < WGM ? (nM - fm) : WGM;
        u.pm = fm + ((wgid % nig) % gsz); u.pn = (wgid % nig) / gsz; u.kb = 0; u.nt = 0; return true;
    }
    __device__ __forceinline__ void a_ready(const Unit&) const {}
    __device__ __forceinline__ void done(const Unit&) const {}
};

typedef float f32x2c_t __attribute__((ext_vector_type(2))); typedef __bf16 bf16x2c_t __attribute__((ext_vector_type(2)));
__device__ __forceinline__ unsigned cvt_pk_bf16(float lo, float hi) { const f32x2c_t v = {lo, hi}; const bf16x2c_t b = __builtin_convertvector(v, bf16x2c_t); return __builtin_bit_cast(unsigned, b); }
typedef float f32x2 __attribute__((ext_vector_type(2)));
__device__ __forceinline__ f32x2 gelu_pk(f32x2 v) {
    const f32x2 av = __builtin_elementwise_abs(v), d = av * 0.2316418882f + 1.0f;
    f32x2 t; t.x = __builtin_amdgcn_rcpf(d.x); t.y = __builtin_amdgcn_rcpf(d.y);
    f32x2 q = t * 0.5307027145f + (-0.7265760135f); q = q * t + 0.7107068705f; q = q * t + (-0.142248368f); q = q * t + 0.127414796f; q = q * t;
    const f32x2 s = (v * v) * (-0.72134752044f);
    f32x2 e; e.x = __builtin_amdgcn_exp2f(s.x); e.y = __builtin_amdgcn_exp2f(s.y);
    const f32x2 m = v * (q * e), r = v - m;
    f32x2 o; o.x = v.x < 0.f ? m.x : r.x; o.y = v.y < 0.f ? m.y : r.y; return o;
}
template <class Epi, class Sched, bool ALIGN_EPI = false, bool SP2 = false>
__device__ __forceinline__ void gemm_phase(PG8_LAS unsigned char* lds, const Gemm g, const Sched& S, const Epi& E, const int tid_in) {
    const int tid = tid_in, wid = __builtin_amdgcn_readfirstlane(tid >> 6), lane = tid & 63, wr = wid >> 2, wc = wid & 3, fr = lane & 15, fq = lane >> 4;
    const int K = g.K, nt = g.nt;
    unsigned voffA[2], voffB[2];
#pragma unroll
    for (int i = 0; i < 2; ++i) { int R, C; stage_rc(tid * 16 + i * 8192, R, C); const int Rb = Epi::PERM ? ((R & ~31) + perm32(R & 31)) : R;
        voffA[i] = (unsigned)(R * K + C) * 2u; voffB[i] = (unsigned)(Rb * K + C) * 2u; }
    const size_t kstep = (size_t)(BK * 2);
    const size_t hstep = (size_t)HALF * K * 2;
    const size_t tstep = 2 * hstep;
    const unsigned ldsw = (unsigned)wid * 1024u;
    const int aoff = lds_byte(wr * 64 + fr, fq * 8), boff = lds_byte(wc * 32 + fr, fq * 8);
#define PG8_SA(b, h) (((b) * 2 + (h)) * HTB)
#define PG8_SB(b, h) ((4 + (b) * 2 + (h)) * HTB)
#define PG8_STAGE(bufoff, gbase, voff) do { _Pragma("unroll") for (int _i = 0; _i < 2; ++_i) \
        __builtin_amdgcn_global_load_lds((const unsigned*)((const char*)(gbase) + (voff)[_i]), (PG8_LAS unsigned*)(lds + (bufoff) + ldsw + _i * 8192), 16, 0, 0); } while (0)
#define PG8_LDA(dst, b, h) do { _Pragma("unroll") for (int m = 0; m < 4; ++m) _Pragma("unroll") for (int k = 0; k < 2; ++k) dst[m][k] = *(const PG8_LAS bf16x8*)(lds + PG8_SA(b, h) + aoff + m * 2048 + k * 1024); } while (0)
#define PG8_LDB(dst, b, h) do { _Pragma("unroll") for (int n = 0; n < 2; ++n) _Pragma("unroll") for (int k = 0; k < 2; ++k) dst[n][k] = *(const PG8_LAS bf16x8*)(lds + PG8_SB(b, h) + boff + n * 2048 + k * 1024); } while (0)
#define PG8_MMA(ai, bj, At, Bt) do { __builtin_amdgcn_s_setprio(1); _Pragma("unroll") for (int m = 0; m < 4; ++m) _Pragma("unroll") for (int n = 0; n < 2; ++n) _Pragma("unroll") for (int k = 0; k < 2; ++k) \
        acc[ai][bj][m][n] = __builtin_amdgcn_mfma_f32_16x16x32_bf16(Bt[n][k], At[m][k], acc[ai][bj][m][n], 0, 0, 0); __builtin_amdgcn_s_setprio(0); } while (0)
#define PG8_WAIT_V(n) asm volatile("s_waitcnt vmcnt(" #n ")" ::: "memory")
#define PG8_WAIT_L(n) asm volatile("s_waitcnt lgkmcnt(" #n ")" ::: "memory")
#define PG8_BAR __builtin_amdgcn_s_barrier()
#define PG8_SCHED __builtin_amdgcn_sched_barrier(0)
    Unit cur, nxt; int ui = 0;
    if (!S.next(0, cur)) return;
    f32x4 acc[2][2][4][2];
#pragma unroll
    for (int a = 0; a < 2; ++a)
#pragma unroll
        for (int b = 0; b < 2; ++b)
#pragma unroll
            for (int m = 0; m < 4; ++m)
#pragma unroll
                for (int n = 0; n < 2; ++n) acc[a][b][m][n] = (f32x4){0.f, 0.f, 0.f, 0.f};
    bf16x8 At[4][2], B0[2][2], B1[2][2];
    const char* cA = (const char*)g.A + (size_t)cur.pm * tstep + cur.kb; const char* cB = (const char*)g.Bt + (size_t)cur.pn * tstep + cur.kb;
    S.a_ready(cur);
    if constexpr (SP2) {
        PG8_STAGE(PG8_SB(0, 0), cB, voffB); PG8_STAGE(PG8_SB(0, 1), cB + hstep, voffB); PG8_STAGE(PG8_SA(0, 0), cA, voffA); PG8_STAGE(PG8_SA(0, 1), cA + hstep, voffA);
        if (wr == 1) PG8_BAR;
        PG8_WAIT_V(2); PG8_BAR;
        PG8_STAGE(PG8_SB(1, 0), cB + kstep, voffB); PG8_STAGE(PG8_SA(1, 0), cA + kstep, voffA); PG8_STAGE(PG8_SB(1, 1), cB + hstep + kstep, voffB);
        PG8_WAIT_V(6); PG8_BAR;
    } else {
        PG8_STAGE(PG8_SB(0, 0), cB, voffB); PG8_STAGE(PG8_SA(0, 0), cA, voffA); PG8_STAGE(PG8_SB(0, 1), cB + hstep, voffB); PG8_STAGE(PG8_SA(0, 1), cA + hstep, voffA);
        if (wr == 1) PG8_BAR;
        PG8_WAIT_V(4); PG8_BAR;
        PG8_STAGE(PG8_SB(1, 0), cB + kstep, voffB); PG8_STAGE(PG8_SA(1, 0), cA + kstep, voffA); PG8_STAGE(PG8_SB(1, 1), cB + hstep + kstep, voffB);
        PG8_WAIT_V(6); PG8_BAR;
    }
    for (;;) {
        const bool has_next = S.next(ui + 1, nxt);
        const char* nA = has_next ? (const char*)g.A + (size_t)nxt.pm * tstep + nxt.kb : cA; const char* nB = has_next ? (const char*)g.Bt + (size_t)nxt.pn * tstep + nxt.kb : cB;
        const int ntu = cur.nt ? cur.nt : nt;
        for (int t = 0; t < ntu; t += 2) {
            const bool last = (t == ntu - 2);
            const char* a1 = cA + (size_t)(t + 1) * kstep;
            const char* a2 = last ? nA : cA + (size_t)(t + 2) * kstep; const char* b2 = last ? nB : cB + (size_t)(t + 2) * kstep;
            const char* a3 = a2 + kstep; const char* b3 = b2 + kstep;
            if (last && has_next) S.a_ready(nxt);
            if constexpr (SP2) {
            PG8_LDB(B0, 0, 0); PG8_LDB(B1, 0, 1); PG8_SCHED; PG8_LDA(At, 0, 0); PG8_STAGE(PG8_SA(1, 1), a1 + hstep, voffA);
            PG8_WAIT_V(8); PG8_WAIT_L(0); PG8_BAR; PG8_MMA(0, 0, At, B0); PG8_MMA(0, 1, At, B1); PG8_BAR; PG8_SCHED;
            PG8_LDA(At, 0, 1); PG8_STAGE(PG8_SB(0, 0), b2, voffB); PG8_STAGE(PG8_SB(0, 1), b2 + hstep, voffB); PG8_STAGE(PG8_SA(0, 0), a2, voffA);
            PG8_WAIT_V(8); PG8_WAIT_L(0); PG8_BAR; PG8_MMA(1, 0, At, B0); PG8_MMA(1, 1, At, B1); PG8_BAR; PG8_SCHED;
            PG8_LDB(B0, 1, 0); PG8_LDB(B1, 1, 1); PG8_SCHED; PG8_LDA(At, 1, 0); PG8_STAGE(PG8_SA(0, 1), a2 + hstep, voffA);
            PG8_WAIT_V(8); PG8_WAIT_L(0); PG8_BAR; PG8_MMA(0, 0, At, B0); PG8_MMA(0, 1, At, B1); PG8_BAR; PG8_SCHED;
            PG8_LDA(At, 1, 1); PG8_STAGE(PG8_SB(1, 0), b3, voffB); PG8_STAGE(PG8_SB(1, 1), b3 + hstep, voffB); PG8_STAGE(PG8_SA(1, 0), a3, voffA);
            PG8_WAIT_V(8); PG8_WAIT_L(0); PG8_BAR; PG8_MMA(1, 0, At, B0); PG8_MMA(1, 1, At, B1); PG8_BAR; PG8_SCHED;
            } else {
            PG8_LDB(B0, 0, 0); PG8_SCHED; PG8_LDA(At, 0, 0); PG8_STAGE(PG8_SA(1, 1), a1 + hstep, voffA);
            PG8_WAIT_L(8); PG8_BAR; PG8_WAIT_L(0); PG8_MMA(0, 0, At, B0); PG8_BAR; PG8_SCHED;
            PG8_LDB(B1, 0, 1); PG8_STAGE(PG8_SB(0, 0), b2, voffB);
            PG8_BAR; PG8_WAIT_L(0); PG8_MMA(0, 1, At, B1); PG8_BAR;
            PG8_LDA(At, 0, 1); PG8_STAGE(PG8_SA(0, 0), a2, voffA);
            PG8_BAR; PG8_WAIT_L(0); PG8_MMA(1, 0, At, B0); PG8_BAR; PG8_SCHED;
            PG8_STAGE(PG8_SB(0, 1), b2 + hstep, voffB);
            PG8_WAIT_V(6); PG8_BAR; PG8_MMA(1, 1, At, B1); PG8_BAR;
            PG8_LDB(B0, 1, 0); PG8_SCHED; PG8_LDA(At, 1, 0); PG8_STAGE(PG8_SA(0, 1), a2 + hstep, voffA);
            PG8_WAIT_L(8); PG8_BAR; PG8_WAIT_L(0); PG8_MMA(0, 0, At, B0); PG8_BAR; PG8_SCHED;
            PG8_LDB(B1, 1, 1); PG8_STAGE(PG8_SB(1, 0), b3, voffB);
            PG8_BAR; PG8_WAIT_L(0); PG8_MMA(0, 1, At, B1); PG8_BAR;
            PG8_LDA(At, 1, 1); PG8_STAGE(PG8_SA(1, 0), a3, voffA);
            PG8_BAR; PG8_WAIT_L(0); PG8_MMA(1, 0, At, B0); PG8_BAR; PG8_SCHED;
            PG8_STAGE(PG8_SB(1, 1), b3 + hstep, voffB);
            PG8_WAIT_V(6); PG8_BAR; PG8_MMA(1, 1, At, B1); PG8_BAR;
            }
        }
        if constexpr (ALIGN_EPI) { if (wr == 0) PG8_BAR; }
        if constexpr (!Epi::AFTER_DRAIN) { E(acc, cur, wr, wc, fr, fq); S.done(cur); }
        if (!has_next) break;
#pragma unroll
        for (int a = 0; a < 2; ++a)
#pragma unroll
            for (int b = 0; b < 2; ++b)
#pragma unroll
                for (int m = 0; m < 4; ++m)
#pragma unroll
                    for (int n = 0; n < 2; ++n) acc[a][b][m][n] = (f32x4){0.f, 0.f, 0.f, 0.f};
        cur = nxt; cA = nA; cB = nB; ++ui;
        if constexpr (ALIGN_EPI) { if (wr == 1) PG8_BAR; }
    }
    PG8_WAIT_V(0);
    if constexpr (!ALIGN_EPI) { if (wr == 0) PG8_BAR; }
    PG8_BAR;
    if constexpr (Epi::AFTER_DRAIN) { E.fused(acc, cur, wr, wc, fr, fq, lds, wid, lane); S.done(cur); }
#undef PG8_SA
#undef PG8_SB
#undef PG8_STAGE
#undef PG8_LDA
#undef PG8_LDB
#undef PG8_MMA
#undef PG8_WAIT_V
#undef PG8_WAIT_L
#undef PG8_BAR
#undef PG8_SCHED
}
}
#include <hip/hip_bf16.h>
#include <cmath>
namespace attn_body {
using bf16=__hip_bfloat16;
using bf16x8=__attribute__((ext_vector_type(8)))short;
using s16x4=__attribute__((ext_vector_type(4)))short;
using f32x16=__attribute__((ext_vector_type(16)))float;
using u32x4=__attribute__((ext_vector_type(4)))unsigned;
constexpr int BATCH=4,NVH=32,SEQ=8192,D=64,DM=1024,OPITCH=2048;
constexpr int NW=8,QBLK=32,QB=QBLK*NW,KVBLK=64,NQB=SEQ/QB;
constexpr int ATTN_PITCH=DM, ATTN_UNIT_ROWS=QB;
__device__ __forceinline__ int crow(int r,int hi){return (r&3)+8*(r>>2)+4*hi;}
#define SBAR() __builtin_amdgcn_sched_barrier(0)
__device__ __forceinline__ void cmask(f32x16&p0,f32x16&p1,int jb,int qrel,int hi){
  const float NEG=-INFINITY; (void)hi;
  if(jb>(qrel>>6)){
  #pragma unroll
  for(int r=0;r<16;++r){p0[r]=NEG;p1[r]=NEG;}}
}


constexpr int NSLOT=3, SLOTB=8192, SLOTV=16384;
constexpr int LDS_K=0, LDS_V=NSLOT*SLOTB, LDS_WS=LDS_V+NSLOT*SLOTV, LDS_OST=LDS_WS+NW*64*4, LDS_BYTES=LDS_OST+NW*4096;
constexpr float C2=0.125f*1.4426950408889634f;
__device__ __forceinline__ void glds16(const void*gsrc,unsigned lds_dst){unsigned keep;
  asm volatile("s_mov_b32 %0, m0\n\ts_mov_b32 m0, %2\n\ts_nop 0\n\tglobal_load_lds_dwordx4 %1, off\n\ts_mov_b32 m0, %0":"=&s"(keep):"v"(gsrc),"s"(lds_dst):"memory");}
__device__ __forceinline__ float max3f(float a,float b,float c){float r;asm("v_max3_f32 %0, %1, %2, %3":"=v"(r):"v"(a),"v"(b),"v"(c));return r;}
__device__ __forceinline__ float max2f(float a,float b){float r;asm("v_max_f32_e32 %0, %1, %2":"=v"(r):"v"(a),"v"(b));return r;}
__device__ __forceinline__ float fadd_s(float a,float b){float r;asm("v_add_f32_e32 %0, %1, %2":"=v"(r):"v"(a),"v"(b));return r;}
__device__ __forceinline__ float fsub_s(float a,float b){float r;asm("v_sub_f32_e32 %0, %1, %2":"=v"(r):"v"(a),"v"(b));return r;}
typedef float f32x2_t __attribute__((ext_vector_type(2))); typedef __bf16 bf16x2_t __attribute__((ext_vector_type(2)));
__device__ __forceinline__ unsigned cvtpk_s(float lo,float hi){f32x2_t v={lo,hi};bf16x2_t b=__builtin_convertvector(v,bf16x2_t);return __builtin_bit_cast(unsigned,b);}
#define WAIT_BAR(N) asm volatile("s_waitcnt vmcnt(" #N ") lgkmcnt(0)\n\ts_barrier":::"memory")

__device__ __forceinline__ void qkt(f32x16&p0,f32x16&p1,const char*Kslot,const bf16x8*qr,const f32x16&negm,int r32,int hi){
  const char*kb=Kslot+hi*1024+r32*16;
  #pragma unroll
  for(int d0=0;d0<4;++d0){
    const bf16x8 b0=*reinterpret_cast<const bf16x8*>(kb+d0*2048);
    const bf16x8 b1=*reinterpret_cast<const bf16x8*>(kb+d0*2048+512);
    if(d0==0){p0=__builtin_amdgcn_mfma_f32_32x32x16_bf16(b0,qr[0],negm,0,0,0);p1=__builtin_amdgcn_mfma_f32_32x32x16_bf16(b1,qr[0],negm,0,0,0);}
    else{p0=__builtin_amdgcn_mfma_f32_32x32x16_bf16(b0,qr[d0],p0,0,0,0);p1=__builtin_amdgcn_mfma_f32_32x32x16_bf16(b1,qr[d0],p1,0,0,0);}}
}
typedef __attribute__((address_space(3))) const char* lds_cptr;
typedef short v4i16_t __attribute__((ext_vector_type(4)));
__device__ __forceinline__ void kload8(bf16x8*kf,lds_cptr kp){
  kf[0]=*(const __attribute__((address_space(3))) bf16x8*)(kp);      kf[1]=*(const __attribute__((address_space(3))) bf16x8*)(kp+512);
  kf[2]=*(const __attribute__((address_space(3))) bf16x8*)(kp+2048); kf[3]=*(const __attribute__((address_space(3))) bf16x8*)(kp+2560);
  kf[4]=*(const __attribute__((address_space(3))) bf16x8*)(kp+4096); kf[5]=*(const __attribute__((address_space(3))) bf16x8*)(kp+4608);
  kf[6]=*(const __attribute__((address_space(3))) bf16x8*)(kp+6144); kf[7]=*(const __attribute__((address_space(3))) bf16x8*)(kp+6656);
}
__device__ __forceinline__ void kload2(bf16x8*kf,lds_cptr kp,int j){ kf[2*j]=*(const __attribute__((address_space(3))) bf16x8*)(kp+j*2048); kf[2*j+1]=*(const __attribute__((address_space(3))) bf16x8*)(kp+j*2048+512); }
__device__ __forceinline__ s16x4 vtr(lds_cptr p){ return __builtin_bit_cast(s16x4,__builtin_amdgcn_ds_read_tr16_b64_v4i16((__attribute__((address_space(3))) v4i16_t*)p)); }
__device__ __forceinline__ float rowmax(const f32x16&p0,const f32x16&p1){
  float a=max3f(p0[0],p0[1],p1[0]),b=max3f(p0[2],p0[3],p1[1]);a=max3f(a,p1[2],p1[3]);
  #pragma unroll
  for(int r=4;r<16;r+=4){a=max3f(a,p0[r],p0[r+1]);b=max3f(b,p0[r+2],p0[r+3]);a=max3f(a,p1[r],p1[r+1]);b=max3f(b,p1[r+2],p1[r+3]);}
  const float m=max2f(a,b);
  auto rr=__builtin_amdgcn_permlane32_swap(__float_as_uint(m),__float_as_uint(m),false,false);
  return max2f(__uint_as_float(rr[0]),__uint_as_float(rr[1]));
}
__device__ __forceinline__ void pv(f32x16*o,int vb,bf16x8 pa0,bf16x8 pa1,bf16x8 pa2,bf16x8 pa3){
  #pragma unroll
  for(int d0=0;d0<4;++d0){s16x4 lo[4],hi[4];
    #pragma unroll
    for(int ks=0;ks<4;++ks){
      asm volatile("ds_read_b64_tr_b16 %0,%1 offset:%c2":"=&v"(lo[ks]):"v"(vb),"i"(d0*4096+ks*1024):"memory");
      asm volatile("ds_read_b64_tr_b16 %0,%1 offset:%c2":"=&v"(hi[ks]):"v"(vb),"i"(d0*4096+ks*1024+512):"memory");}
    asm volatile("s_waitcnt lgkmcnt(0)":::"memory");SBAR();
    #define PK(k) (bf16x8){lo[k][0],lo[k][1],lo[k][2],lo[k][3],hi[k][0],hi[k][1],hi[k][2],hi[k][3]}
    o[d0]=__builtin_amdgcn_mfma_f32_32x32x16_bf16(pa0,PK(0),o[d0],0,0,0);
    o[d0]=__builtin_amdgcn_mfma_f32_32x32x16_bf16(pa1,PK(1),o[d0],0,0,0);
    o[d0]=__builtin_amdgcn_mfma_f32_32x32x16_bf16(pa2,PK(2),o[d0],0,0,0);
    o[d0]=__builtin_amdgcn_mfma_f32_32x32x16_bf16(pa3,PK(3),o[d0],0,0,0);
    #undef PK
  }
}

#ifndef ATTN_STORE16
#define ATTN_STORE16(p,v) (*(u32x4*)(p)=(v))
#endif
template<int THRL> __device__ __forceinline__ void attn_unit(int b,int qoff,int koff,int voff,int ooff,int qb,const bf16*Q,const bf16*__restrict__ K,const bf16*__restrict__ V,bf16*O,char*shm,const int tid_in,const int mode,bf16*A2,const int a2off,const float lam,const float*__restrict__ subln){
  const int tid=tid_in,lane=tid&63,r32=lane&31,hi=lane>>5; const int wid=__builtin_amdgcn_readfirstlane(tid>>6);
  const long rowbase=(long)b*SEQ; const int q0=qb*QB;
  const bf16*Qw=Q+(rowbase+q0+wid*QBLK)*DM+qoff;
  const bf16*Kh=K+rowbase*DM+koff,*Vh=V+rowbase*DM+voff;
  const unsigned lds0=(unsigned)(uintptr_t)shm;
  float*wsf=(float*)(shm+LDS_WS)+wid*64;
  const bf16*ksrc=Kh+(long)lane*DM+wid*8;
  const bf16*vsrc=Vh+(long)(16*(wid&3)+(lane>>2))*DM+(wid>>2)*32+(lane&3)*8;
  const unsigned kdst=lds0+LDS_K+wid*1024, vdst=lds0+LDS_V+wid*1024;
  #define DMA_K(t,slot) glds16(ksrc+(long)(t)*KVBLK*DM,(unsigned)__builtin_amdgcn_readfirstlane(kdst+(slot)))
  #define DMA_V(t,slot) do{ glds16(vsrc+(long)(t)*KVBLK*DM,(unsigned)__builtin_amdgcn_readfirstlane(vdst+(slot))); glds16(vsrc+(long)(t)*KVBLK*DM+64,(unsigned)__builtin_amdgcn_readfirstlane(vdst+(slot)+8192)); }while(0)
  const int vb0=(int)(lds0+LDS_V)+((lane>>4)&1)*32+(lane&3)*8+(4*hi+((lane&15)>>2))*64;
  const char*Kbase=shm+LDS_K; bf16x8 kf[8];
  const lds_cptr shm3=(lds_cptr)shm; const lds_cptr kp0=shm3+LDS_K+hi*1024+r32*16; const lds_cptr vp0=shm3+LDS_V+((lane>>4)&1)*32+(lane&3)*8+(4*hi+((lane&15)>>2))*64;
  const int NT=(q0+QB)/KVBLK;
  DMA_K(0,0);DMA_V(0,0);DMA_K(1,SLOTB);
  bf16x8 qr[4];
  #pragma unroll
  for(int d0=0;d0<4;++d0)qr[d0]=*reinterpret_cast<const bf16x8*>(&Qw[(long)r32*DM+d0*16+hi*8]);
  float mhat=0.f,l_reg=0.f;f32x16 o[4];o[0]=f32x16{};o[1]=f32x16{};o[2]=f32x16{};o[3]=f32x16{};f32x16 negm=f32x16{};asm volatile("":"+v"(negm));
  const int qrel=wid*QBLK+r32;
  #define CMASK(P0,P1,t) do{int jb_=(t)-(NT-4); if(jb_>=0)cmask(P0,P1,jb_,qrel,hi);}while(0)
  bool resc=false;
  #define START(P0,P1) do{ const float rm=rowmax(P0,P1); resc=false; \
    { const float dl=rm; mhat=fadd_s(mhat,dl); \
      _Pragma("unroll") for(int r=0;r<16;++r){P0[r]=fsub_s(P0[r],dl);P1[r]=fsub_s(P1[r],dl);} \
      _Pragma("unroll") for(int r=0;r<16;++r)negm[r]=-mhat; asm volatile("":"+v"(negm)); } \
    _Pragma("unroll") for(int r=0;r<16;++r)P0[r]=__builtin_amdgcn_exp2f(P0[r]); }while(0)
  #define RESC() do{ if(resc){ asm volatile("s_waitcnt lgkmcnt(0)":::"memory"); \
      _Pragma("unroll") for(int d_=0;d_<4;++d_) _Pragma("unroll") for(int r=0;r<16;++r)o[d_][r]*=wsf[crow(r,hi)]; } }while(0)
  f32x16 pA0,pA1,pB0,pB1;
  int sl_prev=0,sl_cur=0,sl_next=SLOTB;
  #define ROT() do{sl_prev=sl_cur;sl_cur=sl_next;sl_next=(sl_next==(NSLOT-1)*SLOTB)?0:sl_next+SLOTB;}while(0)
  DMA_K(2,2*SLOTB);
  WAIT_BAR(3);
  qkt(pA0,pA1,Kbase,qr,negm,r32,hi);asm volatile("s_nop 15\n\ts_nop 7":"+v"(pA0),"+v"(pA1));CMASK(pA0,pA1,0);
  START(pA0,pA1);
  _Pragma("unroll") for(int r=0;r<16;++r)pA1[r]=__builtin_amdgcn_exp2f(pA1[r]);
  WAIT_BAR(0);
  DMA_K(3,0);DMA_V(1,SLOTV);
  ROT();
  kload8(kf,kp0+sl_cur);
  WAIT_BAR(3);
  s16x4 vlo[8],vhi[8]; u32x4 pw0,pw1,pw2,pw3;
  #define PKW(P,B) cvtpk_s(P[B],P[B+1])
  #define PAF(k) __builtin_bit_cast(bf16x8,pw##k)
  #define VFR(i) (bf16x8){vlo[i][0],vlo[i][1],vlo[i][2],vlo[i][3],vhi[i][0],vhi[i][1],vhi[i][2],vhi[i][3]}
  #define PIN(x) asm volatile("":"+v"(x))
  #define MX3(a,b,c) __builtin_fmaxf(__builtin_fmaxf((a),(b)),(c))
  #define GAPA(MF,A0,A1,A2,A3,W0,W1,PW) do{ MF; sacc+=A0; sacc+=A1; sacc+=A2; sacc+=A3; PIN(sacc); W0; W1; PIN(PW); SBAR(); }while(0)
  #define EX(v) __builtin_amdgcn_exp2f(v)
  #define GAPB(MF,X,B) do{ MF; X[B]=EX(X[B]); X[B+1]=EX(X[B+1]); X[B+2]=EX(X[B+2]); X[B+3]=EX(X[B+3]); PIN(X); SBAR(); }while(0)
  #define VRD(i) do{ vlo[i]=vtr(vp_+(((i)>>2)*4096+((i)&3)*1024)); vhi[i]=vtr(vp_+(((i)>>2)*4096+((i)&3)*1024+512)); }while(0)
  #define VRD2(i) do{ vlo[i]=vtr(vp_+(8192+((i)>>2)*4096+((i)&3)*1024)); vhi[i]=vtr(vp_+(8192+((i)>>2)*4096+((i)&3)*1024+512)); }while(0)
  #define GAPB2(MF,X,B) do{ MF; X[B]=EX(X[B]); X[B+1]=EX(X[B+1]); PIN(X); SBAR(); }while(0)
  #define KRD(G,j) do{ if(G){ kload2(kf,kp0+sl_next,j); SBAR(); } }while(0)
  #define STEP(C0,C1,P0,P1,t,GK,GV,GL) do{ SBAR(); \
    const lds_cptr vp_=vp0+2*sl_prev; \
    VRD(0); SBAR(); float sacc=(P0[0]+P0[1]); \
    GAPA(C0=__builtin_amdgcn_mfma_f32_32x32x16_bf16(kf[0],qr[0],negm,0,0,0), P0[2],P0[3],P0[4],P0[5],     pw0[0]=PKW(P0,0), pw0[1]=PKW(P0,2), pw0); \
    VRD(4); SBAR(); GAPA(C1=__builtin_amdgcn_mfma_f32_32x32x16_bf16(kf[1],qr[0],negm,0,0,0), P0[6],P0[7],P0[8],P0[9],     pw0[2]=PKW(P0,4), pw0[3]=PKW(P0,6), pw0); \
    VRD(1); SBAR(); GAPA(C0=__builtin_amdgcn_mfma_f32_32x32x16_bf16(kf[2],qr[1],C0,0,0,0),   P0[10],P0[11],P0[12],P0[13], pw1[0]=PKW(P0,8), pw1[1]=PKW(P0,10), pw1); \
    VRD(5); SBAR(); GAPA(C1=__builtin_amdgcn_mfma_f32_32x32x16_bf16(kf[3],qr[1],C1,0,0,0),   P0[14],P0[15],P1[0],P1[1],   pw1[2]=PKW(P0,12),pw1[3]=PKW(P0,14), pw1); \
    GAPA(C0=__builtin_amdgcn_mfma_f32_32x32x16_bf16(kf[4],qr[2],C0,0,0,0),   P1[2],P1[3],P1[4],P1[5],     pw2[0]=PKW(P1,0), pw2[1]=PKW(P1,2), pw2); \
    GAPA(C1=__builtin_amdgcn_mfma_f32_32x32x16_bf16(kf[5],qr[2],C1,0,0,0),   P1[6],P1[7],P1[8],P1[9],     pw2[2]=PKW(P1,4), pw2[3]=PKW(P1,6), pw2); \
    GAPA(C0=__builtin_amdgcn_mfma_f32_32x32x16_bf16(kf[6],qr[3],C0,0,0,0),   P1[10],P1[11],P1[12],P1[13], pw3[0]=PKW(P1,8), pw3[1]=PKW(P1,10), pw3); \
    GAPA(C1=__builtin_amdgcn_mfma_f32_32x32x16_bf16(kf[7],qr[3],C1,0,0,0),   P1[14],P1[15],0.f,0.f,       pw3[2]=PKW(P1,12),pw3[3]=PKW(P1,14), pw3); \
    l_reg+=sacc; \
    if(GK){DMA_K((t)+3,sl_cur);} if(GV){DMA_V((t)+1,2*sl_next);} \
    CMASK(C0,C1,t); \
    { float a=MX3(C0[0],C0[1],C1[0]),b=MX3(C0[2],C0[3],C1[1]); a=MX3(a,C1[2],C1[3]); \
      _Pragma("unroll") for(int r=4;r<16;r+=4){a=MX3(a,C0[r],C0[r+1]);b=MX3(b,C0[r+2],C0[r+3]);a=MX3(a,C1[r],C1[r+1]);b=MX3(b,C1[r+2],C1[r+3]);} \
      float rm=__builtin_fmaxf(a,b); { auto rr=__builtin_amdgcn_permlane32_swap(__float_as_uint(rm),__float_as_uint(rm),false,false); rm=__builtin_fmaxf(__uint_as_float(rr[0]),__uint_as_float(rr[1])); } \
      resc=false; \
      if(__builtin_expect(__any(rm>(float)THRL),0)){ const float dl=__builtin_fmaxf(rm,0.f); mhat+=dl; \
        _Pragma("unroll") for(int r=0;r<16;++r){C0[r]-=dl;C1[r]-=dl;} \
        _Pragma("unroll") for(int r=0;r<16;++r)negm[r]=-mhat; asm volatile("":"+v"(negm)); \
        const float f=__builtin_amdgcn_exp2f(-dl); l_reg*=f; if(hi==0)wsf[r32]=f; resc=true; } } \
    SBAR(); \
    GAPB2(o[0]=__builtin_amdgcn_mfma_f32_32x32x16_bf16(PAF(0),VFR(0),o[0],0,0,0), C0,0);  VRD(2);  SBAR(); \
    GAPB2(o[1]=__builtin_amdgcn_mfma_f32_32x32x16_bf16(PAF(0),VFR(4),o[1],0,0,0), C0,2);  VRD(6);  SBAR(); \
    GAPB2(o[0]=__builtin_amdgcn_mfma_f32_32x32x16_bf16(PAF(1),VFR(1),o[0],0,0,0), C0,4);  VRD(3);  SBAR(); \
    GAPB2(o[1]=__builtin_amdgcn_mfma_f32_32x32x16_bf16(PAF(1),VFR(5),o[1],0,0,0), C0,6);  VRD(7);  SBAR(); \
    GAPB2(o[0]=__builtin_amdgcn_mfma_f32_32x32x16_bf16(PAF(2),VFR(2),o[0],0,0,0), C0,8);  VRD2(0); SBAR(); \
    GAPB2(o[1]=__builtin_amdgcn_mfma_f32_32x32x16_bf16(PAF(2),VFR(6),o[1],0,0,0), C0,10); VRD2(4); SBAR(); \
    GAPB2(o[0]=__builtin_amdgcn_mfma_f32_32x32x16_bf16(PAF(3),VFR(3),o[0],0,0,0), C0,12); VRD2(1); SBAR(); \
    GAPB2(o[1]=__builtin_amdgcn_mfma_f32_32x32x16_bf16(PAF(3),VFR(7),o[1],0,0,0), C0,14); VRD2(5); SBAR(); \
    GAPB2(o[2]=__builtin_amdgcn_mfma_f32_32x32x16_bf16(PAF(0),VFR(0),o[2],0,0,0), C1,0);  VRD2(2); SBAR(); \
    GAPB2(o[3]=__builtin_amdgcn_mfma_f32_32x32x16_bf16(PAF(0),VFR(4),o[3],0,0,0), C1,2);  VRD2(6); SBAR(); \
    GAPB2(o[2]=__builtin_amdgcn_mfma_f32_32x32x16_bf16(PAF(1),VFR(1),o[2],0,0,0), C1,4);  VRD2(3); SBAR(); \
    GAPB2(o[3]=__builtin_amdgcn_mfma_f32_32x32x16_bf16(PAF(1),VFR(5),o[3],0,0,0), C1,6);  VRD2(7); SBAR(); \
    GAPB2(o[2]=__builtin_amdgcn_mfma_f32_32x32x16_bf16(PAF(2),VFR(2),o[2],0,0,0), C1,8);  KRD(GL,0); \
    GAPB2(o[3]=__builtin_amdgcn_mfma_f32_32x32x16_bf16(PAF(2),VFR(6),o[3],0,0,0), C1,10); KRD(GL,1); \
    GAPB2(o[2]=__builtin_amdgcn_mfma_f32_32x32x16_bf16(PAF(3),VFR(3),o[2],0,0,0), C1,12); KRD(GL,2); \
    GAPB2(o[3]=__builtin_amdgcn_mfma_f32_32x32x16_bf16(PAF(3),VFR(7),o[3],0,0,0), C1,14); KRD(GL,3); \
    }while(0)
  int t=1;
  #undef CMASK
  #define CMASK(P0,P1,t) do{}while(0)
  for(;t+5<NT;t+=2){
    STEP(pB0,pB1,pA0,pA1,t,true,true,true);     WAIT_BAR(3); RESC(); ROT();
    STEP(pA0,pA1,pB0,pB1,t+1,true,true,true);   WAIT_BAR(3); RESC(); ROT();
  }
  #undef CMASK
  #define CMASK(P0,P1,t) do{int jb_=(t)-(NT-4); if(jb_>=0)cmask(P0,P1,jb_,qrel,hi);}while(0)
  #define ENDW(tt) do{ if((tt)+3<NT){WAIT_BAR(3);} else if((tt)+2<NT){WAIT_BAR(2);} else {WAIT_BAR(0);} }while(0)
  for(;t+1<NT;t+=2){
    STEP(pB0,pB1,pA0,pA1,t,(t+3<NT),(t+1<NT),(t+1<NT));       ENDW(t);   RESC(); ROT();
    STEP(pA0,pA1,pB0,pB1,t+1,(t+4<NT),(t+2<NT),(t+2<NT));     ENDW(t+1); RESC(); ROT();
  }
  STEP(pB0,pB1,pA0,pA1,NT-1,false,false,false); RESC();
  { float sacc=pB0[0]+pB0[1]; _Pragma("unroll") for(int r=2;r<16;++r)sacc+=pB0[r]; _Pragma("unroll") for(int r=0;r<16;++r)sacc+=pB1[r]; l_reg+=sacc;
    pw0=(u32x4){PKW(pB0,0),PKW(pB0,2),PKW(pB0,4),PKW(pB0,6)};pw1=(u32x4){PKW(pB0,8),PKW(pB0,10),PKW(pB0,12),PKW(pB0,14)};pw2=(u32x4){PKW(pB1,0),PKW(pB1,2),PKW(pB1,4),PKW(pB1,6)};pw3=(u32x4){PKW(pB1,8),PKW(pB1,10),PKW(pB1,12),PKW(pB1,14)};
    SBAR(); pv(o,vb0+2*sl_cur,PAF(0),PAF(1),PAF(2),PAF(3)); }
  #undef PKW
  #undef PAF
  #undef VFR
  #undef PIN
  #undef MX3
  #undef GAPA
  #undef GAPB
  #undef EX
  #undef VRD
  #undef VRD2
  #undef GAPB2
  #undef KRD
  #undef STEP
  #undef ENDW
  {auto rr=__builtin_amdgcn_permlane32_swap(__float_as_uint(l_reg),__float_as_uint(l_reg),false,false);l_reg=__uint_as_float(rr[0])+__uint_as_float(rr[1]);}
  if(hi==0)wsf[32+r32]=l_reg;asm volatile("s_waitcnt lgkmcnt(0)":::"memory");
  float rli[16];
  #pragma unroll
  for(int r=0;r<16;++r)rli[r]=__builtin_amdgcn_rcpf(wsf[32+crow(r,hi)]);
  bf16*Ow=O+(rowbase+q0+wid*QBLK)*OPITCH+ooff;
  { bf16*stg=(bf16*)(shm+LDS_OST)+wid*2048;
    float rs4[4]={0.f,0.f,0.f,0.f}; int le=lane; asm volatile("":"+v"(le));
    #pragma unroll
    for(int pass=0;pass<2;++pass){ if(pass==1&&mode==0)break;
    #pragma unroll
    for(int hf=0;hf<2;++hf){
    #pragma unroll
    for(int r=0;r<16;++r){const int orow=crow(r,hi);
      #pragma unroll
      for(int d0=0;d0<2;++d0)stg[orow*64+d0*32+r32]=__float2bfloat16(o[2*hf+d0][r]*rli[r]);}
    asm volatile("s_waitcnt lgkmcnt(0)":::"memory");
    #pragma unroll
    for(int i=0;i<4;++i){const int row=i*8+(le>>3),ch=le&7; const u32x4 v=*(const u32x4*)(stg+row*64+ch*8);
      if(mode==0){ ATTN_STORE16(Ow+(long)row*OPITCH+hf*64+ch*8,v); }
      else{ const u32x4 z=*(const u32x4*)(Ow-128+(long)row*OPITCH+hf*64+ch*8); const unsigned zw[4]={z.x,z.y,z.z,z.w},vw[4]={v.x,v.y,v.z,v.w}; float d8[8];
        #pragma unroll
        for(int k=0;k<4;++k){ d8[2*k]=__uint_as_float(zw[k]<<16)-lam*__uint_as_float(vw[k]<<16); d8[2*k+1]=__uint_as_float(zw[k]&0xffff0000u)-lam*__uint_as_float(vw[k]&0xffff0000u); }
        if(pass==0){
          #pragma unroll
          for(int k=0;k<8;++k)rs4[i]+=d8[k]*d8[k]; }
        else{ const float rstd=rs4[i]; const float*g=subln+hf*64+ch*8; u32x4 w;
          w.x=cvtpk_s(d8[0]*rstd*g[0],d8[1]*rstd*g[1]); w.y=cvtpk_s(d8[2]*rstd*g[2],d8[3]*rstd*g[3]); w.z=cvtpk_s(d8[4]*rstd*g[4],d8[5]*rstd*g[5]); w.w=cvtpk_s(d8[6]*rstd*g[6],d8[7]*rstd*g[7]);
          *(u32x4*)(A2+(rowbase+q0+wid*QBLK+row)*1024+a2off+hf*64+ch*8)=w; } } }
    asm volatile("s_waitcnt lgkmcnt(0)":::"memory"); }
    if(pass==0&&mode!=0){
      #pragma unroll
      for(int i=0;i<4;++i){ float q=rs4[i]; q+=__shfl_xor(q,1); q+=__shfl_xor(q,2); q+=__shfl_xor(q,4); rs4[i]=(1.0f-0.35550906f)/sqrtf(q*(1.0f/128.0f)+1e-6f); } } } }
  asm volatile("s_waitcnt lgkmcnt(0)\n\ts_barrier":::"memory");
  #undef DMA_K
  #undef DMA_V
  #undef CMASK
  #undef START
  #undef RESC
  #undef ROT
}
constexpr int ATTN_LDS_BYTES=LDS_BYTES;
struct AttnTensors { const bf16* Q; const bf16* K; const bf16* V; bf16* O; };
struct AttnUnit { int bh; int qb; };
struct StaticOrder {
  int vcu;
  __device__ __forceinline__ explicit StaticOrder(int grid,int block):vcu((block%8)*(grid/8)+block/8){}
  __device__ __forceinline__ bool next(int i,AttnUnit&u)const{ if(i>=8)return false; const int s=vcu&7,j=i&3; u.bh=vcu>>3; u.qb=(j==0)?s:(j==1)?15-s:(j==2)?16+s:31-s; return true; }
};
struct AttnFuse { bf16* A2; float lam; const float* subln; };
template<class Sched,int THRL=8> __device__ __forceinline__ void attn_phase(char*lds,const AttnTensors&T,const Sched&S,const int tid_in,const AttnFuse&F){
  AttnUnit u;
  for(int i=0;S.next(i,u);++i){ const int b=u.bh>>3,h=u.bh&7,sh=i>>2,hs=2*h+sh;
    attn_unit<THRL>(b,hs*64,hs*64,h*128,hs*128,u.qb,T.Q,T.K,T.V,T.O,lds,tid_in,sh,F.A2,h*128,F.lam,F.subln); }
}
#undef SBAR
#undef WAIT_BAR
}
constexpr int NWAVES = 8;
constexpr int DM_ = 1024, MP = 32768, MS = 512, MT = MP + MS, SEQ_ = 8192, PAST = 4096;
constexpr int FFH = 2816, GH = 3072;
constexpr float EPS_ = 1e-6f;
constexpr float LAM_INIT = 0.35550906f;
constexpr size_t MiB = 1u << 20;
constexpr size_t WS_CTL = 0, CTL_ZERO_BYTES = 1 * MiB;
constexpr size_t WS_STATS = 640 * 1024;
constexpr size_t WS_MOD = 1 * MiB;
constexpr size_t WS_TAB = 5 * MiB;
constexpr size_t WS_LB = 13 * MiB;
constexpr size_t WS_W = 16 * MiB;
constexpr size_t W_GIN = WS_W, W_GOUT = W_GIN + 12 * MiB, W_DIN = W_GOUT + 6 * MiB, W_DOUT = W_DIN + 6 * MiB, W_RIN = W_DOUT + 2 * MiB, W_ROUT = W_RIN + 12 * MiB,
                 W_HIN = W_ROUT + 4 * MiB, W_HOUT = W_HIN + 8 * MiB, W_FIN = W_HOUT + 2 * MiB, W_FOUT = W_FIN + 44 * MiB, W_END = W_FOUT + 22 * MiB;
constexpr size_t FIN_STRIDE = 11 * MiB, FOUT_STRIDE = (size_t)1024 * 2816 * 2;
constexpr size_t WS_H = 144 * MiB;
constexpr size_t WS_F = 209 * MiB;
constexpr size_t WS_BIG = 274 * MiB;
constexpr size_t WS_B2 = 664 * MiB;
constexpr size_t WS_B3 = 859 * MiB;
constexpr size_t WS_LF = 989 * MiB;
constexpr size_t WS_QD = 1119 * MiB, WS_KI = 1184 * MiB, WS_KE = 1249 * MiB;
constexpr size_t WS_EB = 1314 * MiB;
constexpr size_t WS_PART = 1320 * MiB;
constexpr size_t WS_XB = 1344 * MiB;
constexpr size_t WS_STATP = 1410 * MiB;
constexpr size_t WS_END = 1424 * MiB;
static_assert(W_END <= WS_H && WS_STATS + (size_t)MT * 8 <= CTL_ZERO_BYTES, "ws map");
constexpr int CW_TMO = 0, CW_BAR = 4096;
constexpr int RING_BYTES = 131072, LDSCTL_OFF = 139264, MISC_OFF = LDSCTL_OFF + 320, LDS_BYTES = 147456;
constexpr size_t O_YP = 0, O_YS = 33554432, O_GV = 34078720, O_KDP = 35651584, O_VDP = 69206016, O_KDS = 102760448, O_VDS = 103284736,
                 O_RSP = 103809024, O_RSS = 105906176, O_HSP = 122683392, O_HSS = 123207680, O_END = 127401984;
#define GAS __attribute__((address_space(1)))
#define LAS __attribute__((address_space(3)))
typedef unsigned short bf16;
typedef unsigned v4u __attribute__((ext_vector_type(4)));
typedef float f32x4 __attribute__((ext_vector_type(4)));
typedef short bf16x8 __attribute__((ext_vector_type(8)));
typedef GAS unsigned gu32;
typedef GAS unsigned long long gu64;
#define RLX_AGENT __ATOMIC_RELAXED, __HIP_MEMORY_SCOPE_AGENT
#define LDS_WAIT() asm volatile("s_waitcnt lgkmcnt(0)" ::: "memory")
#define VM_WAIT() asm volatile("s_waitcnt vmcnt(0)" ::: "memory")
__device__ __forceinline__ unsigned long long rt() { return __builtin_amdgcn_s_memrealtime(); }
__device__ __forceinline__ unsigned f2bf(float f) { unsigned u = __builtin_bit_cast(unsigned, f); return (u + 0x7fffu + ((u >> 16) & 1u)) >> 16; }
__device__ __forceinline__ unsigned pk2(float lo, float hi) { return f2bf(lo) | (f2bf(hi) << 16); }

#define XB_TMO      128
#define XB_XCNT(j)  (256  + 64 * (j))
#define XB_XSUB(j)  (1280 + 64 * (j))
#define XB_XGEN(j)  (2304 + 64 * (j))
#define XB_TOP      3328
#define XB_TOPGEN   3392
#define XCD_BAR_WORDS 3456
#define XB_SPIN_CAP (1u << 18)

__device__ __forceinline__ unsigned xb_ld(unsigned* p)              { return __hip_atomic_load(p, __ATOMIC_RELAXED, __HIP_MEMORY_SCOPE_AGENT); }
__device__ __forceinline__ unsigned xb_add(unsigned* p, unsigned v) { return __hip_atomic_fetch_add(p, v, __ATOMIC_RELAXED, __HIP_MEMORY_SCOPE_AGENT); }
__device__ __forceinline__ unsigned xb_xcc_id() { return (unsigned)__builtin_amdgcn_s_getreg((3 << 11) | 20) & 0xFu; }
#define XB_SPIN(cond, bar) do { unsigned _sp = 0; while (cond) { __builtin_amdgcn_s_sleep(1); \
    if ((++_sp & 255u) == 0u) { if (xb_ld(&(bar)[XB_TMO])) break; if (_sp > XB_SPIN_CAP) { atomicAdd(&(bar)[XB_TMO], 1u); break; } } } } while (0)

struct XcdBarrier {
    unsigned* bar; unsigned x;
    volatile LAS unsigned* st;
};

__device__ __forceinline__ XcdBarrier xcd_barrier_post(unsigned* bar, volatile LAS unsigned* st, bool leader) {
    XcdBarrier b; b.bar = bar; b.x = xb_xcc_id(); b.st = st;
    if (leader) (void)xb_add(&bar[XB_XCNT(b.x)], 1u);
    return b;
}
__device__ __forceinline__ void xcd_barrier_complete(unsigned* bar, unsigned x, unsigned& nloc, unsigned& nx) {
    const unsigned G = gridDim.x * gridDim.y * gridDim.z;
    unsigned sum, cnt, mine, sp = 0u;
    for (;;) {
        sum = 0u; cnt = 0u; mine = 0u;
#pragma unroll
        for (unsigned j = 0; j < 16; ++j) { const unsigned c = xb_ld(&bar[XB_XCNT(j)]); sum += c; cnt += (c > 0u) ? 1u : 0u; mine = (j == x) ? c : mine; }
        if (sum == G) break;
        __builtin_amdgcn_s_sleep(1);
        if ((++sp & 255u) == 0u) { if (xb_ld(&bar[XB_TMO])) break; if (sp > XB_SPIN_CAP) { atomicAdd(&bar[XB_TMO], 1u); break; } }
    }
    nloc = mine > 0u ? mine : 1u; nx = cnt > 0u ? cnt : 1u;
}

__device__ __forceinline__ void xcd_barrier(const XcdBarrier& b, bool leader) {
    asm volatile("s_waitcnt vmcnt(0)" ::: "memory");
    __syncthreads();
    if (leader) {
        unsigned* bar = b.bar;
        __builtin_amdgcn_s_waitcnt(0);
        unsigned nloc = b.st[0], nx = b.st[1];
        if (nloc == 0u) { xcd_barrier_complete(bar, b.x, nloc, nx); b.st[0] = nloc; b.st[1] = nx; }
        const unsigned old = xb_add(&bar[XB_XSUB(b.x)], 1u);
        const unsigned gen = old / nloc;
        if (old + 1u == (gen + 1u) * nloc) {
            __builtin_amdgcn_fence(__ATOMIC_RELEASE, "agent");
            asm volatile("s_waitcnt vmcnt(0)" ::: "memory");
            const unsigned og = xb_add(&bar[XB_TOP], 1u);
            const unsigned tg = og / nx;
            if (og + 1u == (tg + 1u) * nx) xb_add(&bar[XB_TOPGEN], 1u);
            else XB_SPIN(xb_ld(&bar[XB_TOPGEN]) == tg, bar);
            __builtin_amdgcn_fence(__ATOMIC_ACQUIRE, "agent");
            xb_add(&bar[XB_XGEN(b.x)], 1u);
            asm volatile("s_waitcnt vmcnt(0)" ::: "memory");
        } else {
            XB_SPIN(xb_ld(&bar[XB_XGEN(b.x)]) == gen, bar);
            __builtin_amdgcn_fence(__ATOMIC_ACQUIRE, "agent");
            asm volatile("s_waitcnt vmcnt(0)" ::: "memory");
        }
    }
    __syncthreads();
}
typedef short s16x4 __attribute__((ext_vector_type(4)));
typedef unsigned u32x2 __attribute__((ext_vector_type(2)));
typedef unsigned u32x4 __attribute__((ext_vector_type(4)));
typedef LAS unsigned char* lptr;
__device__ __forceinline__ float bflo(unsigned w) { return __uint_as_float(w << 16); }
__device__ __forceinline__ float bfhi(unsigned w) { return __uint_as_float(w & 0xffff0000u); }
__device__ __forceinline__ unsigned pkbf(float lo, float hi) { return pg8::cvt_pk_bf16(lo, hi); }
__device__ __forceinline__ u32x4 pack8(f32x4 a, f32x4 b) { u32x4 w; w.x = pkbf(a[0], a[1]); w.y = pkbf(a[2], a[3]); w.z = pkbf(b[0], b[1]); w.w = pkbf(b[2], b[3]); return w; }
__device__ __forceinline__ float wave_sum(float v) {
#pragma unroll
    for (int o = 1; o < 64; o <<= 1) v += __shfl_xor(v, o);
    return v;
}
__device__ __forceinline__ float shx(float v, int mask, int lane) { return __int_as_float(__builtin_amdgcn_ds_bpermute((lane ^ mask) << 2, __float_as_int(v))); }
__device__ __forceinline__ float siluf(float x) { return x * __builtin_amdgcn_rcpf(1.0f + __expf(-x)); }
__device__ __forceinline__ int sid_of_row(int row) { return row < MP ? (row >> 13) : 4 + ((row - MP) >> 4); }
__device__ __forceinline__ f32x4 mma32(bf16x8 a, bf16x8 b, f32x4 c) { return __builtin_amdgcn_mfma_f32_16x16x32_bf16(a, b, c, 0, 0, 0); }
__device__ __forceinline__ f32x4 mma16(s16x4 a, s16x4 b, f32x4 c) { return __builtin_amdgcn_mfma_f32_16x16x16bf16_1k(a, b, c, 0, 0, 0); }
__device__ __forceinline__ bf16x8 frag_row(lptr base, int pitch, int x0, int k0, int lane) {
    return *(const LAS bf16x8*)(base + (x0 + (lane & 15)) * pitch + (k0 + 8 * (lane >> 4)) * 2);
}
typedef short v4i16_t __attribute__((ext_vector_type(4)));
__device__ __forceinline__ bf16x8 frag_tr(lptr base, int pitch, int k0, int x0, int lane) {
    const int g = lane >> 4, i = lane & 15, q = i >> 2, p = i & 3;
    lptr a = base + (k0 + 8 * g + q) * pitch + (x0 + 4 * p) * 2;
    const s16x4 lo = __builtin_bit_cast(s16x4, __builtin_amdgcn_ds_read_tr16_b64_v4i16((LAS v4i16_t*)a));
    const s16x4 hi = __builtin_bit_cast(s16x4, __builtin_amdgcn_ds_read_tr16_b64_v4i16((LAS v4i16_t*)(a + 4 * pitch)));
    return (bf16x8){lo[0], lo[1], lo[2], lo[3], hi[0], hi[1], hi[2], hi[3]};
}

#define LDS_BARRIER() do { asm volatile("s_waitcnt lgkmcnt(0)" ::: "memory"); __builtin_amdgcn_s_barrier(); asm volatile("" ::: "memory"); } while (0)
struct Ctx { int tid, lane, wave, vcu, G, gw, NGW; lptr lds; };

__device__ __forceinline__ Ctx mk_ctx(lptr lds, int wave_sgpr) {
    Ctx C; C.lds = lds; C.tid = fresh_tid(wave_sgpr); C.lane = C.tid & 63; C.wave = __builtin_amdgcn_readfirstlane(C.tid >> 6);
    int G = gridDim.x, bx = blockIdx.x; asm volatile("" : "+s"(G), "+s"(bx));
    C.G = G; C.vcu = (G % 8 == 0) ? (bx % 8) * (G / 8) + bx / 8 : bx; C.gw = C.vcu * NWAVES + C.wave; C.NGW = G * NWAVES; return C;
}
__device__ __forceinline__ void p0_transpose_item(const float* W, int K, int N, bf16* WT, int mode, LAS float* scr, int item, int lane) {
    const int nblk = N / 32, kb = item / nblk, nb = item % nblk, k0 = 64 * kb, n0 = 32 * nb;
    int d0 = n0;
    if (mode == 1) { d0 = (n0 < FFH) ? ((n0 >> 7) * 256 + (n0 & 127)) : (((n0 - FFH) >> 7) * 256 + 128 + ((n0 - FFH) & 127)); }
    if (mode == 2) { d0 = (n0 < 1024) ? ((n0 >> 7) * 256 + (n0 & 127)) : (n0 < 2048 ? (((n0 - 1024) >> 7) * 256 + 128 + (n0 & 127)) : n0); }
#pragma unroll 8
    for (int i = 0; i < 32; ++i) { const int kk = 2 * i + (lane >> 5); scr[kk * 33 + (lane & 31)] = W[(size_t)(k0 + kk) * N + n0 + (lane & 31)]; }
    LDS_WAIT(); asm volatile("" ::: "memory");
    const int c = lane & 7;
#pragma unroll
    for (int j = 0; j < 4; ++j) { const int n = (lane >> 3) + 8 * j; const LAS float* s = scr + (8 * c) * 33 + n;
        v4u o; o.x = pk2(s[0 * 33], s[1 * 33]); o.y = pk2(s[2 * 33], s[3 * 33]); o.z = pk2(s[4 * 33], s[5 * 33]); o.w = pk2(s[6 * 33], s[7 * 33]);
        *(GAS v4u*)(WT + (size_t)(d0 + n) * K + k0 + 8 * c) = o; }
    LDS_WAIT(); asm volatile("" ::: "memory");
}
__device__ __forceinline__ void p0_transpose(const Ctx& C, const float* W, int K, int N, bf16* WT, int mode) {
    LAS float* scr = (LAS float*)(C.lds + C.wave * 16384);
    const int nitems = (K / 64) * (N / 32);
    for (int it = C.gw; it < nitems; it += C.NGW) p0_transpose_item(W, K, N, WT, mode, scr, it, C.lane);
}
__device__ __forceinline__ void bg_transpose(const Ctx& C, int nbusy, const float* W, int K, int N, bf16* WT, int mode) {
    const int bx = (int)blockIdx.x; if (bx < nbusy) return;
    LAS float* scr = (LAS float*)(C.lds + C.wave * 16384);
    const int nitems = (K / 64) * (N / 32), stride = (C.G - nbusy) * NWAVES;
    for (int it = (bx - nbusy) * NWAVES + C.wave; it < nitems; it += stride) p0_transpose_item(W, K, N, WT, mode, scr, it, C.lane);
}
__device__ __forceinline__ void p0_adaln(const Ctx& C, const float* cp, const float* cs, const float* w_ada, const float* b_ada, float* mod) {
    LAS float* sl = (LAS float*)C.lds;
    LAS float* red = (LAS float*)(C.lds + 81920);
    for (int u = C.vcu; u < 768; u += C.G) {
        const int half = u & 1, cb = (u >> 1) % 96, l = (u >> 1) / 96, sid0 = half * 18;
        __syncthreads();
        for (int idx = C.tid; idx < 18 * 1024; idx += 512) { const int i = idx >> 10, k = idx & 1023, sid = sid0 + i;
            const float cv = sid < 4 ? cp[sid * 1024 + k] : cs[(sid - 4) * 1024 + k]; sl[k * 20 + i] = siluf(cv); }
        __syncthreads();
        const int c = C.tid & 63, kg = C.wave, col = cb * 64 + c;
        float acc[18];
#pragma unroll
        for (int i = 0; i < 18; ++i) acc[i] = 0.f;
        const float* wp = w_ada + ((size_t)l * 1024 + kg * 128) * 6144 + col;
#pragma unroll 4
        for (int kk = 0; kk < 128; ++kk) { const float w = wp[(size_t)kk * 6144]; const LAS float* s = sl + (kg * 128 + kk) * 20;
            const f32x4 a = *(const LAS f32x4*)s, b = *(const LAS f32x4*)(s + 4), cc = *(const LAS f32x4*)(s + 8), d = *(const LAS f32x4*)(s + 12); const float e0 = s[16], e1 = s[17];
            acc[0] += a[0] * w; acc[1] += a[1] * w; acc[2] += a[2] * w; acc[3] += a[3] * w; acc[4] += b[0] * w; acc[5] += b[1] * w; acc[6] += b[2] * w; acc[7] += b[3] * w;
            acc[8] += cc[0] * w; acc[9] += cc[1] * w; acc[10] += cc[2] * w; acc[11] += cc[3] * w; acc[12] += d[0] * w; acc[13] += d[1] * w; acc[14] += d[2] * w; acc[15] += d[3] * w;
            acc[16] += e0 * w; acc[17] += e1 * w; }
#pragma unroll
        for (int i = 0; i < 18; ++i) red[(kg * 18 + i) * 64 + c] = acc[i];
        __syncthreads();
        for (int idx = C.tid; idx < 18 * 64; idx += 512) { const int i = idx >> 6, cc = idx & 63; float s = 0.f;
#pragma unroll
            for (int g = 0; g < 8; ++g) s += red[(g * 18 + i) * 64 + cc];
            const int colo = cb * 64 + cc; mod[((size_t)l * 36 + sid0 + i) * 6144 + colo] = s + b_ada[l * 6144 + colo]; }
    }
    __syncthreads();
}
__device__ __forceinline__ void p0_tables(const Ctx& C, float* tab, float* lb, const float* hlb) {
    const int gt = C.vcu * 512 + C.tid, NT = C.G * 512;
    for (int idx = gt; idx < 8192 * 128; idx += NT) { const int pos = idx >> 7, i = idx & 127;
        const double inv = exp(-9.210340371976184 * ((double)i / 127.0)); const double ang = (double)pos * inv;
        double sn, cs; sincos(ang, &sn, &cs); tab[2 * (size_t)idx] = (float)cs; tab[2 * (size_t)idx + 1] = (float)sn; }
    for (int c = gt; c < 1024; c += NT) { const float a0 = hlb[c], a1 = hlb[1024 + c], a2 = hlb[2048 + c], a3 = hlb[3072 + c];
        const float mx = fmaxf(fmaxf(a0, a1), fmaxf(a2, a3)); const float e0 = expf(a0 - mx), e1 = expf(a1 - mx), e2 = expf(a2 - mx), e3 = expf(a3 - mx);
        lb[c] = (e1 + e2 + e3) / (e0 + e1 + e2 + e3); }
}

template <bool HAS_F, bool HAS_H, bool XIN32, bool XOUT32>
__device__ __forceinline__ void resnorm_phase(const Ctx& C, const float* xp, const float* xs, const bf16* Xb, const bf16* Fb, float* xout, bf16* Xo, const float* mod,
                                              const float* gpost, int mgate, bf16* Hb, const float* gpre, int mshift, int mscale, const float* part = nullptr, int nslab = 0) {
    const int MROWS = (HAS_F && part) ? MP : MT;
    if (HAS_F && part) { const int wrev = C.NGW - 1 - C.gw;
        for (int m = MP + wrev; m < MT; m += C.NGW) { const int sid = sid_of_row(m); const float* mrow = mod + (size_t)sid * 6144;
            f32x4 v[4], f[4];
            if (XIN32) { const GAS f32x4* xr = (const GAS f32x4*)(xs + (size_t)(m - MP) * DM_) + C.lane;
#pragma unroll
                for (int j = 0; j < 4; ++j) v[j] = xr[64 * j]; }
            else { const GAS u32x2* xr = (const GAS u32x2*)(Xb + (size_t)m * DM_) + C.lane;
#pragma unroll
                for (int j = 0; j < 4; ++j) { const u32x2 w = xr[64 * j]; v[j] = (f32x4){bflo(w.x), bfhi(w.x), bflo(w.y), bfhi(w.y)}; } }
#pragma unroll
            for (int j = 0; j < 4; ++j) f[j] = (f32x4){0.f, 0.f, 0.f, 0.f};
            for (int s = 0; s < nslab; ++s) { const GAS f32x4* pr = (const GAS f32x4*)(part + ((size_t)s * 512 + (m - MP)) * DM_) + C.lane;
#pragma unroll
                for (int j = 0; j < 4; ++j) f[j] = f[j] + pr[64 * j]; }
            float ss = 0.f;
#pragma unroll
            for (int j = 0; j < 4; ++j) ss += (f[j].x * f[j].x + f[j].y * f[j].y) + (f[j].z * f[j].z + f[j].w * f[j].w);
            float rstd = 1.0f / sqrtf(wave_sum(ss) * (1.0f / DM_) + EPS_);
#pragma unroll
            for (int j = 0; j < 4; ++j) { const f32x4 g = *((const GAS f32x4*)gpost + C.lane + 64 * j), gt = *((const GAS f32x4*)(mrow + mgate) + C.lane + 64 * j);
                v[j] = v[j] + gt * (f[j] * rstd * g);
                if (XOUT32) ((GAS f32x4*)(xout + (size_t)m * DM_) + C.lane)[64 * j] = v[j];
                else { u32x2 w; w.x = pkbf(v[j].x, v[j].y); w.y = pkbf(v[j].z, v[j].w); ((GAS u32x2*)(Xo + (size_t)m * DM_) + C.lane)[64 * j] = w; } }
            if (HAS_H) { ss = 0.f;
#pragma unroll
                for (int j = 0; j < 4; ++j) ss += (v[j].x * v[j].x + v[j].y * v[j].y) + (v[j].z * v[j].z + v[j].w * v[j].w);
                rstd = 1.0f / sqrtf(wave_sum(ss) * (1.0f / DM_) + EPS_);
                GAS u32x2* ho = (GAS u32x2*)(Hb + (size_t)m * DM_) + C.lane;
#pragma unroll
                for (int j = 0; j < 4; ++j) { const f32x4 g = *((const GAS f32x4*)gpre + C.lane + 64 * j), sc = *((const GAS f32x4*)(mrow + mscale) + C.lane + 64 * j), sh = *((const GAS f32x4*)(mrow + mshift) + C.lane + 64 * j);
                    const f32x4 h = v[j] * rstd * g * (sc + 1.0f) + sh; u32x2 w; w.x = pkbf(h.x, h.y); w.y = pkbf(h.z, h.w); ho[64 * j] = w; } } } }
    f32x4 vnA[4], vnB[4]; u32x4 xnA[2], xnB[2], fnA[2], fnB[2];
#define RN_LOAD(mm, vn, xn, fn) do { \
        if (XIN32) { const GAS f32x4* xr_ = (const GAS f32x4*)((mm) < MP ? xp + (size_t)(mm) * DM_ : xs + (size_t)((mm) - MP) * DM_) + 2 * C.lane; vn[0] = xr_[0]; vn[1] = xr_[1]; vn[2] = xr_[128]; vn[3] = xr_[129]; } \
        else { const GAS u32x4* xr_ = (const GAS u32x4*)(Xb + (size_t)(mm) * DM_) + C.lane; xn[0] = xr_[0]; xn[1] = xr_[64]; } \
        if (HAS_F) { const GAS u32x4* fr_ = (const GAS u32x4*)(Fb + (size_t)(mm) * DM_) + C.lane; fn[0] = fr_[0]; fn[1] = fr_[64]; } } while (0)
    const int RPW = (MROWS + C.NGW - 1) / C.NGW; int m = C.gw * RPW; const int mend = (m + RPW < MROWS) ? m + RPW : MROWS;
    int cur_sid = -1; f32x4 gg[4], aa[4], shv[4];
#define RN_VEC(ptr, q) (*((const GAS f32x4*)(ptr) + 2 * C.lane + ((q) >> 1) * 128 + ((q) & 1)))
#define RN_UNPK(src_, lo, hi) do { const u32x4 t_ = (src_); lo = (f32x4){bflo(t_.x), bfhi(t_.x), bflo(t_.y), bfhi(t_.y)}; hi = (f32x4){bflo(t_.z), bfhi(t_.z), bflo(t_.w), bfhi(t_.w)}; } while (0)
#define RN_ROW(mm, vn, xn, fn) do { \
        const int sid = sid_of_row(mm); \
        if (sid != cur_sid) { cur_sid = sid; const float* mrow = mod + (size_t)sid * 6144; \
            _Pragma("unroll") for (int q = 0; q < 4; ++q) { \
                if (HAS_F) gg[q] = RN_VEC(gpost, q) * RN_VEC(mrow + mgate, q); \
                if (HAS_H) { aa[q] = RN_VEC(gpre, q) * (RN_VEC(mrow + mscale, q) + 1.0f); shv[q] = RN_VEC(mrow + mshift, q); } } } \
        f32x4 v[4]; u32x4 fw[2]; \
        if (XIN32) { _Pragma("unroll") for (int q = 0; q < 4; ++q) v[q] = vn[q]; } else { RN_UNPK(xn[0], v[0], v[1]); RN_UNPK(xn[1], v[2], v[3]); } \
        fw[0] = fn[0]; fw[1] = fn[1]; \
        if ((mm) + 2 < mend) RN_LOAD((mm) + 2, vn, xn, fn); \
        if (HAS_F) { \
            f32x4 f[4]; float ss = 0.f; RN_UNPK(fw[0], f[0], f[1]); RN_UNPK(fw[1], f[2], f[3]); \
            _Pragma("unroll") for (int q = 0; q < 4; ++q) ss += (f[q].x * f[q].x + f[q].y * f[q].y) + (f[q].z * f[q].z + f[q].w * f[q].w); \
            const float rstd = 1.0f / sqrtf(wave_sum(ss) * (1.0f / DM_) + EPS_); \
            _Pragma("unroll") for (int q = 0; q < 4; ++q) v[q] = v[q] + gg[q] * (f[q] * rstd); \
            if (XOUT32) { GAS f32x4* xo_ = (GAS f32x4*)(xout + (size_t)(mm) * DM_) + 2 * C.lane; xo_[0] = v[0]; xo_[1] = v[1]; xo_[128] = v[2]; xo_[129] = v[3]; } \
            else { GAS u32x4* xo_ = (GAS u32x4*)(Xo + (size_t)(mm) * DM_) + C.lane; xo_[0] = pack8(v[0], v[1]); xo_[64] = pack8(v[2], v[3]); } \
        } \
        if (HAS_H) { \
            float ss = 0.f; \
            _Pragma("unroll") for (int q = 0; q < 4; ++q) ss += (v[q].x * v[q].x + v[q].y * v[q].y) + (v[q].z * v[q].z + v[q].w * v[q].w); \
            const float rstd = 1.0f / sqrtf(wave_sum(ss) * (1.0f / DM_) + EPS_); \
            GAS u32x4* ho = (GAS u32x4*)(Hb + (size_t)(mm) * DM_) + C.lane; \
            ho[0] = pack8(v[0] * rstd * aa[0] + shv[0], v[1] * rstd * aa[1] + shv[1]); ho[64] = pack8(v[2] * rstd * aa[2] + shv[2], v[3] * rstd * aa[3] + shv[3]); \
        } } while (0)
    if (m < mend) RN_LOAD(m, vnA, xnA, fnA);
    if (m + 1 < mend) RN_LOAD(m + 1, vnB, xnB, fnB);
    for (; m < mend; m += 2) {
        RN_ROW(m, vnA, xnA, fnA);
        if (m + 1 < mend) RN_ROW(m + 1, vnB, xnB, fnB);
    }
#undef RN_ROW
#undef RN_VEC
#undef RN_UNPK
#undef RN_LOAD
}
#define EPI_LOOP_ROWS for (int ai = 0; ai < 2; ++ai) _Pragma("unroll") for (int m = 0; m < 4; ++m)
typedef pg8::f32x2 f32x2;
__device__ __forceinline__ f32x4 gelu4(f32x4 v) { const f32x2 a = pg8::gelu_pk((f32x2){v[0], v[1]}), b = pg8::gelu_pk((f32x2){v[2], v[3]}); return (f32x4){a.x, a.y, b.x, b.y}; }
__device__ __forceinline__ f32x4 silu4(f32x4 v) { return (f32x4){siluf(v[0]), siluf(v[1]), siluf(v[2]), siluf(v[3])}; }

struct EpiPlain {
    static constexpr bool PERM = true, AFTER_DRAIN = false;
    bf16* O; int ldc;
    __device__ __forceinline__ void operator()(const f32x4 (&acc)[2][2][4][2], const pg8::Unit& u, int wr, int wc, int fr, int fq) const {
        const int row0 = u.pm * 256 + wr * 64 + fr, col0 = u.pn * 256 + wc * 32 + 8 * fq;
#pragma unroll
        EPI_LOOP_ROWS { bf16* rowp = O + (size_t)(row0 + ai * 128 + m * 16) * ldc + col0;
#pragma unroll
            for (int bj = 0; bj < 2; ++bj) *(u32x4*)(rowp + bj * 128) = pack8(acc[ai][bj][m][0], acc[ai][bj][m][1]); }
    }
};
struct EpiGelu {
    static constexpr bool PERM = true, AFTER_DRAIN = false;
    bf16* Z; float* stats;
    __device__ __forceinline__ void operator()(const f32x4 (&acc)[2][2][4][2], const pg8::Unit& u, int wr, int wc, int fr, int fq) const {
        const int row0 = u.pm * 256 + wr * 64 + fr, col0 = u.pn * 256 + wc * 32 + 8 * fq; const bool isv = u.pn >= 12;
#pragma unroll
        EPI_LOOP_ROWS { const int row = row0 + ai * 128 + m * 16; bf16* rowp = Z + ((size_t)(2 * u.pn) * MT + row) * 128 + wc * 32 + 8 * fq; float s = 0.f, q = 0.f;
#pragma unroll
            for (int bj = 0; bj < 2; ++bj) { const f32x4 a = gelu4(acc[ai][bj][m][0]), b = gelu4(acc[ai][bj][m][1]); *(u32x4*)(rowp + (size_t)bj * ((size_t)MT * 128)) = pack8(a, b);
                s += (a[0] + a[1]) + (a[2] + a[3]) + (b[0] + b[1]) + (b[2] + b[3]);
                q += (a[0] * a[0] + a[1] * a[1]) + (a[2] * a[2] + a[3] * a[3]) + (b[0] * b[0] + b[1] * b[1]) + (b[2] * b[2] + b[3] * b[3]); }
            if (isv) { s += __shfl_xor(s, 16); s += __shfl_xor(s, 32); q += __shfl_xor(q, 16); q += __shfl_xor(q, 32);
                if (fq == 0) { typedef float f32x2s __attribute__((ext_vector_type(2))); *(f32x2s*)(stats + ((size_t)row * 48 + (u.pn - 12) * 4 + wc) * 2) = (f32x2s){s, q}; } } }
    }
};
struct EpiSwiglu {
    static constexpr bool PERM = true, AFTER_DRAIN = false;
    bf16* O;
    __device__ __forceinline__ void operator()(const f32x4 (&acc)[2][2][4][2], const pg8::Unit& u, int wr, int wc, int fr, int fq) const {
        const int row0 = u.pm * 256 + wr * 64 + fr, col0 = u.pn * 128 + wc * 32 + 8 * fq;
#pragma unroll
        EPI_LOOP_ROWS { bf16* rowp = O + (size_t)(row0 + ai * 128 + m * 16) * FFH + col0;
            *(u32x4*)rowp = pack8(silu4(acc[ai][0][m][0]) * acc[ai][1][m][0], silu4(acc[ai][0][m][1]) * acc[ai][1][m][1]); }
    }
};
struct EpiDiff {
    static constexpr bool PERM = true, AFTER_DRAIN = false;
    bf16* Qb; float* kp; float* ks; float c2;
    __device__ __forceinline__ void operator()(const f32x4 (&acc)[2][2][4][2], const pg8::Unit& u, int wr, int wc, int fr, int fq) const {
        const int row0 = u.pm * 256 + wr * 64 + fr, t = u.pn >> 2, col0 = (u.pn & 3) * 256 + wc * 32 + 8 * fq;
        bf16* ob = Qb + (size_t)t * MT * DM_; const float sc = t == 0 ? c2 : 1.0f;
#pragma unroll
        EPI_LOOP_ROWS { const int row = row0 + ai * 128 + m * 16; bf16* rowp = ob + (size_t)row * DM_ + col0;
            float* fo = row < MP ? kp + (size_t)row * DM_ + (size_t)(t == 2 ? (O_VDP - O_KDP) : 0) : ks + (size_t)(row - MP) * DM_ + (size_t)(t == 2 ? (O_VDS - O_KDS) : 0);
#pragma unroll
            for (int bj = 0; bj < 2; ++bj) { const f32x4 a = acc[ai][bj][m][0] * sc, b = acc[ai][bj][m][1] * sc; *(u32x4*)(rowp + bj * 128) = pack8(a, b);
                if (t != 0) { *(f32x4*)(fo + col0 + bj * 128) = a; *(f32x4*)(fo + col0 + bj * 128 + 4) = b; } } }
    }
};
struct EpiRet {
    static constexpr bool PERM = true, AFTER_DRAIN = false;
    bf16* O; const float* tab;
    __device__ __forceinline__ void operator()(const f32x4 (&acc)[2][2][4][2], const pg8::Unit& u, int wr, int wc, int fr, int fq) const {
        const int row0 = u.pm * 256 + wr * 64 + fr, col0 = u.pn * 256 + wc * 32 + 8 * fq; const int t = u.pn < 4 ? 0 : (u.pn < 8 ? 1 : (u.pn < 16 ? 2 : 3));
        bf16* const QKp = O + (WS_LF - WS_BIG) / 2; bf16* const VVp = O + (WS_QD - WS_BIG) / 2;
#pragma unroll
        EPI_LOOP_ROWS { const int row = row0 + ai * 128 + m * 16; bf16* rowp = O + (size_t)row * 6144 + col0;
            const int pos = row < MP ? (row & 8191) : PAST + ((row - MP) & 15);
#pragma unroll
            for (int bj = 0; bj < 2; ++bj) { f32x4 a = acc[ai][bj][m][0], b = acc[ai][bj][m][1];
                if (t <= 1) { const int cl = (col0 + bj * 128) & 255; const float* tp = tab + ((size_t)pos * 128 + (cl >> 1)) * 2; const f32x4 t0 = *(const f32x4*)tp, t1 = *(const f32x4*)(tp + 4);
                    const int hd = ((col0 + bj * 128) >> 8) & 3; const float fac = exp2f(__log2f(1.0f - exp2f(-5.0f - (float)hd)) * (float)(row < MP ? (row & 63) : ((row - MP) & 15)));
                    const float sc = t == 1 ? 0.0625f * __builtin_amdgcn_rcpf(fac) : fac;
                    a = (f32x4){a[0] * t0[0] - a[1] * t0[1], a[1] * t0[0] + a[0] * t0[1], a[2] * t0[2] - a[3] * t0[3], a[3] * t0[2] + a[2] * t0[3]} * sc;
                    b = (f32x4){b[0] * t1[0] - b[1] * t1[1], b[1] * t1[0] + b[0] * t1[1], b[2] * t1[2] - b[3] * t1[3], b[3] * t1[2] + b[2] * t1[3]} * sc; }
                else if (t == 3) { a = silu4(a); b = silu4(b); }
                const int col = col0 + bj * 128;
                bf16* dst = t == 3 ? rowp + bj * 128 : (t == 2 ? VVp + ((size_t)((col - 2048) >> 5) * MT + row) * 32 + (col & 31) : QKp + ((size_t)((col >> 8) & 3) * MT + row) * 512 + (t == 1 ? 256 : 0) + (col & 255));
                *(u32x4*)dst = pack8(a, b); } }
    }
};
template <int N> __device__ __forceinline__ float dpp_row_shr(float x) { return __int_as_float(__builtin_amdgcn_update_dpp(0, __float_as_int(x), 0x110 + N, 0xf, 0xf, true)); }
struct EpiHgrn {
    static constexpr bool PERM = true, AFTER_DRAIN = false;
    bf16* HB; bf16* QD; bf16* KI; bf16* KE; float* EB; const float* lb;
    __device__ __forceinline__ void operator()(const f32x4 (&acc)[2][2][4][2], const pg8::Unit& u, int wr, int wc, int fr, int fq) const {
        const int row0 = u.pm * 256 + wr * 64 + fr;
        if (u.pn >= 8) { const int col0 = u.pn * 256 + wc * 32 + 8 * fq; const bool isg = u.pn >= 12; bf16* const VHp = HB + (WS_LF - WS_BIG) / 2;
            if (isg) {
#pragma unroll
                EPI_LOOP_ROWS { bf16* rowp = HB + (size_t)(row0 + ai * 128 + m * 16) * 4096 + col0;
#pragma unroll
                    for (int bj = 0; bj < 2; ++bj) { const f32x4 a = silu4(acc[ai][bj][m][0]), b = silu4(acc[ai][bj][m][1]); *(u32x4*)(rowp + bj * 128) = pack8(a, b); } }
            } else {
                const unsigned iv0 = (unsigned)(col0 - 2048), vo0 = (iv0 >> 4) * (unsigned)MT * 16u + (iv0 & 15u);
#pragma unroll
                EPI_LOOP_ROWS { bf16* rowp = VHp + vo0 + (unsigned)(row0 + ai * 128 + m * 16) * 16u;
#pragma unroll
                    for (int bj = 0; bj < 2; ++bj) *(u32x4*)(rowp + (size_t)bj * (8u * MT * 16u)) = pack8(acc[ai][bj][m][0], acc[ai][bj][m][1]); } }
            return; }
        const int d0 = u.pn * 128 + wc * 32 + 8 * fq; const bool smp = u.pm >= 128; const int bsrc = ((fq << 4) | 15) << 2;
#pragma unroll
        for (int n = 0; n < 2; ++n) { const f32x4 lbv = *(const f32x4*)(lb + d0 + 4 * n);
#pragma unroll
            for (int ai = 0; ai < 2; ++ai) { float lf[4][4], kk[4][4], tot[4][4];
#pragma unroll
                for (int m = 0; m < 4; ++m)
#pragma unroll
                    for (int j = 0; j < 4; ++j) { const float k = (1.0f - lbv[j]) * __builtin_amdgcn_rcpf(1.0f + __expf(acc[ai][1][m][n][j])); kk[m][j] = k; float x = log1pf(-k);
                        x += dpp_row_shr<1>(x); x += dpp_row_shr<2>(x); x += dpp_row_shr<4>(x); x += dpp_row_shr<8>(x); lf[m][j] = x;
                        tot[m][j] = __int_as_float(__builtin_amdgcn_ds_bpermute(bsrc, __float_as_int(x))); }
                float bl[4];
                if (!smp) {
#pragma unroll
                    for (int j = 0; j < 4; ++j) { float p = 0.f;
#pragma unroll
                        for (int m = 0; m < 4; ++m) { lf[m][j] += p; p += tot[m][j]; } bl[j] = p; } }
#pragma unroll
                for (int m = 0; m < 4; ++m) { const int row = row0 + ai * 128 + m * 16; float qd[4], ki[4], eb[4];
#pragma unroll
                    for (int j = 0; j < 4; ++j) { const float b = lf[m][j], bL = smp ? tot[m][j] : bl[j]; qd[j] = siluf(acc[ai][0][m][n][j]) * __expf(b); ki[j] = kk[m][j] * __expf(-b); eb[j] = __expf(bL); }
                    const unsigned o = ((unsigned)(d0 >> 7) * (unsigned)MT + (unsigned)row) * 128u + (unsigned)((d0 & 127) + 4 * n);
                    *(u32x2*)(QD + o) = (u32x2){pkbf(qd[0], qd[1]), pkbf(qd[2], qd[3])}; *(u32x2*)(KI + o) = (u32x2){pkbf(ki[0], ki[1]), pkbf(ki[2], ki[3])};
                    if (fr == 15 && (smp || m == 3)) { const int ch = smp ? 512 + ((row - MP) >> 4) : (row >> 6); *(f32x4*)(EB + (size_t)ch * DM_ + d0 + 4 * n) = (f32x4){eb[0], eb[1], eb[2], eb[3]}; } } } }
    }
};
struct FOrder {
    pg8::StaticOrder P; int nsub, G, c;
    __device__ __forceinline__ bool next(int i, pg8::Unit& u) const {
        if (P.next(i, u)) return true;
        const int idx = (i - 2) * G + c; if (idx < 0 || idx >= nsub) return false;
        u.pm = 128 + ((idx & 7) >> 2); u.pn = idx & 3; u.kb = (idx >> 3) * 512; u.nt = 4; return true; }
    __device__ __forceinline__ void a_ready(const pg8::Unit&) const {}
    __device__ __forceinline__ void done(const pg8::Unit&) const {}
};
struct EpiF {
    static constexpr bool PERM = true, AFTER_DRAIN = false;
    bf16* F; float* P;
    __device__ __forceinline__ void operator()(const f32x4 (&acc)[2][2][4][2], const pg8::Unit& u, int wr, int wc, int fr, int fq) const {
        const int row0 = u.pm * 256 + wr * 64 + fr, col0 = u.pn * 256 + wc * 32 + 8 * fq;
        if (u.nt == 0) {
#pragma unroll
            EPI_LOOP_ROWS { bf16* rowp = F + (size_t)(row0 + ai * 128 + m * 16) * DM_ + col0;
#pragma unroll
                for (int bj = 0; bj < 2; ++bj) *(u32x4*)(rowp + bj * 128) = pack8(acc[ai][bj][m][0], acc[ai][bj][m][1]); }
        } else { float* base = P + ((size_t)(u.kb >> 9) * 512 - MP) * 1024;
#pragma unroll
            EPI_LOOP_ROWS { float* rowp = base + (size_t)(row0 + ai * 128 + m * 16) * 1024 + col0;
#pragma unroll
                for (int bj = 0; bj < 2; ++bj) { *(f32x4*)(rowp + bj * 128) = acc[ai][bj][m][0]; *(f32x4*)(rowp + bj * 128 + 4) = acc[ai][bj][m][1]; } }
        }
    }
};
__device__ __forceinline__ void gmlp_gate_phase(const Ctx& C, const bf16* Z, const float* stats, const float* lng, const float* lnb, const float* w_s, const float* b_s, bf16* GO, float* gv_out) {
    constexpr int PW = 288;
    lptr Wl = C.lds, Vl = C.lds + 36864, Ml = C.lds + 73728; LAS float* st = (LAS float*)(C.lds + 110592); LAS float* bl = st + 256;
    const int lane = C.lane, w = C.wave, fq = lane >> 4, ln = lane & 15;
    const int g = C.vcu >> 5, cg = C.vcu & 31;
    int wstate = -1;
    for (int k = cg; k < 260 * 3; k += 32) {
        const int ch = k / 3, cb = 3 * g + (k - ch * 3), c0 = cb * 128, r0 = ch * 128; const bool smp = ch >= 256;
        __syncthreads();
        if (wstate != (smp ? 1 : 0)) { wstate = smp ? 1 : 0;
            for (int idx = C.tid; idx < 2048; idx += 512) { const int t = idx >> 4, s8 = (idx & 15) * 8; f32x4 a = {0.f, 0.f, 0.f, 0.f}, b = a; int lim;
                if (!smp) { const float* wp = w_s + ((size_t)g * 128 + t) * 128 + s8; a = *(const f32x4*)wp; b = *(const f32x4*)(wp + 4); lim = t - s8; }
                else { const int tl = t & 15, sl8 = s8 & 15; lim = -1; if ((t >> 4) == (s8 >> 4)) { const float* wp = w_s + ((size_t)g * 128 + tl) * 128 + sl8; a = *(const f32x4*)wp; b = *(const f32x4*)(wp + 4); lim = tl - sl8; } }
#pragma unroll
                for (int j = 0; j < 4; ++j) { if (j > lim) a[j] = 0.f; if (j + 4 > lim) b[j] = 0.f; }
                *(LAS u32x4*)(Wl + t * PW + s8 * 2) = pack8(a, b); }
            if (C.tid < 128) bl[C.tid] = b_s[g * 128 + (smp ? (C.tid & 15) : C.tid)]; }
        if (C.tid < 128) { const int row = r0 + C.tid; const f32x4* sp = (const f32x4*)(stats + (size_t)row * 96); float s = 0.f, q = 0.f;
#pragma unroll 8
            for (int i = 0; i < 24; ++i) { const f32x4 x = sp[i]; s += x[0]; q += x[1]; s += x[2]; q += x[3]; }
            const float mu = s * (1.0f / GH), var = q * (1.0f / GH) - mu * mu;
            st[2 * C.tid] = mu; st[2 * C.tid + 1] = 1.0f / sqrtf(fmaxf(var, 0.f) + EPS_); }
        __syncthreads();
        for (int idx = C.tid; idx < 2048; idx += 512) { const int s = idx >> 4, c8 = (idx & 15) * 8; const u32x4 zv = *(const u32x4*)(Z + ((size_t)(24 + cb) * MT + r0 + s) * 128 + c8);
            const f32x4 g0 = *(const f32x4*)(lng + c0 + c8), g1 = *(const f32x4*)(lng + c0 + c8 + 4), b0 = *(const f32x4*)(lnb + c0 + c8), b1 = *(const f32x4*)(lnb + c0 + c8 + 4);
            const float mu = st[2 * s], rs = st[2 * s + 1];
            f32x4 a = {bflo(zv.x), bfhi(zv.x), bflo(zv.y), bfhi(zv.y)}, b = {bflo(zv.z), bfhi(zv.z), bflo(zv.w), bfhi(zv.w)};
            a = (a - mu) * rs * g0 + b0; b = (b - mu) * rs * g1 + b1;
            *(LAS u32x4*)(Vl + s * PW + c8 * 2) = pack8(a, b);
            if (smp) { float* go = gv_out + (size_t)(r0 + s - MP) * GH + c0 + c8; *(f32x4*)go = a; *(f32x4*)(go + 4) = b; } }
        __syncthreads();
        f32x4 acc[8];
#pragma unroll
        for (int nt = 0; nt < 8; ++nt) acc[nt] = (f32x4){0.f, 0.f, 0.f, 0.f};
#pragma unroll
        for (int ks = 0; ks < 4; ++ks) if (32 * ks <= 16 * w + 15) { const bf16x8 A = frag_row(Wl, PW, 16 * w, 32 * ks, lane);
#pragma unroll
            for (int nt = 0; nt < 8; ++nt) { const bf16x8 B = frag_tr(Vl, PW, 32 * ks, 16 * nt, lane); acc[nt] = mma32(A, B, acc[nt]); } }
#pragma unroll
        for (int nt = 0; nt < 8; ++nt)
#pragma unroll
            for (int i = 0; i < 4; ++i) { const int t = 16 * w + 4 * fq + i; *(LAS bf16*)(Ml + t * PW + (16 * nt + ln) * 2) = (bf16)f2bf(acc[nt][i] + bl[t]); }
        __syncthreads();
        for (int idx = C.tid; idx < 2048; idx += 512) { const int t = idx >> 4, c8 = (idx & 15) * 8; const u32x4 uv = *(const u32x4*)(Z + ((size_t)cb * MT + r0 + t) * 128 + c8), mv = *(const LAS u32x4*)(Ml + t * PW + c8 * 2);
            u32x4 o; o.x = pkbf(bflo(uv.x) * bflo(mv.x), bfhi(uv.x) * bfhi(mv.x)); o.y = pkbf(bflo(uv.y) * bflo(mv.y), bfhi(uv.y) * bfhi(mv.y));
            o.z = pkbf(bflo(uv.z) * bflo(mv.z), bfhi(uv.z) * bfhi(mv.z)); o.w = pkbf(bflo(uv.w) * bflo(mv.w), bfhi(uv.w) * bfhi(mv.w));
            *(u32x4*)(GO + (size_t)(r0 + t) * GH + c0 + c8) = o; }
    }
    __syncthreads();
}

__device__ __forceinline__ float diff_lambda(const float* lamp, int lane) {
    const float p1 = lamp[lane] * lamp[64 + lane], p2 = lamp[128 + lane] * lamp[192 + lane];
    return expf(wave_sum(p1)) - expf(wave_sum(p2)) + LAM_INIT;
}
__device__ __forceinline__ void diff_combine_phase(const Ctx& C, const bf16* O4, const float* lamp, const float* subln, bf16* A2) {
    const float lam = diff_lambda(lamp, C.lane); const int lane = C.lane, h = lane >> 3, sub = lane & 7, dv0 = sub * 16;
    float gsc[16];
#pragma unroll
    for (int j = 0; j < 16; ++j) gsc[j] = subln[dv0 + j] * (1.0f - LAM_INIT);
    u32x4 a0n, a1n, b0n, b1n;
#define DC_LOAD(mm) do { const bf16* p0_ = O4 + (size_t)(mm) * 2048 + h * 256 + dv0; a0n = *(const u32x4*)p0_; a1n = *(const u32x4*)(p0_ + 8); b0n = *(const u32x4*)(p0_ + 128); b1n = *(const u32x4*)(p0_ + 136); } while (0)
    if (C.gw < MP) DC_LOAD(C.gw);
    for (int m = C.gw; m < MP; m += C.NGW) {
        const u32x4 a0 = a0n, a1 = a1n, b0 = b0n, b1 = b1n;
        if (m + C.NGW < MP) DC_LOAD(m + C.NGW);
        float o[16]; const unsigned aw[8] = {a0.x, a0.y, a0.z, a0.w, a1.x, a1.y, a1.z, a1.w}, bw[8] = {b0.x, b0.y, b0.z, b0.w, b1.x, b1.y, b1.z, b1.w}; float ss = 0.f;
#pragma unroll
        for (int j = 0; j < 8; ++j) { o[2 * j] = bflo(aw[j]) - lam * bflo(bw[j]); o[2 * j + 1] = bfhi(aw[j]) - lam * bfhi(bw[j]); ss += o[2 * j] * o[2 * j] + o[2 * j + 1] * o[2 * j + 1]; }
        ss += __shfl_xor(ss, 1); ss += __shfl_xor(ss, 2); ss += __shfl_xor(ss, 4);
        const float rstd = 1.0f / sqrtf(ss * (1.0f / 128.0f) + EPS_);
        u32x4 w0, w1; w0.x = pkbf(o[0] * rstd * gsc[0], o[1] * rstd * gsc[1]); w0.y = pkbf(o[2] * rstd * gsc[2], o[3] * rstd * gsc[3]); w0.z = pkbf(o[4] * rstd * gsc[4], o[5] * rstd * gsc[5]); w0.w = pkbf(o[6] * rstd * gsc[6], o[7] * rstd * gsc[7]);
        w1.x = pkbf(o[8] * rstd * gsc[8], o[9] * rstd * gsc[9]); w1.y = pkbf(o[10] * rstd * gsc[10], o[11] * rstd * gsc[11]); w1.z = pkbf(o[12] * rstd * gsc[12], o[13] * rstd * gsc[13]); w1.w = pkbf(o[14] * rstd * gsc[14], o[15] * rstd * gsc[15]);
        bf16* op = A2 + (size_t)m * DM_ + h * 128 + dv0; *(u32x4*)op = w0; *(u32x4*)(op + 8) = w1;
    }
}

__device__ __forceinline__ void diff_sample_phase(const Ctx& C, const bf16* Qb, const float* ck, const float* cv, const float* kds, const float* vds, const float lam, const float* subln, bf16* A2) {
    constexpr int PK = 288, PV = 136, KBUF = 64 * PK, VBUF = 128 * PV;
    lptr Kl0 = C.lds, Vt0 = C.lds + 2 * KBUF;
    LAS float* Om = (LAS float*)C.lds; LAS float* ml = (LAS float*)(C.lds + 65536);
    const int lane = C.lane, fq = lane >> 4, ln = lane & 15, s = C.wave & 1, kt = C.wave >> 1, key = C.tid >> 3, part = C.tid & 7;
    for (int u = C.vcu; u < 256; u += C.G) {
        const int sb = u >> 3, h = u & 7;
        const bf16* qp = Qb + (size_t)(MP + 16 * sb + ln) * DM_ + (2 * h + s) * 64 + 8 * fq;
        const bf16x8 qf0 = *(const bf16x8*)qp, qf1 = *(const bf16x8*)(qp + 32);
        float mrun = -INFINITY, lrun = 0.f; f32x4 o[8];
#pragma unroll
        for (int dt = 0; dt < 8; ++dt) o[dt] = (f32x4){0.f, 0.f, 0.f, 0.f};
        f32x4 kr[4], vr[4];
#define DS_LOAD(T) do { const float* kp_; const float* vp_; bool ok_ = true; \
            if ((T) < 64) { kp_ = ck + ((size_t)(sb * PAST + 64 * (T) + key) * 16 + 2 * h) * 64 + 16 * part; vp_ = cv + ((size_t)(sb * PAST + 64 * (T) + key) * 8 + h) * 128 + 16 * part; } \
            else { ok_ = key < 16; kp_ = kds + ((size_t)(sb * 16 + (key & 15)) * 16 + 2 * h) * 64 + 16 * part; vp_ = vds + ((size_t)(sb * 16 + (key & 15)) * 8 + h) * 128 + 16 * part; } \
            _Pragma("unroll") for (int i_ = 0; i_ < 4; ++i_) { kr[i_] = ok_ ? *(const f32x4*)(kp_ + 4 * i_) : (f32x4){0.f, 0.f, 0.f, 0.f}; vr[i_] = ok_ ? *(const f32x4*)(vp_ + 4 * i_) : (f32x4){0.f, 0.f, 0.f, 0.f}; } } while (0)
        DS_LOAD(0);
        __syncthreads();
        for (int T = 0; T <= 64; ++T) {
            lptr Kl = Kl0 + (T & 1) * KBUF, Vt = Vt0 + (T & 1) * VBUF;
            *(LAS u32x4*)(Kl + key * PK + part * 32) = pack8(kr[0], kr[1]); *(LAS u32x4*)(Kl + key * PK + part * 32 + 16) = pack8(kr[2], kr[3]);
#pragma unroll
            for (int i = 0; i < 4; ++i)
#pragma unroll
                for (int j = 0; j < 4; ++j) *(LAS bf16*)(Vt + (16 * part + 4 * i + j) * PV + key * 2) = (bf16)f2bf(vr[i][j]);
            __syncthreads();
            if (T < 64) DS_LOAD(T + 1);
            if (T < 64 || kt == 0) {
                f32x4 sc = {0.f, 0.f, 0.f, 0.f};
                sc = mma32(frag_row(Kl, PK, 16 * kt, s * 64, lane), qf0, sc); sc = mma32(frag_row(Kl, PK, 16 * kt, s * 64 + 32, lane), qf1, sc);
                float mx = fmaxf(fmaxf(sc[0], sc[1]), fmaxf(sc[2], sc[3])); mx = fmaxf(mx, shx(mx, 16, lane)); mx = fmaxf(mx, shx(mx, 32, lane));
                const float mn = fmaxf(mrun, mx), alpha = exp2f(mrun - mn); mrun = mn;
                const float p0 = exp2f(sc[0] - mn), p1 = exp2f(sc[1] - mn), p2 = exp2f(sc[2] - mn), p3 = exp2f(sc[3] - mn);
                lrun = lrun * alpha + ((p0 + p1) + (p2 + p3));
                const u32x2 pw = {pkbf(p0, p1), pkbf(p2, p3)}; const s16x4 P = __builtin_bit_cast(s16x4, pw);
#pragma unroll
                for (int dt = 0; dt < 8; ++dt) { const s16x4 A = *(const LAS s16x4*)(Vt + (16 * dt + ln) * PV + (16 * kt + 4 * fq) * 2); o[dt] = mma16(A, P, o[dt] * alpha); }
            }
        }
#undef DS_LOAD
        lrun += shx(lrun, 16, lane); lrun += shx(lrun, 32, lane);
        __syncthreads();
        if (fq == 0) { ml[C.wave * 16 + ln] = mrun; ml[128 + C.wave * 16 + ln] = lrun; }
#pragma unroll
        for (int dt = 0; dt < 8; ++dt) *(LAS f32x4*)(Om + (C.wave * 16 + ln) * 128 + 16 * dt + 4 * fq) = o[dt];
        __syncthreads();
        { const int q = C.tid >> 5, dv4 = (C.tid & 31) * 4; f32x4 os[2];
#pragma unroll
            for (int ss = 0; ss < 2; ++ss) { float M = -INFINITY;
#pragma unroll
                for (int k = 0; k < 4; ++k) M = fmaxf(M, ml[(2 * k + ss) * 16 + q]);
                float Ls = 0.f; f32x4 a = {0.f, 0.f, 0.f, 0.f};
#pragma unroll
                for (int k = 0; k < 4; ++k) { const int wv = 2 * k + ss; const float e = exp2f(ml[wv * 16 + q] - M); Ls += ml[128 + wv * 16 + q] * e; a = a + *(const LAS f32x4*)(Om + (wv * 16 + q) * 128 + dv4) * e; }
                os[ss] = a * (1.0f / Ls); }
            const f32x4 od = os[0] - os[1] * lam; float ssq = (od[0] * od[0] + od[1] * od[1]) + (od[2] * od[2] + od[3] * od[3]);
#pragma unroll
            for (int x = 1; x < 32; x <<= 1) ssq += shx(ssq, x, lane);
            const float rstd = 1.0f / sqrtf(ssq * (1.0f / 128.0f) + EPS_) * (1.0f - LAM_INIT); const f32x4 g = *(const f32x4*)(subln + dv4);
            u32x2 wv2; wv2.x = pkbf(od[0] * rstd * g[0], od[1] * rstd * g[1]); wv2.y = pkbf(od[2] * rstd * g[2], od[3] * rstd * g[3]);
            *(u32x2*)(A2 + (size_t)(MP + 16 * sb + q) * DM_ + h * 128 + dv4) = wv2; }
        __syncthreads();
    }
}
template <int OFF> __device__ __forceinline__ void dma16s(const void* sbase, unsigned voff, lptr dst) { unsigned keep; const unsigned d = __builtin_amdgcn_readfirstlane((unsigned)(__SIZE_TYPE__)dst);
    const unsigned long long b_ = (unsigned long long)sbase; const unsigned long long sb = ((unsigned long long)(unsigned)__builtin_amdgcn_readfirstlane((int)(unsigned)(b_ >> 32)) << 32) | (unsigned)__builtin_amdgcn_readfirstlane((int)(unsigned)b_);
    asm volatile("s_mov_b32 %0, m0\n\ts_mov_b32 m0, %3\n\ts_nop 4\n\tglobal_load_lds_dwordx4 %1, %2 offset:%c4\n\ts_mov_b32 m0, %0" : "=&s"(keep) : "v"(voff), "s"(sb), "s"(d), "i"(OFF) : "memory"); }
__device__ __forceinline__ void dma16(const void* gsrc, lptr dst) { unsigned keep; const unsigned d = __builtin_amdgcn_readfirstlane((unsigned)(__SIZE_TYPE__)dst);
    asm volatile("s_mov_b32 %0, m0\n\ts_mov_b32 m0, %2\n\ts_nop 0\n\tglobal_load_lds_dwordx4 %1, off\n\ts_mov_b32 m0, %0" : "=&s"(keep) : "v"(gsrc), "s"(d) : "memory"); }
__device__ __forceinline__ int swz512(int r, int c) { return r * 512 + (((c & 16) | ((c ^ r) & 15)) << 4); }
__device__ __forceinline__ bf16x8 frag_row_s(lptr base, int x0, int k0, int lane) { const int r = x0 + (lane & 15), c = (k0 >> 3) + (lane >> 4); return *(const LAS bf16x8*)(base + swz512(r, c)); }
__device__ __forceinline__ bf16x8 frag_tr_s(lptr base, int k0, int x0, int lane) {
    const int g = lane >> 4, i = lane & 15, q = i >> 2, pq = i & 3; const int r0 = k0 + 8 * g + q, c = (x0 + 4 * pq) >> 3, off = (pq & 1) * 8;
    const s16x4 lo = __builtin_bit_cast(s16x4, __builtin_amdgcn_ds_read_tr16_b64_v4i16((LAS v4i16_t*)(base + swz512(r0, c) + off)));
    const s16x4 hi = __builtin_bit_cast(s16x4, __builtin_amdgcn_ds_read_tr16_b64_v4i16((LAS v4i16_t*)(base + swz512(r0 + 4, c) + off)));
    return (bf16x8){lo[0], lo[1], lo[2], lo[3], hi[0], hi[1], hi[2], hi[3]};
}
#ifndef RETPROBE
#define RETPROBE 0
#endif
__device__ __forceinline__ f32x4 keep3(bf16x8 a, bf16x8 b, f32x4 c) { asm volatile("" :: "v"(a), "v"(b)); return c; }
__device__ __forceinline__ void ret_scan_phase(const Ctx& C, const bf16* BIG, const float* st_in, bf16* Or, float* st_out_p, float* st_out_s, const bool crip = false) {
    const bf16* const QK = BIG + (WS_LF - WS_BIG) / 2; const bf16* const VV = BIG + (WS_QD - WS_BIG) / 2;
    const bool c_nodma = crip && (RETPROBE == 2 || RETPROBE >= 7), c_nobar = crip && (RETPROBE == 3 || RETPROBE == 8), c_one = crip && RETPROBE == 1, c_nolds = crip && (RETPROBE == 4 || RETPROBE == 7), c_nomma = crip && (RETPROBE == 5 || RETPROBE == 9);
#define RMMA(a_, b_, c_) (c_nomma ? keep3(a_, b_, c_) : mma32(a_, b_, c_))
    constexpr int PP = 160, PS = 544;
    lptr Ql = C.lds, Kl0 = Ql + 32768, Vl0 = Kl0 + 65536, Pl = Vl0 + 8192, Sl = Pl + 64 * PP;
    const int lane = C.lane, w = C.wave, fq = lane >> 4, ln = lane & 15, tid = C.tid;
    for (int u = C.vcu; u < 256 + 2048; u += C.G) {
        int h, j, row0, nsteps, L; const float* sin_ = nullptr; float* sout;
        if (u < 256) { const int b = u >> 6; h = (u >> 4) & 3; j = u & 15; row0 = b * SEQ_; nsteps = c_one ? 1 : 128; L = 64; sout = st_out_p + ((size_t)(b * 4 + h) * 256) * 512 + 32 * j; }
        else { const int su = u - 256, sb = su >> 6; h = (su >> 4) & 3; j = su & 15; row0 = MP + 16 * sb; nsteps = 1; L = 16; sin_ = st_in + ((size_t)(sb * 4 + h) * 256) * 512 + 32 * j; sout = st_out_s + ((size_t)(sb * 4 + h) * 256) * 512 + 32 * j; }
        const float lg2 = __log2f(1.0f - exp2f(-5.0f - (float)h)), gam = exp2f(lg2), gLm1 = exp2f(lg2 * (float)(L - 1));
        f32x4 st[2][2];
#pragma unroll
        for (int dt = 0; dt < 2; ++dt)
#pragma unroll
            for (int vt = 0; vt < 2; ++vt)
#pragma unroll
                for (int i = 0; i < 4; ++i) st[dt][vt][i] = sin_ ? sin_[(size_t)(16 * (2 * w + dt) + 4 * fq + i) * 512 + 16 * vt + ln] : 0.f;
        float mk[2][4];
        { const int t = 16 * (w >> 1) + ln;
#pragma unroll
            for (int x = 0; x < 2; ++x)
#pragma unroll
                for (int i = 0; i < 4; ++i) { const int s = 16 * (2 * (w & 1) + x) + 4 * fq + i; mk[x][i] = (s <= t && s < L) ? 1.f : 0.f; } }
        unsigned qoff[4];
#pragma unroll
        for (int i = 0; i < 4; ++i) { const int pi = 4 * w + i, r = 2 * pi + (lane >> 5), pc = lane & 31, c = (pc & 16) | ((pc ^ r) & 15), rc = r < L ? r : L - 1; qoff[i] = (unsigned)(rc * 512 + c * 8) * 2u; }
        const int vrow = 16 * (w & 3) + (lane >> 2); const unsigned voff = (unsigned)(vrow * 32 + (lane & 3) * 8) * 2u; const bool vdo = w < 4 && 16 * w < L;
        __builtin_amdgcn_s_waitcnt(0); __builtin_amdgcn_s_barrier();
        if (L < 64) { const u32x4 z4 = {0u, 0u, 0u, 0u}; if (((tid & 255) >> 2) >= L) *(LAS u32x4*)(Vl0 + tid * 16) = z4; }
#define RET_DMA_Q(n) do { const bf16* qb_ = QK + ((size_t)h * MT + row0 + 64 * (n)) * 512; _Pragma("unroll") for (int i_ = 0; i_ < 4; ++i_) \
            dma16s<0>(qb_, qoff[i_], Ql + (4 * w + i_) * 1024); } while (0)
#define RET_DMA_KV(n) do { const bf16* kb_ = QK + ((size_t)h * MT + row0 + 64 * (n)) * 512; lptr kd_ = Kl0 + ((n) & 1) * 32768; _Pragma("unroll") for (int i_ = 0; i_ < 4; ++i_) \
            dma16s<0>(kb_ + 256, qoff[i_], kd_ + (4 * w + i_) * 1024); \
            if (vdo) dma16s<0>(VV + ((size_t)(h * 16 + j) * MT + row0 + 64 * (n)) * 32, voff, Vl0 + ((n) & 1) * 4096 + (w & 3) * 1024); } while (0)
        RET_DMA_KV(0); RET_DMA_Q(0);
        u32x2 ow = {0u, 0u}; bf16* const orow = Or + (size_t)(row0 + 16 * (w >> 1) + ln) * 2048 + h * 512 + 32 * j + 16 * (w & 1) + 4 * fq; const bool odo = 16 * (w >> 1) + ln < L;
        for (int n = 0; n < nsteps; ++n) {
            lptr Kl = Kl0 + (n & 1) * 32768, Vl = Vl0 + (n & 1) * 4096;
            asm volatile("s_waitcnt vmcnt(0) lgkmcnt(0)" ::: "memory"); if (!c_nobar) __builtin_amdgcn_s_barrier(); asm volatile("" ::: "memory");
            if (n > 0 && odo && !c_nodma) *(u32x2*)(orow + (size_t)(n - 1) * (64 * 2048)) = ow;
            if (n + 1 < nsteps && !c_nodma) RET_DMA_KV(n + 1);
            bf16x8 qf[8];
            { const int ti = w >> 1, si0 = 2 * (w & 1); bf16x8 kf0[8], kf1[8];
#pragma unroll
                for (int ks = 0; ks < 8; ++ks) { if (!c_nolds) { qf[ks] = frag_row_s(Ql, 16 * ti, 32 * ks, lane); kf0[ks] = frag_row_s(Kl, 16 * si0, 32 * ks, lane); kf1[ks] = frag_row_s(Kl, 16 * si0 + 16, 32 * ks, lane); } else { qf[ks] = (bf16x8){(short)ks, 1, 2, 3, 4, 5, 6, 7}; kf0[ks] = qf[ks]; kf1[ks] = qf[ks]; } }
                __builtin_amdgcn_sched_barrier(0);
                f32x4 a0 = {0.f, 0.f, 0.f, 0.f}, a1 = a0, a2 = a0, a3 = a0;
#pragma unroll
                for (int ks = 0; ks < 8; ks += 2) { a0 = RMMA(kf0[ks], qf[ks], a0); a1 = RMMA(kf1[ks], qf[ks], a1); a2 = RMMA(kf0[ks + 1], qf[ks + 1], a2); a3 = RMMA(kf1[ks + 1], qf[ks + 1], a3); }
#pragma unroll
                for (int dt = 0; dt < 2; ++dt)
#pragma unroll
                    for (int vt = 0; vt < 2; ++vt) { const u32x2 sw = {pkbf(st[dt][vt][0], st[dt][vt][1]), pkbf(st[dt][vt][2], st[dt][vt][3])}; *(LAS u32x2*)(Sl + (16 * vt + ln) * PS + (16 * (2 * w + dt) + 4 * fq) * 2) = sw; }
                a0 = a0 + a2; a1 = a1 + a3;
                const int t = 16 * ti + ln;
#pragma unroll
                for (int x = 0; x < 2; ++x) { const f32x4 a = x ? a1 : a0; const int sb0 = 16 * (si0 + x) + 4 * fq;
                    const u32x2 pw = {pkbf(a[0] * mk[x][0], a[1] * mk[x][1]), pkbf(a[2] * mk[x][2], a[3] * mk[x][3])}; *(LAS u32x2*)(Pl + t * PP + sb0 * 2) = pw; } }
            asm volatile("s_waitcnt lgkmcnt(0)" ::: "memory"); if (!c_nobar) __builtin_amdgcn_s_barrier(); asm volatile("" ::: "memory");
            if (n + 1 < nsteps && !c_nodma) RET_DMA_Q(n + 1);
            { const int vi = w & 1, ti = w >> 1; bf16x8 sf[8], pf[2], vt_[2], ka[2][2], vb[2][2];
#pragma unroll
                for (int ks = 0; ks < 8; ++ks) sf[ks] = c_nolds ? qf[ks] : frag_row(Sl, PS, 16 * vi, 32 * ks, lane);
#pragma unroll
                for (int ks = 0; ks < 2; ++ks) { if (!c_nolds) { pf[ks] = frag_row(Pl, PP, 16 * ti, 32 * ks, lane); vt_[ks] = frag_tr(Vl, 64, 32 * ks, 16 * vi, lane); } else { pf[ks] = qf[ks]; vt_[ks] = qf[ks + 2]; } }
#pragma unroll
                for (int x = 0; x < 2; ++x)
#pragma unroll
                    for (int ks = 0; ks < 2; ++ks) { if (!c_nolds) { ka[x][ks] = frag_tr_s(Kl, 32 * ks, 16 * (2 * w + x), lane); vb[x][ks] = frag_tr(Vl, 64, 32 * ks, 16 * x, lane); } else { ka[x][ks] = qf[2 * x + ks]; vb[x][ks] = qf[4 + 2 * x + ks]; } }
                __builtin_amdgcn_sched_barrier(0);
                f32x4 oi = {0.f, 0.f, 0.f, 0.f}, oc = oi, oc2 = oi;
#pragma unroll
                for (int ks = 0; ks < 8; ks += 2) { oc = RMMA(sf[ks], qf[ks], oc); oc2 = RMMA(sf[ks + 1], qf[ks + 1], oc2); }
#pragma unroll
                for (int ks = 0; ks < 2; ++ks) if (32 * ks <= 16 * ti + 15) oi = RMMA(vt_[ks], pf[ks], oi);
#pragma unroll
                for (int dt = 0; dt < 2; ++dt)
#pragma unroll
                    for (int vt = 0; vt < 2; ++vt) { f32x4 a = st[dt][vt] * gam;
#pragma unroll
                        for (int ks = 0; ks < 2; ++ks) a = RMMA(ka[dt][ks], vb[vt][ks], a);
                        st[dt][vt] = a * gLm1; }
                oc = (oc + oc2) * gam;
                ow = (u32x2){pkbf(oi[0] + oc[0], oi[1] + oc[1]), pkbf(oi[2] + oc[2], oi[3] + oc[3])}; }
        }
#undef RET_DMA_Q
#undef RET_DMA_KV
        if (odo) *(u32x2*)(orow + (size_t)(nsteps - 1) * (64 * 2048)) = ow;
#pragma unroll
        for (int dt = 0; dt < 2; ++dt)
#pragma unroll
            for (int vt = 0; vt < 2; ++vt)
#pragma unroll
                for (int i = 0; i < 4; ++i) sout[(size_t)(16 * (2 * w + dt) + 4 * fq + i) * 512 + 16 * vt + ln] = st[dt][vt][i];
    }
    asm volatile("s_waitcnt vmcnt(0) lgkmcnt(0)" ::: "memory"); __syncthreads();
}
#undef RMMA
__device__ __forceinline__ void ret_post_phase(const Ctx& C, const bf16* Or, const bf16* BIG, bf16* A3) {
    const int lane = C.lane, h = lane >> 4, c0 = h * 512 + (lane & 15) * 32;
    u32x4 on[4], gn[4];
#define RP_LOAD(mm) do { const u32x4* op_ = (const u32x4*)(Or + (size_t)(mm) * 2048 + c0); const u32x4* gp_ = (const u32x4*)(BIG + (size_t)(mm) * 6144 + 4096 + c0); \
        _Pragma("unroll") for (int i_ = 0; i_ < 4; ++i_) { on[i_] = op_[i_]; gn[i_] = gp_[i_]; } } while (0)
    int m = C.gw;
    if (m < MT) RP_LOAD(m);
    for (; m < MT; m += C.NGW) {
        u32x4 ov[4], gv[4]; float ss = 0.f;
#pragma unroll
        for (int i = 0; i < 4; ++i) { ov[i] = on[i]; gv[i] = gn[i]; }
        if (m + C.NGW < MT) RP_LOAD(m + C.NGW);
#pragma unroll
        for (int i = 0; i < 4; ++i) { const unsigned ww[4] = {ov[i].x, ov[i].y, ov[i].z, ov[i].w};
#pragma unroll
            for (int k = 0; k < 4; ++k) { const float a = bflo(ww[k]), b = bfhi(ww[k]); ss += a * a + b * b; } }
        ss += __shfl_xor(ss, 1); ss += __shfl_xor(ss, 2); ss += __shfl_xor(ss, 4); ss += __shfl_xor(ss, 8);
        const float rstd = 1.0f / sqrtf(ss * (1.0f / 512.0f) + EPS_);
        u32x4* ap = (u32x4*)(A3 + (size_t)m * 2048 + c0);
#pragma unroll
        for (int i = 0; i < 4; ++i) { const unsigned ww[4] = {ov[i].x, ov[i].y, ov[i].z, ov[i].w}, gg[4] = {gv[i].x, gv[i].y, gv[i].z, gv[i].w}; unsigned r[4];
#pragma unroll
            for (int k = 0; k < 4; ++k) r[k] = pkbf(bflo(ww[k]) * rstd * bflo(gg[k]), bfhi(ww[k]) * rstd * bfhi(gg[k]));
            ap[i] = (u32x4){r[0], r[1], r[2], r[3]}; }
    }
#undef RP_LOAD
}

__device__ __forceinline__ void hgrn_prep_phase(const Ctx& C, const bf16* HB, const float* LF, bf16* QD, bf16* KI, bf16* KE, float* EB) {
    LAS float* part = (LAS float*)C.lds;
    const int w = C.wave, lane = C.lane;
    for (int u = C.vcu; u < 544 * 2; u += C.G) {
        const int cidx = u >> 1, col = (u & 1) * 512 + lane * 8; const int r0 = cidx < 512 ? 64 * cidx : MP + 16 * (cidx - 512), R = cidx < 512 ? 8 : 2;
        const int rw = r0 + w * R;
        f32x4 la[8], lb_[8];
#pragma unroll
        for (int t = 0; t < 8; ++t) if (t < R) { const float* lp = LF + (size_t)(rw + t) * DM_ + col; la[t] = *(const f32x4*)lp; lb_[t] = *(const f32x4*)(lp + 4); }
        u32x4 qv[8], kv[8];
#pragma unroll
        for (int t = 0; t < 8; ++t) if (t < R) { const bf16* hp = HB + (size_t)(rw + t) * 4096 + col; qv[t] = *(const u32x4*)hp; kv[t] = *(const u32x4*)(hp + 1024); }
        f32x4 sa = {0.f, 0.f, 0.f, 0.f}, sb = sa;
#pragma unroll
        for (int t = 0; t < 8; ++t) if (t < R) { sa = sa + la[t]; sb = sb + lb_[t]; la[t] = sa; lb_[t] = sb; }
        __syncthreads();
        *(LAS f32x4*)(part + w * 512 + lane * 8) = sa; *(LAS f32x4*)(part + w * 512 + lane * 8 + 4) = sb;
        __syncthreads();
        f32x4 pa = {0.f, 0.f, 0.f, 0.f}, pb = pa, ta = pa, tb = pa;
#pragma unroll
        for (int g = 0; g < 8; ++g) { const f32x4 xa = *(const LAS f32x4*)(part + g * 512 + lane * 8), xb = *(const LAS f32x4*)(part + g * 512 + lane * 8 + 4);
            if (g < w) { pa = pa + xa; pb = pb + xb; } ta = ta + xa; tb = tb + xb; }
        if (w == 0) { float* ep = EB + (size_t)cidx * DM_ + col; *(f32x4*)ep = (f32x4){__expf(ta[0]), __expf(ta[1]), __expf(ta[2]), __expf(ta[3])}; *(f32x4*)(ep + 4) = (f32x4){__expf(tb[0]), __expf(tb[1]), __expf(tb[2]), __expf(tb[3])}; }
#pragma unroll
        for (int t = 0; t < 8; ++t) if (t < R) {
            const f32x4 ba = la[t] + pa, bb = lb_[t] + pb; float b[8] = {ba[0], ba[1], ba[2], ba[3], bb[0], bb[1], bb[2], bb[3]}; const float bl[8] = {ta[0], ta[1], ta[2], ta[3], tb[0], tb[1], tb[2], tb[3]};
            const unsigned qw[4] = {qv[t].x, qv[t].y, qv[t].z, qv[t].w}, kw[4] = {kv[t].x, kv[t].y, kv[t].z, kv[t].w}; unsigned oq[4], oi[4], oe[4];
#pragma unroll
            for (int k = 0; k < 4; ++k) { const float e0 = __expf(b[2 * k]), e1 = __expf(b[2 * k + 1]), k0 = bflo(kw[k]), k1 = bfhi(kw[k]);
                oq[k] = pkbf(bflo(qw[k]) * e0, bfhi(qw[k]) * e1); oi[k] = pkbf(k0 * __expf(-b[2 * k]), k1 * __expf(-b[2 * k + 1])); oe[k] = pkbf(k0 * __expf(bl[2 * k] - b[2 * k]), k1 * __expf(bl[2 * k + 1] - b[2 * k + 1])); }
            const size_t o = (size_t)(rw + t) * DM_ + col;
            *(u32x4*)(QD + o) = (u32x4){oq[0], oq[1], oq[2], oq[3]}; *(u32x4*)(KI + o) = (u32x4){oi[0], oi[1], oi[2], oi[3]}; *(u32x4*)(KE + o) = (u32x4){oe[0], oe[1], oe[2], oe[3]}; }
    }
    __syncthreads();
}
__device__ __forceinline__ int swz256(int r, int c) { return r * 256 + (((c ^ r) & 15) << 4); }
__device__ __forceinline__ bf16x8 frag_row_h(lptr base, int x0, int k0, int lane) { const int r = x0 + (lane & 15), c = (k0 >> 3) + (lane >> 4); return *(const LAS bf16x8*)(base + swz256(r, c)); }
__device__ __forceinline__ bf16x8 frag_tr_h(lptr base, int k0, int x0, int lane) {
    const int g = lane >> 4, i = lane & 15, q = i >> 2, pq = i & 3; const int r0 = k0 + 8 * g + q, c = (x0 + 4 * pq) >> 3, off = (pq & 1) * 8;
    const s16x4 lo = __builtin_bit_cast(s16x4, __builtin_amdgcn_ds_read_tr16_b64_v4i16((LAS v4i16_t*)(base + swz256(r0, c) + off)));
    const s16x4 hi = __builtin_bit_cast(s16x4, __builtin_amdgcn_ds_read_tr16_b64_v4i16((LAS v4i16_t*)(base + swz256(r0 + 4, c) + off)));
    return (bf16x8){lo[0], lo[1], lo[2], lo[3], hi[0], hi[1], hi[2], hi[3]};
}
__device__ __forceinline__ void hgrn_scan_phase(const Ctx& C, const bf16* QD, const bf16* KI, const bf16* KE, const bf16* HB, const float* EB, const float* st_in, bf16* Oh, float* st_out_p, float* st_out_s) {
    constexpr int PP = 160, PS = 288;
    lptr Ql0 = C.lds, KIl0 = Ql0 + 32768, KEl0 = KIl0 + 32768, Vl0 = KEl0 + 32768, Pl = Vl0 + 4096, Sl = Pl + 64 * PP;
    const bf16* const VH = HB + (WS_LF - WS_BIG) / 2;
    const int lane = C.lane, w = __builtin_amdgcn_readfirstlane(C.wave), fq = lane >> 4, ln = lane & 15, tid = C.tid;
    const int ti = w >> 1, si0 = 2 * (w & 1);
    for (int u = C.vcu; u < 256 + 2048; u += C.G) {
        int h, j, row0, nsteps, L, ch0; const float* sin_ = nullptr; float* sout;
        if (u < 256) { const int b = u >> 6; h = (u >> 3) & 7; j = u & 7; row0 = b * SEQ_; nsteps = 128; L = 64; ch0 = b * 128; sout = st_out_p + ((size_t)(b * 8 + h) * 128) * 128 + 16 * j; }
        else { const int su = u - 256, sb = su >> 6; h = (su >> 3) & 7; j = su & 7; row0 = MP + 16 * sb; nsteps = 1; L = 16; ch0 = 512 + sb; sin_ = st_in + ((size_t)(sb * 8 + h) * 128) * 128 + 16 * j; sout = st_out_s + ((size_t)(sb * 8 + h) * 128) * 128 + 16 * j; }
        f32x4 st;
#pragma unroll
        for (int i = 0; i < 4; ++i) st[i] = sin_ ? sin_[(size_t)(16 * w + 4 * fq + i) * 128 + ln] : 0.f;
        float mk[2][4];
        { const int t = 16 * ti + ln;
#pragma unroll
            for (int x = 0; x < 2; ++x)
#pragma unroll
                for (int i = 0; i < 4; ++i) { const int s = 16 * (si0 + x) + 4 * fq + i; mk[x][i] = (s <= t && s < L) ? 1.f : 0.f; } }
        unsigned toff[2];
#pragma unroll
        for (int i = 0; i < 2; ++i) { const int pi = 2 * w + i, r = 4 * pi + (lane >> 4), pc = lane & 15, c = (pc ^ r) & 15, rc = r < L ? r : L - 1; toff[i] = (unsigned)(rc * 128 + c * 8) * 2u; }
        const unsigned voff = (unsigned)((32 * (w & 1) + (lane >> 1)) * 16 + (lane & 1) * 8) * 2u; const bool vdo = w < 2 && L == 64;
        const float* const ebp = EB + (size_t)ch0 * DM_ + h * 128 + 16 * w + 4 * fq;
        __builtin_amdgcn_s_waitcnt(0); __builtin_amdgcn_s_barrier();
        if (L < 64) {
            if (tid < 128) { const int row = tid >> 1; u32x4 vv = {0u, 0u, 0u, 0u}; if (row < L) vv = *(const u32x4*)(VH + ((size_t)(h * 8 + j) * MT + row0 + row) * 16 + (tid & 1) * 8); *(LAS u32x4*)(Vl0 + tid * 16) = vv; } }
#define HG_DMA(n) do { const size_t o_ = ((size_t)h * MT + row0 + 64 * (n)) * 128; const int b_ = ((n) & 1) * 16384; _Pragma("unroll") for (int i_ = 0; i_ < 2; ++i_) { \
                dma16s<0>(QD + o_, toff[i_], Ql0 + b_ + (2 * w + i_) * 1024); dma16s<0>(KI + o_, toff[i_], KIl0 + b_ + (2 * w + i_) * 1024); } \
            if (vdo) dma16s<0>(VH + ((size_t)(h * 8 + j) * MT + row0 + 64 * (n)) * 16, voff, Vl0 + ((n) & 1) * 2048 + w * 1024); } while (0)
        HG_DMA(0);
        f32x4 e = *(const f32x4*)ebp, en = e;
        u32x2 ow = {0u, 0u}; bf16* const orow = Oh + (size_t)(row0 + 16 * w + ln) * DM_ + h * 128 + 16 * j + 4 * fq; const bool odo = w < 4 && 16 * w + ln < L;
        for (int n = 0; n < nsteps; ++n) {
            lptr Ql = Ql0 + (n & 1) * 16384, KIl = KIl0 + (n & 1) * 16384, Vl = Vl0 + (n & 1) * 2048;
            asm volatile("s_waitcnt vmcnt(0) lgkmcnt(0)" ::: "memory"); __builtin_amdgcn_s_barrier(); asm volatile("" ::: "memory");
            if (n > 0 && odo) *(u32x2*)(orow + (size_t)(n - 1) * (64 * DM_)) = ow;
            if (n + 1 < nsteps) { HG_DMA(n + 1); en = *(const f32x4*)(ebp + (size_t)(n + 1) * DM_); }
            { bf16x8 qf[4], kf0[4], kf1[4];
#pragma unroll
                for (int ks = 0; ks < 4; ++ks) { qf[ks] = frag_row_h(Ql, 16 * ti, 32 * ks, lane); kf0[ks] = frag_row_h(KIl, 16 * si0, 32 * ks, lane); kf1[ks] = frag_row_h(KIl, 16 * si0 + 16, 32 * ks, lane); }
                __builtin_amdgcn_sched_barrier(0);
                f32x4 a0 = {0.f, 0.f, 0.f, 0.f}, a1 = a0, a2 = a0, a3 = a0;
#pragma unroll
                for (int ks = 0; ks < 4; ks += 2) { a0 = mma32(kf0[ks], qf[ks], a0); a1 = mma32(kf1[ks], qf[ks], a1); a2 = mma32(kf0[ks + 1], qf[ks + 1], a2); a3 = mma32(kf1[ks + 1], qf[ks + 1], a3); }
                { const u32x2 sw = {pkbf(st[0], st[1]), pkbf(st[2], st[3])}; *(LAS u32x2*)(Sl + ln * PS + (16 * w + 4 * fq) * 2) = sw; }
                a0 = a0 + a2; a1 = a1 + a3;
                const int t = 16 * ti + ln;
#pragma unroll
                for (int x = 0; x < 2; ++x) { const f32x4 a = x ? a1 : a0; const int sb0 = 16 * (si0 + x) + 4 * fq;
                    const u32x2 pw = {pkbf(a[0] * mk[x][0], a[1] * mk[x][1]), pkbf(a[2] * mk[x][2], a[3] * mk[x][3])}; *(LAS u32x2*)(Pl + t * PP + sb0 * 2) = pw; } }
            asm volatile("s_waitcnt lgkmcnt(0)" ::: "memory"); __builtin_amdgcn_s_barrier(); asm volatile("" ::: "memory");
            { bf16x8 ka[2], vb[2];
#pragma unroll
                for (int ks = 0; ks < 2; ++ks) { ka[ks] = frag_tr_h(KIl, 32 * ks, 16 * w, lane); vb[ks] = frag_tr(Vl, 32, 32 * ks, 0, lane); }
                if (w < 4) { bf16x8 sf[4], q2[4], pf[2];
#pragma unroll
                    for (int ks = 0; ks < 4; ++ks) { sf[ks] = frag_row(Sl, PS, 0, 32 * ks, lane); q2[ks] = frag_row_h(Ql, 16 * w, 32 * ks, lane); }
#pragma unroll
                    for (int ks = 0; ks < 2; ++ks) pf[ks] = frag_row(Pl, PP, 16 * w, 32 * ks, lane);
                    __builtin_amdgcn_sched_barrier(0);
                    f32x4 o = {0.f, 0.f, 0.f, 0.f}, o2 = o, o3 = o;
#pragma unroll
                    for (int ks = 0; ks < 2; ++ks) o = mma32(vb[ks], pf[ks], o);
#pragma unroll
                    for (int ks = 0; ks < 4; ks += 2) { o2 = mma32(sf[ks], q2[ks], o2); o3 = mma32(sf[ks + 1], q2[ks + 1], o3); }
                    o = o + o2 + o3;
                    ow = (u32x2){pkbf(o[0], o[1]), pkbf(o[2], o[3])}; }
                f32x4 a = st;
#pragma unroll
                for (int ks = 0; ks < 2; ++ks) a = mma32(ka[ks], vb[ks], a);
                st = a * e; e = en; }
        }
#undef HG_DMA
        if (odo) *(u32x2*)(orow + (size_t)(nsteps - 1) * (64 * DM_)) = ow;
#pragma unroll
        for (int i = 0; i < 4; ++i) sout[(size_t)(16 * w + 4 * fq + i) * 128 + ln] = st[i];
    }
    asm volatile("s_waitcnt vmcnt(0) lgkmcnt(0)" ::: "memory"); __syncthreads();
}
__device__ __forceinline__ void hgrn_post_phase(const Ctx& C, const bf16* Oh, const bf16* HB, const float* ng, bf16* A4) {
    const int lane = C.lane, c0 = lane * 16; float g[16];
#pragma unroll
    for (int j = 0; j < 16; ++j) g[j] = ng[c0 + j];
    u32x4 o0n, o1n, g0n, g1n;
#define HP_LOAD(mm) do { const u32x4* op_ = (const u32x4*)(Oh + (size_t)(mm) * DM_ + c0); const u32x4* gp_ = (const u32x4*)(HB + (size_t)(mm) * 4096 + 3072 + c0); o0n = op_[0]; o1n = op_[1]; g0n = gp_[0]; g1n = gp_[1]; } while (0)
    int m = C.gw;
    if (m < MT) HP_LOAD(m);
    for (; m < MT; m += C.NGW) {
        const u32x4 o0 = o0n, o1 = o1n, g0 = g0n, g1 = g1n;
        if (m + C.NGW < MT) HP_LOAD(m + C.NGW);
        const unsigned ow[8] = {o0.x, o0.y, o0.z, o0.w, o1.x, o1.y, o1.z, o1.w}, gw8[8] = {g0.x, g0.y, g0.z, g0.w, g1.x, g1.y, g1.z, g1.w};
        float ss = 0.f;
#pragma unroll
        for (int k = 0; k < 8; ++k) { const float a = bflo(ow[k]), b = bfhi(ow[k]); ss += a * a + b * b; }
        ss += __shfl_xor(ss, 1); ss += __shfl_xor(ss, 2); ss += __shfl_xor(ss, 4);
        const float rstd = 1.0f / sqrtf(ss * (1.0f / 128.0f) + EPS_); unsigned r[8];
#pragma unroll
        for (int k = 0; k < 8; ++k) r[k] = pkbf(bflo(ow[k]) * rstd * g[2 * k] * bflo(gw8[k]), bfhi(ow[k]) * rstd * g[2 * k + 1] * bfhi(gw8[k]));
        u32x4* ap = (u32x4*)(A4 + (size_t)m * DM_ + c0); ap[0] = (u32x4){r[0], r[1], r[2], r[3]}; ap[1] = (u32x4){r[4], r[5], r[6], r[7]};
    }
#undef HP_LOAD
}
constexpr int N_PHASES = 32;
struct Args { const float* in[29]; float* outp; unsigned char* wsp; int ph_lo, ph_hi, li, pad; };
typedef __attribute__((address_space(4))) const Args* kargs_t;
__device__ __forceinline__ kargs_t KA() { kargs_t p = (kargs_t)__builtin_amdgcn_kernarg_segment_ptr(); asm volatile("" : "+s"(p)); return p; }
__global__ void __launch_bounds__(NWAVES * 64, 2) hybrid_fwd(Args args) {
    extern __shared__ __attribute__((aligned(16))) unsigned char lds[];
    const int wave0 = __builtin_amdgcn_readfirstlane((int)threadIdx.x >> 6);
    Ctx C = mk_ctx((lptr)lds, wave0);
    gu32* ctl = (gu32*)(KA()->wsp + WS_CTL);
    for (int u = threadIdx.x; u < (LDS_BYTES - LDSCTL_OFF) / 4; u += NWAVES * 64) ((LAS unsigned*)(C.lds + LDSCTL_OFF))[u] = 0u;
    __syncthreads();
    const int lo = KA()->ph_lo, hi = KA()->ph_hi;
    XcdBarrier bar; bar.bar = (unsigned*)(ctl + CW_BAR) + KA()->li * XCD_BAR_WORDS; bar.x = 0; bar.st = nullptr;
    if (hi - lo > 1) bar = xcd_barrier_post((unsigned*)(ctl + CW_BAR) + KA()->li * XCD_BAR_WORDS, (volatile LAS unsigned*)(C.lds + MISC_OFF) + 8, C.tid == 0);
#define IN_(i) (KA()->in[i])
#define OUT_ (KA()->outp)
#define WS_ (KA()->wsp)
#define x_p IN_(0)
#define x_s IN_(1)
#define cache_k IN_(2)
#define cache_v IN_(3)
#define st_ret IN_(4)
#define st_hg IN_(5)
#define ngain IN_(10)
#define out OUT_
#define ws WS_
#define stats ((float*)(WS_ + WS_STATP))
#define mod ((float*)(WS_ + WS_MOD))
#define tab ((float*)(WS_ + WS_TAB))
#define lbw ((float*)(WS_ + WS_LB))
#define Hb ((bf16*)(WS_ + WS_H))
#define Xbf ((bf16*)(WS_ + WS_XB))
#define Fb ((bf16*)(WS_ + WS_F))
#define BIG ((bf16*)(WS_ + WS_BIG))
#define B2 ((bf16*)(WS_ + WS_B2))
#define B3 ((bf16*)(WS_ + WS_B3))
#define LF ((float*)(WS_ + WS_LF))
#define QD ((bf16*)(WS_ + WS_QD))
#define KI ((bf16*)(WS_ + WS_KI))
#define KE ((bf16*)(WS_ + WS_KE))
#define EB ((float*)(WS_ + WS_EB))
#define Qb BIG
#define Kb (BIG + (size_t)MT * DM_)
#define Vb (BIG + (size_t)2 * MT * DM_)
    int pid = 0;
#ifndef REPP
#define REPP (-1)
#endif
#define PH_ACTIVE (lo <= pid && pid < hi)
#define PH_ON PH_ACTIVE) for (int rep_ = (pid == REPP ? 2 : 1); rep_ > 0; --rep_) if (((C = mk_ctx((lptr)lds, wave0)), true)
#define GEMM_F_PHASE(Aptr, Wptr, KK) do { pg8::Gemm g_{(const pg8::bf16_t*)(Aptr), (const pg8::bf16_t*)(Wptr), MT, 1024, (KK), (KK) / 64}; FOrder S_; S_.P.init(MP, 1024, C.G, (int)blockIdx.x); S_.nsub = 8 * ((KK) / 256); S_.G = C.G; S_.c = (int)blockIdx.x; \
        EpiF E_{Fb, (float*)(WS_ + WS_PART)}; pg8::gemm_phase<EpiF, FOrder, true, true>(C.lds, g_, S_, E_, C.tid); } while (0)
#define BG_FFN(nb, lay) do { const Ctx Cq_ = mk_ctx((lptr)lds, wave0); bg_transpose(Cq_, (nb), IN_(27) + (size_t)(lay) * 1024 * 5632, 1024, 5632, (bf16*)(ws + W_FIN + (lay) * FIN_STRIDE), 1); \
        bg_transpose(Cq_, (nb), IN_(28) + (size_t)(lay) * 2816 * 1024, 2816, 1024, (bf16*)(ws + W_FOUT + (lay) * FOUT_STRIDE), 0); } while (0)
#define BG_MIX(nb, wi, Ki, Ni, di, wo_, Ko, No, do_, md) do { const Ctx Cq_ = mk_ctx((lptr)lds, wave0); bg_transpose(Cq_, (nb), IN_(wi), Ki, Ni, (bf16*)(ws + (di)), (md)); bg_transpose(Cq_, (nb), IN_(wo_), Ko, No, (bf16*)(ws + (do_)), 0); } while (0)
#define PH_DONE do { if (lo <= pid && pid + 1 < hi) { const Ctx Cb_ = mk_ctx((lptr)lds, wave0); xcd_barrier(bar, Cb_.tid == 0); } ++pid; } while (0)
#define GEMM_PHASE(EPI, Aptr, Wptr, NN, KK, Eobj) do { pg8::Gemm g_{(const pg8::bf16_t*)(Aptr), (const pg8::bf16_t*)(Wptr), MT, (NN), (KK), (KK) / 64}; pg8::StaticOrder S_; S_.init(MT, (NN), C.G, (int)blockIdx.x); \
        pg8::gemm_phase<EPI, pg8::StaticOrder, true, true>(C.lds, g_, S_, Eobj, C.tid); } while (0)

    if (PH_ON) {
        p0_adaln(C, IN_(6), IN_(7), IN_(8), IN_(9), mod);
        p0_tables(C, tab, lbw, IN_(26));
        p0_transpose(C, IN_(11), 1024, 6144, (bf16*)(ws + W_GIN), 0);
        p0_transpose(C, IN_(16), 3072, 1024, (bf16*)(ws + W_GOUT), 0);
    }
    PH_DONE;
    if (PH_ON) resnorm_phase<false, true, true, false>(C, x_p, x_s, nullptr, nullptr, nullptr, nullptr, mod, nullptr, 0, Hb, ngain, 0, 1024);
    PH_DONE;

    { constexpr int l = 0;
        const int ngo = l * 4096; const int mbase = l * 36 * 6144;
        if (l == 0) {
            if (PH_ON) { EpiGelu E{BIG, stats}; GEMM_PHASE(EpiGelu, Hb, ws + W_GIN, 6144, 1024, E); BG_FFN(48, 0); BG_MIX(48, 17, 1024, 3072, W_DIN, 20, 1024, 1024, W_DOUT, 0); }
            PH_DONE;
            if (PH_ON) gmlp_gate_phase(C, BIG, stats, IN_(12), IN_(13), IN_(14), IN_(15), B2, out + O_GV);
            PH_DONE;
        } else if (l == 1) {
            if (PH_ON) { EpiDiff E{Qb, out + O_KDP, out + O_KDS, attn_body::C2}; GEMM_PHASE(EpiDiff, Hb, ws + W_DIN, 3072, 1024, E); BG_FFN(24, 1); BG_MIX(24, 21, 1024, 6144, W_RIN, 22, 2048, 1024, W_ROUT, 0); }
            PH_DONE;
            if (PH_ON) {
                const attn_body::AttnTensors AT{(const attn_body::bf16*)Qb, (const attn_body::bf16*)Kb, (const attn_body::bf16*)Vb, (attn_body::bf16*)B2};
                const attn_body::StaticOrder S((int)C.G, (int)blockIdx.x);
                const float lam_ = __uint_as_float((unsigned)__builtin_amdgcn_readfirstlane((int)__float_as_uint(diff_lambda(IN_(18), C.lane))));
                const attn_body::AttnFuse FU{(attn_body::bf16*)B3, lam_, IN_(19)};
                attn_body::attn_phase<attn_body::StaticOrder>((char*)lds, AT, S, C.tid, FU);
                __syncthreads();
                { const Ctx Cs = mk_ctx((lptr)lds, wave0); diff_sample_phase(Cs, Qb, cache_k, cache_v, out + O_KDS, out + O_VDS, lam_, IN_(19), B3); }
            }
            PH_DONE;
        } else if (l == 2) {
            if (PH_ON) { EpiRet E{BIG, tab}; GEMM_PHASE(EpiRet, Hb, ws + W_RIN, 6144, 1024, E); BG_FFN(48, 2); BG_MIX(48, 23, 1024, 4096, W_HIN, 25, 1024, 1024, W_HOUT, 2); }
            PH_DONE;
            if (PH_ON) ret_scan_phase(C, BIG, st_ret, B2, out + O_RSP, out + O_RSS, RETPROBE != 0 && rep_ == 2);
            PH_DONE;
            if (PH_ON) ret_post_phase(C, B2, BIG, B3);
            PH_DONE;
        } else {
            if (PH_ON) { EpiHgrn E{BIG, QD, KI, KE, EB, lbw}; GEMM_PHASE(EpiHgrn, Hb, ws + W_HIN, 4096, 1024, E); BG_FFN(32, 3); }
            PH_DONE;
            if (PH_ON) hgrn_scan_phase(C, QD, KI, KE, BIG, EB, st_hg, B2, out + O_HSP, out + O_HSS);
            PH_DONE;
            if (PH_ON) hgrn_post_phase(C, B2, BIG, IN_(24), B3);
            PH_DONE;
        }
        if (PH_ON) { const bf16* Am = l == 0 ? B2 : B3; const size_t wo = l == 0 ? W_GOUT : (l == 1 ? W_DOUT : (l == 2 ? W_ROUT : W_HOUT)); const int Km = l == 0 ? 3072 : (l == 2 ? 2048 : 1024);
            GEMM_F_PHASE(Am, ws + wo, Km); }
        PH_DONE;
        if (l == 0) { if (PH_ON) resnorm_phase<true, true, true, false>(C, x_p, x_s, nullptr, Fb, nullptr, Xbf, mod, ngain + ngo + 1024, mbase + 2 * 1024, Hb, ngain + ngo + 2048, mbase + 3 * 1024, mbase + 4 * 1024, (const float*)(WS_ + WS_PART), 3072 / 256); }
        else { if (PH_ON) resnorm_phase<true, true, false, false>(C, nullptr, nullptr, Xbf, Fb, nullptr, Xbf, mod, ngain + ngo + 1024, mbase + 2 * 1024, Hb, ngain + ngo + 2048, mbase + 3 * 1024, mbase + 4 * 1024, (const float*)(WS_ + WS_PART), (l == 2 ? 2048 : 1024) / 256); }
        PH_DONE;
        if (PH_ON) { EpiSwiglu E{B2}; GEMM_PHASE(EpiSwiglu, Hb, ws + W_FIN + l * FIN_STRIDE, 5632, 1024, E); }
        PH_DONE;
        if (PH_ON) { GEMM_F_PHASE(B2, ws + W_FOUT + l * FOUT_STRIDE, FFH); }
        PH_DONE;
        if (l < 3) { if (PH_ON) resnorm_phase<true, true, false, false>(C, nullptr, nullptr, Xbf, Fb, nullptr, Xbf, mod, ngain + ngo + 3072, mbase + 5 * 1024, Hb, ngain + ngo + 4096, mbase + 36 * 6144, mbase + 36 * 6144 + 1024, (const float*)(WS_ + WS_PART), FFH / 256); }
        else { if (PH_ON) resnorm_phase<true, false, false, true>(C, nullptr, nullptr, Xbf, Fb, out, nullptr, mod, ngain + ngo + 3072, mbase + 5 * 1024, nullptr, nullptr, 0, 0, (const float*)(WS_ + WS_PART), FFH / 256); }
        PH_DONE;
    }
    { constexpr int l = 1;
        const int ngo = l * 4096; const int mbase = l * 36 * 6144;
        if (l == 0) {
            if (PH_ON) { EpiGelu E{BIG, stats}; GEMM_PHASE(EpiGelu, Hb, ws + W_GIN, 6144, 1024, E); BG_FFN(48, 0); BG_MIX(48, 17, 1024, 3072, W_DIN, 20, 1024, 1024, W_DOUT, 0); }
            PH_DONE;
            if (PH_ON) gmlp_gate_phase(C, BIG, stats, IN_(12), IN_(13), IN_(14), IN_(15), B2, out + O_GV);
            PH_DONE;
        } else if (l == 1) {
            if (PH_ON) { EpiDiff E{Qb, out + O_KDP, out + O_KDS, attn_body::C2}; GEMM_PHASE(EpiDiff, Hb, ws + W_DIN, 3072, 1024, E); BG_FFN(24, 1); BG_MIX(24, 21, 1024, 6144, W_RIN, 22, 2048, 1024, W_ROUT, 0); }
            PH_DONE;
            if (PH_ON) {
                const attn_body::AttnTensors AT{(const attn_body::bf16*)Qb, (const attn_body::bf16*)Kb, (const attn_body::bf16*)Vb, (attn_body::bf16*)B2};
                const attn_body::StaticOrder S((int)C.G, (int)blockIdx.x);
                const float lam_ = __uint_as_float((unsigned)__builtin_amdgcn_readfirstlane((int)__float_as_uint(diff_lambda(IN_(18), C.lane))));
                const attn_body::AttnFuse FU{(attn_body::bf16*)B3, lam_, IN_(19)};
                attn_body::attn_phase<attn_body::StaticOrder>((char*)lds, AT, S, C.tid, FU);
                __syncthreads();
                { const Ctx Cs = mk_ctx((lptr)lds, wave0); diff_sample_phase(Cs, Qb, cache_k, cache_v, out + O_KDS, out + O_VDS, lam_, IN_(19), B3); }
            }
            PH_DONE;
        } else if (l == 2) {
            if (PH_ON) { EpiRet E{BIG, tab}; GEMM_PHASE(EpiRet, Hb, ws + W_RIN, 6144, 1024, E); BG_FFN(48, 2); BG_MIX(48, 23, 1024, 4096, W_HIN, 25, 1024, 1024, W_HOUT, 2); }
            PH_DONE;
            if (PH_ON) ret_scan_phase(C, BIG, st_ret, B2, out + O_RSP, out + O_RSS, RETPROBE != 0 && rep_ == 2);
            PH_DONE;
            if (PH_ON) ret_post_phase(C, B2, BIG, B3);
            PH_DONE;
        } else {
            if (PH_ON) { EpiHgrn E{BIG, QD, KI, KE, EB, lbw}; GEMM_PHASE(EpiHgrn, Hb, ws + W_HIN, 4096, 1024, E); BG_FFN(32, 3); }
            PH_DONE;
            if (PH_ON) hgrn_scan_phase(C, QD, KI, KE, BIG, EB, st_hg, B2, out + O_HSP, out + O_HSS);
            PH_DONE;
            if (PH_ON) hgrn_post_phase(C, B2, BIG, IN_(24), B3);
            PH_DONE;
        }
        if (PH_ON) { const bf16* Am = l == 0 ? B2 : B3; const size_t wo = l == 0 ? W_GOUT : (l == 1 ? W_DOUT : (l == 2 ? W_ROUT : W_HOUT)); const int Km = l == 0 ? 3072 : (l == 2 ? 2048 : 1024);
            GEMM_F_PHASE(Am, ws + wo, Km); }
        PH_DONE;
        if (l == 0) { if (PH_ON) resnorm_phase<true, true, true, false>(C, x_p, x_s, nullptr, Fb, nullptr, Xbf, mod, ngain + ngo + 1024, mbase + 2 * 1024, Hb, ngain + ngo + 2048, mbase + 3 * 1024, mbase + 4 * 1024, (const float*)(WS_ + WS_PART), 3072 / 256); }
        else { if (PH_ON) resnorm_phase<true, true, false, false>(C, nullptr, nullptr, Xbf, Fb, nullptr, Xbf, mod, ngain + ngo + 1024, mbase + 2 * 1024, Hb, ngain + ngo + 2048, mbase + 3 * 1024, mbase + 4 * 1024, (const float*)(WS_ + WS_PART), (l == 2 ? 2048 : 1024) / 256); }
        PH_DONE;
        if (PH_ON) { EpiSwiglu E{B2}; GEMM_PHASE(EpiSwiglu, Hb, ws + W_FIN + l * FIN_STRIDE, 5632, 1024, E); }
        PH_DONE;
        if (PH_ON) { GEMM_F_PHASE(B2, ws + W_FOUT + l * FOUT_STRIDE, FFH); }
        PH_DONE;
        if (l < 3) { if (PH_ON) resnorm_phase<true, true, false, false>(C, nullptr, nullptr, Xbf, Fb, nullptr, Xbf, mod, ngain + ngo + 3072, mbase + 5 * 1024, Hb, ngain + ngo + 4096, mbase + 36 * 6144, mbase + 36 * 6144 + 1024, (const float*)(WS_ + WS_PART), FFH / 256); }
        else { if (PH_ON) resnorm_phase<true, false, false, true>(C, nullptr, nullptr, Xbf, Fb, out, nullptr, mod, ngain + ngo + 3072, mbase + 5 * 1024, nullptr, nullptr, 0, 0, (const float*)(WS_ + WS_PART), FFH / 256); }
        PH_DONE;
    }
    { constexpr int l = 2;
        const int ngo = l * 4096; const int mbase = l * 36 * 6144;
        if (l == 0) {
            if (PH_ON) { EpiGelu E{BIG, stats}; GEMM_PHASE(EpiGelu, Hb, ws + W_GIN, 6144, 1024, E); BG_FFN(48, 0); BG_MIX(48, 17, 1024, 3072, W_DIN, 20, 1024, 1024, W_DOUT, 0); }
            PH_DONE;
            if (PH_ON) gmlp_gate_phase(C, BIG, stats, IN_(12), IN_(13), IN_(14), IN_(15), B2, out + O_GV);
            PH_DONE;
        } else if (l == 1) {
            if (PH_ON) { EpiDiff E{Qb, out + O_KDP, out + O_KDS, attn_body::C2}; GEMM_PHASE(EpiDiff, Hb, ws + W_DIN, 3072, 1024, E); BG_FFN(24, 1); BG_MIX(24, 21, 1024, 6144, W_RIN, 22, 2048, 1024, W_ROUT, 0); }
            PH_DONE;
            if (PH_ON) {
                const attn_body::AttnTensors AT{(const attn_body::bf16*)Qb, (const attn_body::bf16*)Kb, (const attn_body::bf16*)Vb, (attn_body::bf16*)B2};
                const attn_body::StaticOrder S((int)C.G, (int)blockIdx.x);
                const float lam_ = __uint_as_float((unsigned)__builtin_amdgcn_readfirstlane((int)__float_as_uint(diff_lambda(IN_(18), C.lane))));
                const attn_body::AttnFuse FU{(attn_body::bf16*)B3, lam_, IN_(19)};
                attn_body::attn_phase<attn_body::StaticOrder>((char*)lds, AT, S, C.tid, FU);
                __syncthreads();
                { const Ctx Cs = mk_ctx((lptr)lds, wave0); diff_sample_phase(Cs, Qb, cache_k, cache_v, out + O_KDS, out + O_VDS, lam_, IN_(19), B3); }
            }
            PH_DONE;
        } else if (l == 2) {
            if (PH_ON) { EpiRet E{BIG, tab}; GEMM_PHASE(EpiRet, Hb, ws + W_RIN, 6144, 1024, E); BG_FFN(48, 2); BG_MIX(48, 23, 1024, 4096, W_HIN, 25, 1024, 1024, W_HOUT, 2); }
            PH_DONE;
            if (PH_ON) ret_scan_phase(C, BIG, st_ret, B2, out + O_RSP, out + O_RSS, RETPROBE != 0 && rep_ == 2);
            PH_DONE;
            if (PH_ON) ret_post_phase(C, B2, BIG, B3);
            PH_DONE;
        } else {
            if (PH_ON) { EpiHgrn E{BIG, QD, KI, KE, EB, lbw}; GEMM_PHASE(EpiHgrn, Hb, ws + W_HIN, 4096, 1024, E); BG_FFN(32, 3); }
            PH_DONE;
            if (PH_ON) hgrn_scan_phase(C, QD, KI, KE, BIG, EB, st_hg, B2, out + O_HSP, out + O_HSS);
            PH_DONE;
            if (PH_ON) hgrn_post_phase(C, B2, BIG, IN_(24), B3);
            PH_DONE;
        }
        if (PH_ON) { const bf16* Am = l == 0 ? B2 : B3; const size_t wo = l == 0 ? W_GOUT : (l == 1 ? W_DOUT : (l == 2 ? W_ROUT : W_HOUT)); const int Km = l == 0 ? 3072 : (l == 2 ? 2048 : 1024);
            GEMM_F_PHASE(Am, ws + wo, Km); }
        PH_DONE;
        if (l == 0) { if (PH_ON) resnorm_phase<true, true, true, false>(C, x_p, x_s, nullptr, Fb, nullptr, Xbf, mod, ngain + ngo + 1024, mbase + 2 * 1024, Hb, ngain + ngo + 2048, mbase + 3 * 1024, mbase + 4 * 1024, (const float*)(WS_ + WS_PART), 3072 / 256); }
        else { if (PH_ON) resnorm_phase<true, true, false, false>(C, nullptr, nullptr, Xbf, Fb, nullptr, Xbf, mod, ngain + ngo + 1024, mbase + 2 * 1024, Hb, ngain + ngo + 2048, mbase + 3 * 1024, mbase + 4 * 1024, (const float*)(WS_ + WS_PART), (l == 2 ? 2048 : 1024) / 256); }
        PH_DONE;
        if (PH_ON) { EpiSwiglu E{B2}; GEMM_PHASE(EpiSwiglu, Hb, ws + W_FIN + l * FIN_STRIDE, 5632, 1024, E); }
        PH_DONE;
        if (PH_ON) { GEMM_F_PHASE(B2, ws + W_FOUT + l * FOUT_STRIDE, FFH); }
        PH_DONE;
        if (l < 3) { if (PH_ON) resnorm_phase<true, true, false, false>(C, nullptr, nullptr, Xbf, Fb, nullptr, Xbf, mod, ngain + ngo + 3072, mbase + 5 * 1024, Hb, ngain + ngo + 4096, mbase + 36 * 6144, mbase + 36 * 6144 + 1024, (const float*)(WS_ + WS_PART), FFH / 256); }
        else { if (PH_ON) resnorm_phase<true, false, false, true>(C, nullptr, nullptr, Xbf, Fb, out, nullptr, mod, ngain + ngo + 3072, mbase + 5 * 1024, nullptr, nullptr, 0, 0, (const float*)(WS_ + WS_PART), FFH / 256); }
        PH_DONE;
    }
    { constexpr int l = 3;
        const int ngo = l * 4096; const int mbase = l * 36 * 6144;
        if (l == 0) {
            if (PH_ON) { EpiGelu E{BIG, stats}; GEMM_PHASE(EpiGelu, Hb, ws + W_GIN, 6144, 1024, E); BG_FFN(48, 0); BG_MIX(48, 17, 1024, 3072, W_DIN, 20, 1024, 1024, W_DOUT, 0); }
            PH_DONE;
            if (PH_ON) gmlp_gate_phase(C, BIG, stats, IN_(12), IN_(13), IN_(14), IN_(15), B2, out + O_GV);
            PH_DONE;
        } else if (l == 1) {
            if (PH_ON) { EpiDiff E{Qb, out + O_KDP, out + O_KDS, attn_body::C2}; GEMM_PHASE(EpiDiff, Hb, ws + W_DIN, 3072, 1024, E); BG_FFN(24, 1); BG_MIX(24, 21, 1024, 6144, W_RIN, 22, 2048, 1024, W_ROUT, 0); }
            PH_DONE;
            if (PH_ON) {
                const attn_body::AttnTensors AT{(const attn_body::bf16*)Qb, (const attn_body::bf16*)Kb, (const attn_body::bf16*)Vb, (attn_body::bf16*)B2};
                const attn_body::StaticOrder S((int)C.G, (int)blockIdx.x);
                const float lam_ = __uint_as_float((unsigned)__builtin_amdgcn_readfirstlane((int)__float_as_uint(diff_lambda(IN_(18), C.lane))));
                const attn_body::AttnFuse FU{(attn_body::bf16*)B3, lam_, IN_(19)};
                attn_body::attn_phase<attn_body::StaticOrder>((char*)lds, AT, S, C.tid, FU);
                __syncthreads();
                { const Ctx Cs = mk_ctx((lptr)lds, wave0); diff_sample_phase(Cs, Qb, cache_k, cache_v, out + O_KDS, out + O_VDS, lam_, IN_(19), B3); }
            }
            PH_DONE;
        } else if (l == 2) {
            if (PH_ON) { EpiRet E{BIG, tab}; GEMM_PHASE(EpiRet, Hb, ws + W_RIN, 6144, 1024, E); BG_FFN(48, 2); BG_MIX(48, 23, 1024, 4096, W_HIN, 25, 1024, 1024, W_HOUT, 2); }
            PH_DONE;
            if (PH_ON) ret_scan_phase(C, BIG, st_ret, B2, out + O_RSP, out + O_RSS, RETPROBE != 0 && rep_ == 2);
            PH_DONE;
            if (PH_ON) ret_post_phase(C, B2, BIG, B3);
            PH_DONE;
        } else {
            if (PH_ON) { EpiHgrn E{BIG, QD, KI, KE, EB, lbw}; GEMM_PHASE(EpiHgrn, Hb, ws + W_HIN, 4096, 1024, E); BG_FFN(32, 3); }
            PH_DONE;
            if (PH_ON) hgrn_scan_phase(C, QD, KI, KE, BIG, EB, st_hg, B2, out + O_HSP, out + O_HSS);
            PH_DONE;
            if (PH_ON) hgrn_post_phase(C, B2, BIG, IN_(24), B3);
            PH_DONE;
        }
        if (PH_ON) { const bf16* Am = l == 0 ? B2 : B3; const size_t wo = l == 0 ? W_GOUT : (l == 1 ? W_DOUT : (l == 2 ? W_ROUT : W_HOUT)); const int Km = l == 0 ? 3072 : (l == 2 ? 2048 : 1024);
            GEMM_F_PHASE(Am, ws + wo, Km); }
        PH_DONE;
        if (l == 0) { if (PH_ON) resnorm_phase<true, true, true, false>(C, x_p, x_s, nullptr, Fb, nullptr, Xbf, mod, ngain + ngo + 1024, mbase + 2 * 1024, Hb, ngain + ngo + 2048, mbase + 3 * 1024, mbase + 4 * 1024, (const float*)(WS_ + WS_PART), 3072 / 256); }
        else { if (PH_ON) resnorm_phase<true, true, false, false>(C, nullptr, nullptr, Xbf, Fb, nullptr, Xbf, mod, ngain + ngo + 1024, mbase + 2 * 1024, Hb, ngain + ngo + 2048, mbase + 3 * 1024, mbase + 4 * 1024, (const float*)(WS_ + WS_PART), (l == 2 ? 2048 : 1024) / 256); }
        PH_DONE;
        if (PH_ON) { EpiSwiglu E{B2}; GEMM_PHASE(EpiSwiglu, Hb, ws + W_FIN + l * FIN_STRIDE, 5632, 1024, E); }
        PH_DONE;
        if (PH_ON) { GEMM_F_PHASE(B2, ws + W_FOUT + l * FOUT_STRIDE, FFH); }
        PH_DONE;
        if (l < 3) { if (PH_ON) resnorm_phase<true, true, false, false>(C, nullptr, nullptr, Xbf, Fb, nullptr, Xbf, mod, ngain + ngo + 3072, mbase + 5 * 1024, Hb, ngain + ngo + 4096, mbase + 36 * 6144, mbase + 36 * 6144 + 1024, (const float*)(WS_ + WS_PART), FFH / 256); }
        else { if (PH_ON) resnorm_phase<true, false, false, true>(C, nullptr, nullptr, Xbf, Fb, out, nullptr, mod, ngain + ngo + 3072, mbase + 5 * 1024, nullptr, nullptr, 0, 0, (const float*)(WS_ + WS_PART), FFH / 256); }
        PH_DONE;
    }
#undef PH_ON
#undef PH_DONE
#undef GEMM_PHASE
#undef BG_FFN
#undef BG_MIX
#undef GEMM_F_PHASE
#undef x_p
#undef x_s
#undef cache_k
#undef cache_v
#undef st_ret
#undef st_hg
#undef ngain
#undef out
#undef ws
#undef stats
#undef mod
#undef tab
#undef lbw
#undef Hb
#undef Xbf
#undef Fb
#undef BIG
#undef B2
#undef B3
#undef LF
#undef QD
#undef KI
#undef KE
#undef EB
#undef Qb
#undef Kb
#undef Vb
}

#ifndef MK_SPLIT
#define MK_SPLIT 0
#endif
extern "C" void kernel_launch(void* const* d_in, const int* in_sizes, int n_in, void* d_out, int out_size, void* d_ws, size_t ws_size, hipStream_t stream) {
    static int grid = 0;
    if (grid == 0) {
        if (n_in != 29 || (size_t)out_size != O_END || ws_size < WS_END) { fprintf(stderr, "kernel_launch: unexpected shapes (n_in %d out %d ws %zu); nothing launched\n", n_in, out_size, ws_size); grid = -1; return; }
        int dev = 0, cus = 0, per_cu = 0;
        if (hipGetDevice(&dev) != hipSuccess || hipDeviceGetAttribute(&cus, hipDeviceAttributeMultiprocessorCount, dev) != hipSuccess) { grid = -1; return; }
        if (hipFuncSetAttribute((const void*)hybrid_fwd, hipFuncAttributeMaxDynamicSharedMemorySize, LDS_BYTES) != hipSuccess) { fprintf(stderr, "kernel_launch: hipFuncSetAttribute failed\n"); grid = -1; return; }
        if (hipOccupancyMaxActiveBlocksPerMultiprocessor(&per_cu, (const void*)hybrid_fwd, NWAVES * 64, LDS_BYTES) != hipSuccess || per_cu < 1) { fprintf(stderr, "kernel_launch: occupancy query reports %d blocks per CU\n", per_cu); }
        (void)hipGetLastError();
        grid = cus;
        if (grid != 256) { fprintf(stderr, "kernel_launch: built for 256 CUs, device has %d; nothing launched\n", cus); grid = -1; return; }
    }
    if (grid < 0) return;
    if (hipMemsetAsync((char*)d_ws + WS_CTL, 0, CTL_ZERO_BYTES, stream) != hipSuccess) return;
    Args a{};
    for (int i = 0; i < 29; ++i) a.in[i] = (const float*)d_in[i];
    a.outp = (float*)d_out; a.wsp = (unsigned char*)d_ws; a.pad = 0;
#if MK_SPLIT
    for (int p = 0; p < N_PHASES; ++p) { a.ph_lo = p; a.ph_hi = p + 1; a.li = 0; hipLaunchKernelGGL(hybrid_fwd, dim3(grid), dim3(NWAVES * 64), LDS_BYTES, stream, a); }
#else
    a.ph_lo = 0; a.ph_hi = N_PHASES; a.li = 0;
    hipLaunchKernelGGL(hybrid_fwd, dim3(grid), dim3(NWAVES * 64), LDS_BYTES, stream, a);
#endif
}
```

```cpp
#include <hip/hip_runtime.h>
#include <cstdio>
#include <cstdint>
__device__ __forceinline__ int fresh_tid(int wave_sgpr) { int w = wave_sgpr; asm volatile("" : "+s"(w)); int l; asm volatile("v_mbcnt_lo_u32_b32 %0, -1, 0\n\tv_mbcnt_hi_u32_b32 %0, -1, %0" : "=v"(l)); return w * 64 + l; }
namespace pg8 {
#define PG8_LAS __attribute__((address_space(3)))
typedef unsigned short bf16_t;
typedef short bf16x8 __attribute__((ext_vector_type(8)));
typedef float f32x4 __attribute__((ext_vector_type(4)));
typedef unsigned u32x4 __attribute__((ext_vector_type(4)));
constexpr int BM = 256, BK = 64, HALF = 128, HTB = HALF * BK * 2  , STAGE_BYTES = 8 * HTB, NXCD = 8, WGM = 8;

__host__ __device__ __forceinline__ int lds_byte(int r, int c) { const int st = (r >> 4) * 2 + (c >> 5), rr = r & 15, cc = c & 31, ob = rr * 64 + cc * 2; return st * 1024 + (ob ^ (((ob >> 9) & 1) << 5)); }
__host__ __device__ __forceinline__ void stage_rc(int b, int& R, int& C) { const int st = b / 1024, sb = b % 1024, swz = sb ^ (((sb >> 9) & 1) << 5); R = (st >> 1) * 16 + swz / 64; C = (st & 1) * 32 + (swz % 64) / 2; }
__host__ __device__ __forceinline__ int perm32(int rho) { const int n = rho >> 4, i = rho & 15; return 8 * (i >> 2) + 4 * n + (i & 3); }

struct Unit { int pm, pn, kb, nt; };
struct Gemm { const bf16_t* A; const bf16_t* Bt; int M, N, K, nt; };

struct StaticOrder {
    int nM, nN, nwg, G, c;
    __host__ __device__ void init(int M, int N, int G_, int c_) { nM = M / BM; nN = N / BM; nwg = nM * nN; G = G_; c = c_; }
    __host__ __device__ bool next(int i, Unit& u) const {
        const long L = (long)i * G + c; if (L >= nwg) return false;
        int wgid = (int)L; { const int q = nwg / NXCD, r = nwg % NXCD, xcd = wgid % NXCD, off = wgid / NXCD; wgid = (xcd < r ? xcd * (q + 1) : r * (q + 1) + (xcd - r) * q) + off; }
        const int nig = WGM * nN, gid = wgid / nig, fm = gid * WGM, gsz = (nM - fm) < WGM ? (nM - fm) : WGM;
        u.pm = fm + ((wgid % nig) % gsz); u.pn = (wgid % nig) / gsz; u.kb = 0; u.nt = 0; return true;
    }
    __device__ __forceinline__ void a_ready(const Unit&) const {}
    __device__ __forceinline__ void done(const Unit&) const {}
};

typedef float f32x2c_t __attribute__((ext_vector_type(2))); typedef __bf16 bf16x2c_t __attribute__((ext_vector_type(2)));
__device__ __forceinline__ unsigned cvt_pk_bf16(float lo, float hi) { const f32x2c_t v = {lo, hi}; const bf16x2c_t b = __builtin_convertvector(v, bf16x2c_t); return __builtin_bit_cast(unsigned, b); }
typedef float f32x2 __attribute__((ext_vector_type(2)));
__device__ __forceinline__ f32x2 gelu_pk(f32x2 v) {
    const f32x2 av = __builtin_elementwise_abs(v), d = av * 0.2316418882f + 1.0f;
    f32x2 t; t.x = __builtin_amdgcn_rcpf(d.x); t.y = __builtin_amdgcn_rcpf(d.y);
    f32x2 q = t * 0.5307027145f + (-0.7265760135f); q = q * t + 0.7107068705f; q = q * t + (-0.142248368f); q = q * t + 0.127414796f; q = q * t;
    const f32x2 s = (v * v) * (-0.72134752044f);
    f32x2 e; e.x = __builtin_amdgcn_exp2f(s.x); e.y = __builtin_amdgcn_exp2f(s.y);
    const f32x2 m = v * (q * e), r = v - m;
    f32x2 o; o.x = v.x < 0.f ? m.x : r.x; o.y = v.y < 0.f ? m.y : r.y; return o;
}
template <class Epi, class Sched, bool ALIGN_EPI = false, bool SP2 = false>
__device__ __forceinline__ void gemm_phase(PG8_LAS unsigned char* lds, const Gemm g, const Sched& S, const Epi& E, const int tid_in) {
    const int tid = tid_in, wid = __builtin_amdgcn_readfirstlane(tid >> 6), lane = tid & 63, wr = wid >> 2, wc = wid & 3, fr = lane & 15, fq = lane >> 4;
    const int K = g.K, nt = g.nt;
    unsigned voffA[2], voffB[2];
#pragma unroll
    for (int i = 0; i < 2; ++i) { int R, C; stage_rc(tid * 16 + i * 8192, R, C); const int Rb = Epi::PERM ? ((R & ~31) + perm32(R & 31)) : R;
        voffA[i] = (unsigned)(R * K + C) * 2u; voffB[i] = (unsigned)(Rb * K + C) * 2u; }
    const size_t kstep = (size_t)(BK * 2);
    const size_t hstep = (size_t)HALF * K * 2;
    const size_t tstep = 2 * hstep;
    const unsigned ldsw = (unsigned)wid * 1024u;
    const int aoff = lds_byte(wr * 64 + fr, fq * 8), boff = lds_byte(wc * 32 + fr, fq * 8);
#define PG8_SA(b, h) (((b) * 2 + (h)) * HTB)
#define PG8_SB(b, h) ((4 + (b) * 2 + (h)) * HTB)
#define PG8_STAGE(bufoff, gbase, voff) do { _Pragma("unroll") for (int _i = 0; _i < 2; ++_i) \
        __builtin_amdgcn_global_load_lds((const unsigned*)((const char*)(gbase) + (voff)[_i]), (PG8_LAS unsigned*)(lds + (bufoff) + ldsw + _i * 8192), 16, 0, 0); } while (0)
#define PG8_LDA(dst, b, h) do { _Pragma("unroll") for (int m = 0; m < 4; ++m) _Pragma("unroll") for (int k = 0; k < 2; ++k) dst[m][k] = *(const PG8_LAS bf16x8*)(lds + PG8_SA(b, h) + aoff + m * 2048 + k * 1024); } while (0)
#define PG8_LDB(dst, b, h) do { _Pragma("unroll") for (int n = 0; n < 2; ++n) _Pragma("unroll") for (int k = 0; k < 2; ++k) dst[n][k] = *(const PG8_LAS bf16x8*)(lds + PG8_SB(b, h) + boff + n * 2048 + k * 1024); } while (0)
#define PG8_MMA(ai, bj, At, Bt) do { __builtin_amdgcn_s_setprio(1); _Pragma("unroll") for (int m = 0; m < 4; ++m) _Pragma("unroll") for (int n = 0; n < 2; ++n) _Pragma("unroll") for (int k = 0; k < 2; ++k) \
        acc[ai][bj][m][n] = __builtin_amdgcn_mfma_f32_16x16x32_bf16(Bt[n][k], At[m][k], acc[ai][bj][m][n], 0, 0, 0); __builtin_amdgcn_s_setprio(0); } while (0)
#define PG8_WAIT_V(n) asm volatile("s_waitcnt vmcnt(" #n ")" ::: "memory")
#define PG8_WAIT_L(n) asm volatile("s_waitcnt lgkmcnt(" #n ")" ::: "memory")
#define PG8_BAR __builtin_amdgcn_s_barrier()
#define PG8_SCHED __builtin_amdgcn_sched_barrier(0)
    Unit cur, nxt; int ui = 0;
    if (!S.next(0, cur)) return;
    f32x4 acc[2][2][4][2];
#pragma unroll
    for (int a = 0; a < 2; ++a)
#pragma unroll
        for (int b = 0; b < 2; ++b)
#pragma unroll
            for (int m = 0; m < 4; ++m)
#pragma unroll
                for (int n = 0; n < 2; ++n) acc[a][b][m][n] = (f32x4){0.f, 0.f, 0.f, 0.f};
    bf16x8 At[4][2], B0[2][2], B1[2][2];
    const char* cA = (const char*)g.A + (size_t)cur.pm * tstep + cur.kb; const char* cB = (const char*)g.Bt + (size_t)cur.pn * tstep + cur.kb;
    S.a_ready(cur);
    if constexpr (SP2) {
        PG8_STAGE(PG8_SB(0, 0), cB, voffB); PG8_STAGE(PG8_SB(0, 1), cB + hstep, voffB); PG8_STAGE(PG8_SA(0, 0), cA, voffA); PG8_STAGE(PG8_SA(0, 1), cA + hstep, voffA);
        if (wr == 1) PG8_BAR;
        PG8_WAIT_V(2); PG8_BAR;
        PG8_STAGE(PG8_SB(1, 0), cB + kstep, voffB); PG8_STAGE(PG8_SA(1, 0), cA + kstep, voffA); PG8_STAGE(PG8_SB(1, 1), cB + hstep + kstep, voffB);
        PG8_WAIT_V(6); PG8_BAR;
    } else {
        PG8_STAGE(PG8_SB(0, 0), cB, voffB); PG8_STAGE(PG8_SA(0, 0), cA, voffA); PG8_STAGE(PG8_SB(0, 1), cB + hstep, voffB); PG8_STAGE(PG8_SA(0, 1), cA + hstep, voffA);
        if (wr == 1) PG8_BAR;
        PG8_WAIT_V(4); PG8_BAR;
        PG8_STAGE(PG8_SB(1, 0), cB + kstep, voffB); PG8_STAGE(PG8_SA(1, 0), cA + kstep, voffA); PG8_STAGE(PG8_SB(1, 1), cB + hstep + kstep, voffB);
        PG8_WAIT_V(6); PG8_BAR;
    }
    for (;;) {
        const bool has_next = S.next(ui + 1, nxt);
        const char* nA = has_next ? (const char*)g.A + (size_t)nxt.pm * tstep + nxt.kb : cA; const char* nB = has_next ? (const char*)g.Bt + (size_t)nxt.pn * tstep + nxt.kb : cB;
        const int ntu = cur.nt ? cur.nt : nt;
        for (int t = 0; t < ntu; t += 2) {
            const bool last = (t == ntu - 2);
            const char* a1 = cA + (size_t)(t + 1) * kstep;
            const char* a2 = last ? nA : cA + (size_t)(t + 2) * kstep; const char* b2 = last ? nB : cB + (size_t)(t + 2) * kstep;
            const char* a3 = a2 + kstep; const char* b3 = b2 + kstep;
            if (last && has_next) S.a_ready(nxt);
            if constexpr (SP2) {
            PG8_LDB(B0, 0, 0); PG8_LDB(B1, 0, 1); PG8_SCHED; PG8_LDA(At, 0, 0); PG8_STAGE(PG8_SA(1, 1), a1 + hstep, voffA);
            PG8_WAIT_V(8); PG8_WAIT_L(0); PG8_BAR; PG8_MMA(0, 0, At, B0); PG8_MMA(0, 1, At, B1); PG8_BAR; PG8_SCHED;
            PG8_LDA(At, 0, 1); PG8_STAGE(PG8_SB(0, 0), b2, voffB); PG8_STAGE(PG8_SB(0, 1), b2 + hstep, voffB); PG8_STAGE(PG8_SA(0, 0), a2, voffA);
            PG8_WAIT_V(8); PG8_WAIT_L(0); PG8_BAR; PG8_MMA(1, 0, At, B0); PG8_MMA(1, 1, At, B1); PG8_BAR; PG8_SCHED;
            PG8_LDB(B0, 1, 0); PG8_LDB(B1, 1, 1); PG8_SCHED; PG8_LDA(At, 1, 0); PG8_STAGE(PG8_SA(0, 1), a2 + hstep, voffA);
            PG8_WAIT_V(8); PG8_WAIT_L(0); PG8_BAR; PG8_MMA(0, 0, At, B0); PG8_MMA(0, 1, At, B1); PG8_BAR; PG8_SCHED;
            PG8_LDA(At, 1, 1); PG8_STAGE(PG8_SB(1, 0), b3, voffB); PG8_STAGE(PG8_SB(1, 1), b3 + hstep, voffB); PG8_STAGE(PG8_SA(1, 0), a3, voffA);
            PG8_WAIT_V(8); PG8_WAIT_L(0); PG8_BAR; PG8_MMA(1, 0, At, B0); PG8_MMA(1, 1, At, B1); PG8_BAR; PG8_SCHED;
            } else {
            PG8_LDB(B0, 0, 0); PG8_SCHED; PG8_LDA(At, 0, 0); PG8_STAGE(PG8_SA(1, 1), a1 + hstep, voffA);
            PG8_WAIT_L(8); PG8_BAR; PG8_WAIT_L(0); PG8_MMA(0, 0, At, B0); PG8_BAR; PG8_SCHED;
            PG8_LDB(B1, 0, 1); PG8_STAGE(PG8_SB(0, 0), b2, voffB);
            PG8_BAR; PG8_WAIT_L(0); PG8_MMA(0, 1, At, B1); PG8_BAR;
            PG8_LDA(At, 0, 1); PG8_STAGE(PG8_SA(0, 0), a2, voffA);
            PG8_BAR; PG8_WAIT_L(0); PG8_MMA(1, 0, At, B0); PG8_BAR; PG8_SCHED;
            PG8_STAGE(PG8_SB(0, 1), b2 + hstep, voffB);
            PG8_WAIT_V(6); PG8_BAR; PG8_MMA(1, 1, At, B1); PG8_BAR;
            PG8_LDB(B0, 1, 0); PG8_SCHED; PG8_LDA(At, 1, 0); PG8_STAGE(PG8_SA(0, 1), a2 + hstep, voffA);
            PG8_WAIT_L(8); PG8_BAR; PG8_WAIT_L(0); PG8_MMA(0, 0, At, B0); PG8_BAR; PG8_SCHED;
            PG8_LDB(B1, 1, 1); PG8_STAGE(PG8_SB(1, 0), b3, voffB);
            PG8_BAR; PG8_WAIT_L(0); PG8_MMA(0, 1, At, B1); PG8_BAR;
            PG8_LDA(At, 1, 1); PG8_STAGE(PG8_SA(1, 0), a3, voffA);
            PG8_BAR; PG8_WAIT_L(0); PG8_MMA(1, 0, At, B0); PG8_BAR; PG8_SCHED;
            PG8_STAGE(PG8_SB(1, 1), b3 + hstep, voffB);
            PG8_WAIT_V(6); PG8_BAR; PG8_MMA(1, 1, At, B1); PG8_BAR;
            }
        }
        if constexpr (ALIGN_EPI) { if (wr == 0) PG8_BAR; }
        if constexpr (!Epi::AFTER_DRAIN) { E(acc, cur, wr, wc, fr, fq); S.done(cur); }
        if (!has_next) break;
#pragma unroll
        for (int a = 0; a < 2; ++a)
#pragma unroll
            for (int b = 0; b < 2; ++b)
#pragma unroll
                for (int m = 0; m < 4; ++m)
#pragma unroll
                    for (int n = 0; n < 2; ++n) acc[a][b][m][n] = (f32x4){0.f, 0.f, 0.f, 0.f};
        cur = nxt; cA = nA; cB = nB; ++ui;
        if constexpr (ALIGN_EPI) { if (wr == 1) PG8_BAR; }
    }
    PG8_WAIT_V(0);
    if constexpr (!ALIGN_EPI) { if (wr == 0) PG8_BAR; }
    PG8_BAR;
    if constexpr (Epi::AFTER_DRAIN) { E.fused(acc, cur, wr, wc, fr, fq, lds, wid, lane); S.done(cur); }
#undef PG8_SA
#undef PG8_SB
#undef PG8_STAGE
#undef PG8_LDA
#undef PG8_LDB
#undef PG8_MMA
#undef PG8_WAIT_V
#undef PG8_WAIT_L
#undef PG8_BAR
#undef PG8_SCHED
}
}
#include <hip/hip_bf16.h>
#include <cmath>
namespace attn_body {
using bf16=__hip_bfloat16;
using bf16x8=__attribute__((ext_vector_type(8)))short;
using s16x4=__attribute__((ext_vector_type(4)))short;
using f32x16=__attribute__((ext_vector_type(16)))float;
using u32x4=__attribute__((ext_vector_type(4)))unsigned;
constexpr int BATCH=4,NVH=32,SEQ=8192,D=64,DM=1024,OPITCH=2048;
constexpr int NW=8,QBLK=32,QB=QBLK*NW,KVBLK=64,NQB=SEQ/QB;
constexpr int ATTN_PITCH=DM, ATTN_UNIT_ROWS=QB;
__device__ __forceinline__ int crow(int r,int hi){return (r&3)+8*(r>>2)+4*hi;}
#define SBAR() __builtin_amdgcn_sched_barrier(0)
__device__ __forceinline__ void cmask(f32x16&p0,f32x16&p1,int jb,int qrel,int hi){
  const float NEG=-INFINITY; (void)hi;
  if(jb>(qrel>>6)){
  #pragma unroll
  for(int r=0;r<16;++r){p0[r]=NEG;p1[r]=NEG;}}
}


constexpr int NSLOT=3, SLOTB=8192, SLOTV=16384;
constexpr int LDS_K=0, LDS_V=NSLOT*SLOTB, LDS_WS=LDS_V+NSLOT*SLOTV, LDS_OST=LDS_WS+NW*64*4, LDS_BYTES=LDS_OST+NW*4096;
constexpr float C2=0.125f*1.4426950408889634f;
__device__ __forceinline__ void glds16(const void*gsrc,unsigned lds_dst){unsigned keep;
  asm volatile("s_mov_b32 %0, m0\n\ts_mov_b32 m0, %2\n\ts_nop 0\n\tglobal_load_lds_dwordx4 %1, off\n\ts_mov_b32 m0, %0":"=&s"(keep):"v"(gsrc),"s"(lds_dst):"memory");}
__device__ __forceinline__ float max3f(float a,float b,float c){float r;asm("v_max3_f32 %0, %1, %2, %3":"=v"(r):"v"(a),"v"(b),"v"(c));return r;}
__device__ __forceinline__ float max2f(float a,float b){float r;asm("v_max_f32_e32 %0, %1, %2":"=v"(r):"v"(a),"v"(b));return r;}
__device__ __forceinline__ float fadd_s(float a,float b){float r;asm("v_add_f32_e32 %0, %1, %2":"=v"(r):"v"(a),"v"(b));return r;}
__device__ __forceinline__ float fsub_s(float a,float b){float r;asm("v_sub_f32_e32 %0, %1, %2":"=v"(r):"v"(a),"v"(b));return r;}
typedef float f32x2_t __attribute__((ext_vector_type(2))); typedef __bf16 bf16x2_t __attribute__((ext_vector_type(2)));
__device__ __forceinline__ unsigned cvtpk_s(float lo,float hi){f32x2_t v={lo,hi};bf16x2_t b=__builtin_convertvector(v,bf16x2_t);return __builtin_bit_cast(unsigned,b);}
#define WAIT_BAR(N) asm volatile("s_waitcnt vmcnt(" #N ") lgkmcnt(0)\n\ts_barrier":::"memory")

__device__ __forceinline__ void qkt(f32x16&p0,f32x16&p1,const char*Kslot,const bf16x8*qr,const f32x16&negm,int r32,int hi){
  const char*kb=Kslot+hi*1024+r32*16;
  #pragma unroll
  for(int d0=0;d0<4;++d0){
    const bf16x8 b0=*reinterpret_cast<const bf16x8*>(kb+d0*2048);
    const bf16x8 b1=*reinterpret_cast<const bf16x8*>(kb+d0*2048+512);
    if(d0==0){p0=__builtin_amdgcn_mfma_f32_32x32x16_bf16(b0,qr[0],negm,0,0,0);p1=__builtin_amdgcn_mfma_f32_32x32x16_bf16(b1,qr[0],negm,0,0,0);}
    else{p0=__builtin_amdgcn_mfma_f32_32x32x16_bf16(b0,qr[d0],p0,0,0,0);p1=__builtin_amdgcn_mfma_f32_32x32x16_bf16(b1,qr[d0],p1,0,0,0);}}
}
typedef __attribute__((address_space(3))) const char* lds_cptr;
typedef short v4i16_t __attribute__((ext_vector_type(4)));
__device__ __forceinline__ void kload8(bf16x8*kf,lds_cptr kp){
  kf[0]=*(const __attribute__((address_space(3))) bf16x8*)(kp);      kf[1]=*(const __attribute__((address_space(3))) bf16x8*)(kp+512);
  kf[2]=*(const __attribute__((address_space(3))) bf16x8*)(kp+2048); kf[3]=*(const __attribute__((address_space(3))) bf16x8*)(kp+2560);
  kf[4]=*(const __attribute__((address_space(3))) bf16x8*)(kp+4096); kf[5]=*(const __attribute__((address_space(3))) bf16x8*)(kp+4608);
  kf[6]=*(const __attribute__((address_space(3))) bf16x8*)(kp+6144); kf[7]=*(const __attribute__((address_space(3))) bf16x8*)(kp+6656);
}
__device__ __forceinline__ void kload2(bf16x8*kf,lds_cptr kp,int j){ kf[2*j]=*(const __attribute__((address_space(3))) bf16x8*)(kp+j*2048); kf[2*j+1]=*(const __attribute__((address_space(3))) bf16x8*)(kp+j*2048+512); }
__device__ __forceinline__ s16x4 vtr(lds_cptr p){ return __builtin_bit_cast(s16x4,__builtin_amdgcn_ds_read_tr16_b64_v4i16((__attribute__((address_space(3))) v4i16_t*)p)); }
__device__ __forceinline__ float rowmax(const f32x16&p0,const f32x16&p1){
  float a=max3f(p0[0],p0[1],p1[0]),b=max3f(p0[2],p0[3],p1[1]);a=max3f(a,p1[2],p1[3]);
  #pragma unroll
  for(int r=4;r<16;r+=4){a=max3f(a,p0[r],p0[r+1]);b=max3f(b,p0[r+2],p0[r+3]);a=max3f(a,p1[r],p1[r+1]);b=max3f(b,p1[r+2],p1[r+3]);}
  const float m=max2f(a,b);
  auto rr=__builtin_amdgcn_permlane32_swap(__float_as_uint(m),__float_as_uint(m),false,false);
  return max2f(__uint_as_float(rr[0]),__uint_as_float(rr[1]));
}
__device__ __forceinline__ void pv(f32x16*o,int vb,bf16x8 pa0,bf16x8 pa1,bf16x8 pa2,bf16x8 pa3){
  #pragma unroll
  for(int d0=0;d0<4;++d0){s16x4 lo[4],hi[4];
    #pragma unroll
    for(int ks=0;ks<4;++ks){
      asm volatile("ds_read_b64_tr_b16 %0,%1 offset:%c2":"=&v"(lo[ks]):"v"(vb),"i"(d0*4096+ks*1024):"memory");
      asm volatile("ds_read_b64_tr_b16 %0,%1 offset:%c2":"=&v"(hi[ks]):"v"(vb),"i"(d0*4096+ks*1024+512):"memory");}
    asm volatile("s_waitcnt lgkmcnt(0)":::"memory");SBAR();
    #define PK(k) (bf16x8){lo[k][0],lo[k][1],lo[k][2],lo[k][3],hi[k][0],hi[k][1],hi[k][2],hi[k][3]}
    o[d0]=__builtin_amdgcn_mfma_f32_32x32x16_bf16(pa0,PK(0),o[d0],0,0,0);
    o[d0]=__builtin_amdgcn_mfma_f32_32x32x16_bf16(pa1,PK(1),o[d0],0,0,0);
    o[d0]=__builtin_amdgcn_mfma_f32_32x32x16_bf16(pa2,PK(2),o[d0],0,0,0);
    o[d0]=__builtin_amdgcn_mfma_f32_32x32x16_bf16(pa3,PK(3),o[d0],0,0,0);
    #undef PK
  }
}

#ifndef ATTN_STORE16
#define ATTN_STORE16(p,v) (*(u32x4*)(p)=(v))
#endif
template<int THRL> __device__ __forceinline__ void attn_unit(int b,int qoff,int koff,int voff,int ooff,int qb,const bf16*Q,const bf16*__restrict__ K,const bf16*__restrict__ V,bf16*O,char*shm,const int tid_in,const int mode,bf16*A2,const int a2off,const float lam,const float*__restrict__ subln){
  const int tid=tid_in,lane=tid&63,r32=lane&31,hi=lane>>5; const int wid=__builtin_amdgcn_readfirstlane(tid>>6);
  const long rowbase=(long)b*SEQ; const int q0=qb*QB;
  const bf16*Qw=Q+(rowbase+q0+wid*QBLK)*DM+qoff;
  const bf16*Kh=K+rowbase*DM+koff,*Vh=V+rowbase*DM+voff;
  const unsigned lds0=(unsigned)(uintptr_t)shm;
  float*wsf=(float*)(shm+LDS_WS)+wid*64;
  const bf16*ksrc=Kh+(long)lane*DM+wid*8;
  const bf16*vsrc=Vh+(long)(16*(wid&3)+(lane>>2))*DM+(wid>>2)*32+(lane&3)*8;
  const unsigned kdst=lds0+LDS_K+wid*1024, vdst=lds0+LDS_V+wid*1024;
  #define DMA_K(t,slot) glds16(ksrc+(long)(t)*KVBLK*DM,(unsigned)__builtin_amdgcn_readfirstlane(kdst+(slot)))
  #define DMA_V(t,slot) do{ glds16(vsrc+(long)(t)*KVBLK*DM,(unsigned)__builtin_amdgcn_readfirstlane(vdst+(slot))); glds16(vsrc+(long)(t)*KVBLK*DM+64,(unsigned)__builtin_amdgcn_readfirstlane(vdst+(slot)+8192)); }while(0)
  const int vb0=(int)(lds0+LDS_V)+((lane>>4)&1)*32+(lane&3)*8+(4*hi+((lane&15)>>2))*64;
  const char*Kbase=shm+LDS_K; bf16x8 kf[8];
  const lds_cptr shm3=(lds_cptr)shm; const lds_cptr kp0=shm3+LDS_K+hi*1024+r32*16; const lds_cptr vp0=shm3+LDS_V+((lane>>4)&1)*32+(lane&3)*8+(4*hi+((lane&15)>>2))*64;
  const int NT=(q0+QB)/KVBLK;
  DMA_K(0,0);DMA_V(0,0);DMA_K(1,SLOTB);
  bf16x8 qr[4];
  #pragma unroll
  for(int d0=0;d0<4;++d0)qr[d0]=*reinterpret_cast<const bf16x8*>(&Qw[(long)r32*DM+d0*16+hi*8]);
  float mhat=0.f,l_reg=0.f;f32x16 o[4];o[0]=f32x16{};o[1]=f32x16{};o[2]=f32x16{};o[3]=f32x16{};f32x16 negm=f32x16{};asm volatile("":"+v"(negm));
  const int qrel=wid*QBLK+r32;
  #define CMASK(P0,P1,t) do{int jb_=(t)-(NT-4); if(jb_>=0)cmask(P0,P1,jb_,qrel,hi);}while(0)
  bool resc=false;
  #define START(P0,P1) do{ const float rm=rowmax(P0,P1); resc=false; \
    { const float dl=rm; mhat=fadd_s(mhat,dl); \
      _Pragma("unroll") for(int r=0;r<16;++r){P0[r]=fsub_s(P0[r],dl);P1[r]=fsub_s(P1[r],dl);} \
      _Pragma("unroll") for(int r=0;r<16;++r)negm[r]=-mhat; asm volatile("":"+v"(negm)); } \
    _Pragma("unroll") for(int r=0;r<16;++r)P0[r]=__builtin_amdgcn_exp2f(P0[r]); }while(0)
  #define RESC() do{ if(resc){ asm volatile("s_waitcnt lgkmcnt(0)":::"memory"); \
      _Pragma("unroll") for(int d_=0;d_<4;++d_) _Pragma("unroll") for(int r=0;r<16;++r)o[d_][r]*=wsf[crow(r,hi)]; } }while(0)
  f32x16 pA0,pA1,pB0,pB1;
  int sl_prev=0,sl_cur=0,sl_next=SLOTB;
  #define ROT() do{sl_prev=sl_cur;sl_cur=sl_next;sl_next=(sl_next==(NSLOT-1)*SLOTB)?0:sl_next+SLOTB;}while(0)
  DMA_K(2,2*SLOTB);
  WAIT_BAR(3);
  qkt(pA0,pA1,Kbase,qr,negm,r32,hi);asm volatile("s_nop 15\n\ts_nop 7":"+v"(pA0),"+v"(pA1));CMASK(pA0,pA1,0);
  START(pA0,pA1);
  _Pragma("unroll") for(int r=0;r<16;++r)pA1[r]=__builtin_amdgcn_exp2f(pA1[r]);
  WAIT_BAR(0);
  DMA_K(3,0);DMA_V(1,SLOTV);
  ROT();
  kload8(kf,kp0+sl_cur);
  WAIT_BAR(3);
  s16x4 vlo[8],vhi[8]; u32x4 pw0,pw1,pw2,pw3;
  #define PKW(P,B) cvtpk_s(P[B],P[B+1])
  #define PAF(k) __builtin_bit_cast(bf16x8,pw##k)
  #define VFR(i) (bf16x8){vlo[i][0],vlo[i][1],vlo[i][2],vlo[i][3],vhi[i][0],vhi[i][1],vhi[i][2],vhi[i][3]}
  #define PIN(x) asm volatile("":"+v"(x))
  #define MX3(a,b,c) __builtin_fmaxf(__builtin_fmaxf((a),(b)),(c))
  #define GAPA(MF,A0,A1,A2,A3,W0,W1,PW) do{ MF; sacc+=A0; sacc+=A1; sacc+=A2; sacc+=A3; PIN(sacc); W0; W1; PIN(PW); SBAR(); }while(0)
  #define EX(v) __builtin_amdgcn_exp2f(v)
  #define GAPB(MF,X,B) do{ MF; X[B]=EX(X[B]); X[B+1]=EX(X[B+1]); X[B+2]=EX(X[B+2]); X[B+3]=EX(X[B+3]); PIN(X); SBAR(); }while(0)
  #define VRD(i) do{ vlo[i]=vtr(vp_+(((i)>>2)*4096+((i)&3)*1024)); vhi[i]=vtr(vp_+(((i)>>2)*4096+((i)&3)*1024+512)); }while(0)
  #define VRD2(i) do{ vlo[i]=vtr(vp_+(8192+((i)>>2)*4096+((i)&3)*1024)); vhi[i]=vtr(vp_+(8192+((i)>>2)*4096+((i)&3)*1024+512)); }while(0)
  #define GAPB2(MF,X,B) do{ MF; X[B]=EX(X[B]); X[B+1]=EX(X[B+1]); PIN(X); SBAR(); }while(0)
  #define KRD(G,j) do{ if(G){ kload2(kf,kp0+sl_next,j); SBAR(); } }while(0)
  #define STEP(C0,C1,P0,P1,t,GK,GV,GL) do{ SBAR(); \
    const lds_cptr vp_=vp0+2*sl_prev; \
    VRD(0); SBAR(); float sacc=(P0[0]+P0[1]); \
    GAPA(C0=__builtin_amdgcn_mfma_f32_32x32x16_bf16(kf[0],qr[0],negm,0,0,0), P0[2],P0[3],P0[4],P0[5],     pw0[0]=PKW(P0,0), pw0[1]=PKW(P0,2), pw0); \
    VRD(4); SBAR(); GAPA(C1=__builtin_amdgcn_mfma_f32_32x32x16_bf16(kf[1],qr[0],negm,0,0,0), P0[6],P0[7],P0[8],P0[9],     pw0[2]=PKW(P0,4), pw0[3]=PKW(P0,6), pw0); \
    VRD(1); SBAR(); GAPA(C0=__builtin_amdgcn_mfma_f32_32x32x16_bf16(kf[2],qr[1],C0,0,0,0),   P0[10],P0[11],P0[12],P0[13], pw1[0]=PKW(P0,8), pw1[1]=PKW(P0,10), pw1); \
    VRD(5); SBAR(); GAPA(C1=__builtin_amdgcn_mfma_f32_32x32x16_bf16(kf[3],qr[1],C1,0,0,0),   P0[14],P0[15],P1[0],P1[1],   pw1[2]=PKW(P0,12),pw1[3]=PKW(P0,14), pw1); \
    GAPA(C0=__builtin_amdgcn_mfma_f32_32x32x16_bf16(kf[4],qr[2],C0,0,0,0),   P1[2],P1[3],P1[4],P1[5],     pw2[0]=PKW(P1,0), pw2[1]=PKW(P1,2), pw2); \
    GAPA(C1=__builtin_amdgcn_mfma_f32_32x32x16_bf16(kf[5],qr[2],C1,0,0,0),   P1[6],P1[7],P1[8],P1[9],     pw2[2]=PKW(P1,4), pw2[3]=PKW(P1,6), pw2); \
    GAPA(C0=__builtin_amdgcn_mfma_f32_32x32x16_bf16(kf[6],qr[3],C0,0,0,0),   P1[10],P1[11],P1[12],P1[13], pw3[0]=PKW(P1,8), pw3[1]=PKW(P1,10), pw3); \
    GAPA(C1=__builtin_amdgcn_mfma_f32_32x32x16_bf16(kf[7],qr[3],C1,0,0,0),   P1[14],P1[15],0.f,0.f,       pw3[2]=PKW(P1,12),pw3[3]=PKW(P1,14), pw3); \
    l_reg+=sacc; \
    if(GK){DMA_K((t)+3,sl_cur);} if(GV){DMA_V((t)+1,2*sl_next);} \
    CMASK(C0,C1,t); \
    { float a=MX3(C0[0],C0[1],C1[0]),b=MX3(C0[2],C0[3],C1[1]); a=MX3(a,C1[2],C1[3]); \
      _Pragma("unroll") for(int r=4;r<16;r+=4){a=MX3(a,C0[r],C0[r+1]);b=MX3(b,C0[r+2],C0[r+3]);a=MX3(a,C1[r],C1[r+1]);b=MX3(b,C1[r+2],C1[r+3]);} \
      float rm=__builtin_fmaxf(a,b); { auto rr=__builtin_amdgcn_permlane32_swap(__float_as_uint(rm),__float_as_uint(rm),false,false); rm=__builtin_fmaxf(__uint_as_float(rr[0]),__uint_as_float(rr[1])); } \
      resc=false; \
      if(__builtin_expect(__any(rm>(float)THRL),0)){ const float dl=__builtin_fmaxf(rm,0.f); mhat+=dl; \
        _Pragma("unroll") for(int r=0;r<16;++r){C0[r]-=dl;C1[r]-=dl;} \
        _Pragma("unroll") for(int r=0;r<16;++r)negm[r]=-mhat; asm volatile("":"+v"(negm)); \
        const float f=__builtin_amdgcn_exp2f(-dl); l_reg*=f; if(hi==0)wsf[r32]=f; resc=true; } } \
    SBAR(); \
    GAPB2(o[0]=__builtin_amdgcn_mfma_f32_32x32x16_bf16(PAF(0),VFR(0),o[0],0,0,0), C0,0);  VRD(2);  SBAR(); \
    GAPB2(o[1]=__builtin_amdgcn_mfma_f32_32x32x16_bf16(PAF(0),VFR(4),o[1],0,0,0), C0,2);  VRD(6);  SBAR(); \
    GAPB2(o[0]=__builtin_amdgcn_mfma_f32_32x32x16_bf16(PAF(1),VFR(1),o[0],0,0,0), C0,4);  VRD(3);  SBAR(); \
    GAPB2(o[1]=__builtin_amdgcn_mfma_f32_32x32x16_bf16(PAF(1),VFR(5),o[1],0,0,0), C0,6);  VRD(7);  SBAR(); \
    GAPB2(o[0]=__builtin_amdgcn_mfma_f32_32x32x16_bf16(PAF(2),VFR(2),o[0],0,0,0), C0,8);  VRD2(0); SBAR(); \
    GAPB2(o[1]=__builtin_amdgcn_mfma_f32_32x32x16_bf16(PAF(2),VFR(6),o[1],0,0,0), C0,10); VRD2(4); SBAR(); \
    GAPB2(o[0]=__builtin_amdgcn_mfma_f32_32x32x16_bf16(PAF(3),VFR(3),o[0],0,0,0), C0,12); VRD2(1); SBAR(); \
    GAPB2(o[1]=__builtin_amdgcn_mfma_f32_32x32x16_bf16(PAF(3),VFR(7),o[1],0,0,0), C0,14); VRD2(5); SBAR(); \
    GAPB2(o[2]=__builtin_amdgcn_mfma_f32_32x32x16_bf16(PAF(0),VFR(0),o[2],0,0,0), C1,0);  VRD2(2); SBAR(); \
    GAPB2(o[3]=__builtin_amdgcn_mfma_f32_32x32x16_bf16(PAF(0),VFR(4),o[3],0,0,0), C1,2);  VRD2(6); SBAR(); \
    GAPB2(o[2]=__builtin_amdgcn_mfma_f32_32x32x16_bf16(PAF(1),VFR(1),o[2],0,0,0), C1,4);  VRD2(3); SBAR(); \
    GAPB2(o[3]=__builtin_amdgcn_mfma_f32_32x32x16_bf16(PAF(1),VFR(5),o[3],0,0,0), C1,6);  VRD2(7); SBAR(); \
    GAPB2(o[2]=__builtin_amdgcn_mfma_f32_32x32x16_bf16(PAF(2),VFR(2),o[2],0,0,0), C1,8);  KRD(GL,0); \
    GAPB2(o[3]=__builtin_amdgcn_mfma_f32_32x32x16_bf16(PAF(2),VFR(6),o[3],0,0,0), C1,10); KRD(GL,1); \
    GAPB2(o[2]=__builtin_amdgcn_mfma_f32_32x32x16_bf16(PAF(3),VFR(3),o[2],0,0,0), C1,12); KRD(GL,2); \
    GAPB2(o[3]=__builtin_amdgcn_mfma_f32_32x32x16_bf16(PAF(3),VFR(7),o[3],0,0,0), C1,14); KRD(GL,3); \
    }while(0)
  int t=1;
  #undef CMASK
  #define CMASK(P0,P1,t) do{}while(0)
  for(;t+5<NT;t+=2){
    STEP(pB0,pB1,pA0,pA1,t,true,true,true);     WAIT_BAR(3); RESC(); ROT();
    STEP(pA0,pA1,pB0,pB1,t+1,true,true,true);   WAIT_BAR(3); RESC(); ROT();
  }
  #undef CMASK
  #define CMASK(P0,P1,t) do{int jb_=(t)-(NT-4); if(jb_>=0)cmask(P0,P1,jb_,qrel,hi);}while(0)
  #define ENDW(tt) do{ if((tt)+3<NT){WAIT_BAR(3);} else if((tt)+2<NT){WAIT_BAR(2);} else {WAIT_BAR(0);} }while(0)
  for(;t+1<NT;t+=2){
    STEP(pB0,pB1,pA0,pA1,t,(t+3<NT),(t+1<NT),(t+1<NT));       ENDW(t);   RESC(); ROT();
    STEP(pA0,pA1,pB0,pB1,t+1,(t+4<NT),(t+2<NT),(t+2<NT));     ENDW(t+1); RESC(); ROT();
  }
  STEP(pB0,pB1,pA0,pA1,NT-1,false,false,false); RESC();
  { float sacc=pB0[0]+pB0[1]; _Pragma("unroll") for(int r=2;r<16;++r)sacc+=pB0[r]; _Pragma("unroll") for(int r=0;r<16;++r)sacc+=pB1[r]; l_reg+=sacc;
    pw0=(u32x4){PKW(pB0,0),PKW(pB0,2),PKW(pB0,4),PKW(pB0,6)};pw1=(u32x4){PKW(pB0,8),PKW(pB0,10),PKW(pB0,12),PKW(pB0,14)};pw2=(u32x4){PKW(pB1,0),PKW(pB1,2),PKW(pB1,4),PKW(pB1,6)};pw3=(u32x4){PKW(pB1,8),PKW(pB1,10),PKW(pB1,12),PKW(pB1,14)};
    SBAR(); pv(o,vb0+2*sl_cur,PAF(0),PAF(1),PAF(2),PAF(3)); }
  #undef PKW
  #undef PAF
  #undef VFR
  #undef PIN
  #undef MX3
  #undef GAPA
  #undef GAPB
  #undef EX
  #undef VRD
  #undef VRD2
  #undef GAPB2
  #undef KRD
  #undef STEP
  #undef ENDW
  {auto rr=__builtin_amdgcn_permlane32_swap(__float_as_uint(l_reg),__float_as_uint(l_reg),false,false);l_reg=__uint_as_float(rr[0])+__uint_as_float(rr[1]);}
  if(hi==0)wsf[32+r32]=l_reg;asm volatile("s_waitcnt lgkmcnt(0)":::"memory");
  float rli[16];
  #pragma unroll
  for(int r=0;r<16;++r)rli[r]=__builtin_amdgcn_rcpf(wsf[32+crow(r,hi)]);
  bf16*Ow=O+(rowbase+q0+wid*QBLK)*OPITCH+ooff;
  { bf16*stg=(bf16*)(shm+LDS_OST)+wid*2048;
    float rs4[4]={0.f,0.f,0.f,0.f}; int le=lane; asm volatile("":"+v"(le));
    #pragma unroll
    for(int pass=0;pass<2;++pass){ if(pass==1&&mode==0)break;
    #pragma unroll
    for(int hf=0;hf<2;++hf){
    #pragma unroll
    for(int r=0;r<16;++r){const int orow=crow(r,hi);
      #pragma unroll
      for(int d0=0;d0<2;++d0)stg[orow*64+d0*32+r32]=__float2bfloat16(o[2*hf+d0][r]*rli[r]);}
    asm volatile("s_waitcnt lgkmcnt(0)":::"memory");
    #pragma unroll
    for(int i=0;i<4;++i){const int row=i*8+(le>>3),ch=le&7; const u32x4 v=*(const u32x4*)(stg+row*64+ch*8);
      if(mode==0){ ATTN_STORE16(Ow+(long)row*OPITCH+hf*64+ch*8,v); }
      else{ const u32x4 z=*(const u32x4*)(Ow-128+(long)row*OPITCH+hf*64+ch*8); const unsigned zw[4]={z.x,z.y,z.z,z.w},vw[4]={v.x,v.y,v.z,v.w}; float d8[8];
        #pragma unroll
        for(int k=0;k<4;++k){ d8[2*k]=__uint_as_float(zw[k]<<16)-lam*__uint_as_float(vw[k]<<16); d8[2*k+1]=__uint_as_float(zw[k]&0xffff0000u)-lam*__uint_as_float(vw[k]&0xffff0000u); }
        if(pass==0){
          #pragma unroll
          for(int k=0;k<8;++k)rs4[i]+=d8[k]*d8[k]; }
        else{ const float rstd=rs4[i]; const float*g=subln+hf*64+ch*8; u32x4 w;
          w.x=cvtpk_s(d8[0]*rstd*g[0],d8[1]*rstd*g[1]); w.y=cvtpk_s(d8[2]*rstd*g[2],d8[3]*rstd*g[3]); w.z=cvtpk_s(d8[4]*rstd*g[4],d8[5]*rstd*g[5]); w.w=cvtpk_s(d8[6]*rstd*g[6],d8[7]*rstd*g[7]);
          *(u32x4*)(A2+(rowbase+q0+wid*QBLK+row)*1024+a2off+hf*64+ch*8)=w; } } }
    asm volatile("s_waitcnt lgkmcnt(0)":::"memory"); }
    if(pass==0&&mode!=0){
      #pragma unroll
      for(int i=0;i<4;++i){ float q=rs4[i]; q+=__shfl_xor(q,1); q+=__shfl_xor(q,2); q+=__shfl_xor(q,4); rs4[i]=(1.0f-0.35550906f)/sqrtf(q*(1.0f/128.0f)+1e-6f); } } } }
  asm volatile("s_waitcnt lgkmcnt(0)\n\ts_barrier":::"memory");
  #undef DMA_K
  #undef DMA_V
  #undef CMASK
  #undef START
  #undef RESC
  #undef ROT
}
constexpr int ATTN_LDS_BYTES=LDS_BYTES;
struct AttnTensors { const bf16* Q; const bf16* K; const bf16* V; bf16* O; };
struct AttnUnit { int bh; int qb; };
struct StaticOrder {
  int vcu;
  __device__ __forceinline__ explicit StaticOrder(int grid,int block):vcu((block%8)*(grid/8)+block/8){}
  __device__ __forceinline__ bool next(int i,AttnUnit&u)const{ if(i>=8)return false; const int s=vcu&7,j=i&3; u.bh=vcu>>3; u.qb=(j==0)?s:(j==1)?15-s:(j==2)?16+s:31-s; return true; }
};
struct AttnFuse { bf16* A2; float lam; const float* subln; };
template<class Sched,int THRL=8> __device__ __forceinline__ void attn_phase(char*lds,const AttnTensors&T,const Sched&S,const int tid_in,const AttnFuse&F){
  AttnUnit u;
  for(int i=0;S.next(i,u);++i){ const int b=u.bh>>3,h=u.bh&7,sh=i>>2,hs=2*h+sh;
    attn_unit<THRL>(b,hs*64,hs*64,h*128,hs*128,u.qb,T.Q,T.K,T.V,T.O,lds,tid_in,sh,F.A2,h*128,F.lam,F.subln); }
}
#undef SBAR
#undef WAIT_BAR
}
constexpr int NWAVES = 8;
constexpr int DM_ = 1024, MP = 32768, MS = 512, MT = MP + MS, SEQ_ = 8192, PAST = 4096;
constexpr int FFH = 2816, GH = 3072;
constexpr float EPS_ = 1e-6f;
constexpr float LAM_INIT = 0.35550906f;
constexpr size_t MiB = 1u << 20;
constexpr size_t WS_CTL = 0, CTL_ZERO_BYTES = 1 * MiB;
constexpr size_t WS_STATS = 640 * 1024;
constexpr size_t WS_MOD = 1 * MiB;
constexpr size_t WS_TAB = 5 * MiB;
constexpr size_t WS_LB = 13 * MiB;
constexpr size_t WS_W = 16 * MiB;
constexpr size_t W_GIN = WS_W, W_GOUT = W_GIN + 12 * MiB, W_DIN = W_GOUT + 6 * MiB, W_DOUT = W_DIN + 6 * MiB, W_RIN = W_DOUT + 2 * MiB, W_ROUT = W_RIN + 12 * MiB,
                 W_HIN = W_ROUT + 4 * MiB, W_HOUT = W_HIN + 8 * MiB, W_FIN = W_HOUT + 2 * MiB, W_FOUT = W_FIN + 44 * MiB, W_END = W_FOUT + 22 * MiB;
constexpr size_t FIN_STRIDE = 11 * MiB, FOUT_STRIDE = (size_t)1024 * 2816 * 2;
constexpr size_t WS_H = 144 * MiB;
constexpr size_t WS_F = 209 * MiB;
constexpr size_t WS_BIG = 274 * MiB;
constexpr size_t WS_B2 = 664 * MiB;
constexpr size_t WS_B3 = 859 * MiB;
constexpr size_t WS_LF = 989 * MiB;
constexpr size_t WS_QD = 1119 * MiB, WS_KI = 1184 * MiB, WS_KE = 1249 * MiB;
constexpr size_t WS_EB = 1314 * MiB;
constexpr size_t WS_PART = 1320 * MiB;
constexpr size_t WS_XB = 1344 * MiB;
constexpr size_t WS_STATP = 1410 * MiB;
constexpr size_t WS_END = 1424 * MiB;
static_assert(W_END <= WS_H && WS_STATS + (size_t)MT * 8 <= CTL_ZERO_BYTES, "ws map");
constexpr int CW_TMO = 0, CW_BAR = 4096;
constexpr int RING_BYTES = 131072, LDSCTL_OFF = 139264, MISC_OFF = LDSCTL_OFF + 320, LDS_BYTES = 147456;
constexpr size_t O_YP = 0, O_YS = 33554432, O_GV = 34078720, O_KDP = 35651584, O_VDP = 69206016, O_KDS = 102760448, O_VDS = 103284736,
                 O_RSP = 103809024, O_RSS = 105906176, O_HSP = 122683392, O_HSS = 123207680, O_END = 127401984;
#define GAS __attribute__((address_space(1)))
#define LAS __attribute__((address_space(3)))
typedef unsigned short bf16;
typedef unsigned v4u __attribute__((ext_vector_type(4)));
typedef float f32x4 __attribute__((ext_vector_type(4)));
typedef short bf16x8 __attribute__((ext_vector_type(8)));
typedef GAS unsigned gu32;
typedef GAS unsigned long long gu64;
#define RLX_AGENT __ATOMIC_RELAXED, __HIP_MEMORY_SCOPE_AGENT
#define LDS_WAIT() asm volatile("s_waitcnt lgkmcnt(0)" ::: "memory")
#define VM_WAIT() asm volatile("s_waitcnt vmcnt(0)" ::: "memory")
__device__ __forceinline__ unsigned long long rt() { return __builtin_amdgcn_s_memrealtime(); }
__device__ __forceinline__ unsigned f2bf(float f) { unsigned u = __builtin_bit_cast(unsigned, f); return (u + 0x7fffu + ((u >> 16) & 1u)) >> 16; }
__device__ __forceinline__ unsigned pk2(float lo, float hi) { return f2bf(lo) | (f2bf(hi) << 16); }

#define XB_TMO      128
#define XB_XCNT(j)  (256  + 64 * (j))
#define XB_XSUB(j)  (1280 + 64 * (j))
#define XB_XGEN(j)  (2304 + 64 * (j))
#define XB_TOP      3328
#define XB_TOPGEN   3392
#define XCD_BAR_WORDS 3456
#define XB_SPIN_CAP (1u << 18)

__device__ __forceinline__ unsigned xb_ld(unsigned* p)              { return __hip_atomic_load(p, __ATOMIC_RELAXED, __HIP_MEMORY_SCOPE_AGENT); }
__device__ __forceinline__ unsigned xb_add(unsigned* p, unsigned v) { return __hip_atomic_fetch_add(p, v, __ATOMIC_RELAXED, __HIP_MEMORY_SCOPE_AGENT); }
__device__ __forceinline__ unsigned xb_xcc_id() { return (unsigned)__builtin_amdgcn_s_getreg((3 << 11) | 20) & 0xFu; }
#define XB_SPIN(cond, bar) do { unsigned _sp = 0; while (cond) { __builtin_amdgcn_s_sleep(1); \
    if ((++_sp & 255u) == 0u) { if (xb_ld(&(bar)[XB_TMO])) break; if (_sp > XB_SPIN_CAP) { atomicAdd(&(bar)[XB_TMO], 1u); break; } } } } while (0)

struct XcdBarrier {
    unsigned* bar; unsigned x;
    volatile LAS unsigned* st;
};

__device__ __forceinline__ XcdBarrier xcd_barrier_post(unsigned* bar, volatile LAS unsigned* st, bool leader) {
    XcdBarrier b; b.bar = bar; b.x = xb_xcc_id(); b.st = st;
    if (leader) (void)xb_add(&bar[XB_XCNT(b.x)], 1u);
    return b;
}
__device__ __forceinline__ void xcd_barrier_complete(unsigned* bar, unsigned x, unsigned& nloc, unsigned& nx) {
    const unsigned G = gridDim.x * gridDim.y * gridDim.z;
    unsigned sum, cnt, mine, sp = 0u;
    for (;;) {
        sum = 0u; cnt = 0u; mine = 0u;
#pragma unroll
        for (unsigned j = 0; j < 16; ++j) { const unsigned c = xb_ld(&bar[XB_XCNT(j)]); sum += c; cnt += (c > 0u) ? 1u : 0u; mine = (j == x) ? c : mine; }
        if (sum == G) break;
        __builtin_amdgcn_s_sleep(1);
        if ((++sp & 255u) == 0u) { if (xb_ld(&bar[XB_TMO])) break; if (sp > XB_SPIN_CAP) { atomicAdd(&bar[XB_TMO], 1u); break; } }
    }
    nloc = mine > 0u ? mine : 1u; nx = cnt > 0u ? cnt : 1u;
}

__device__ __forceinline__ void xcd_barrier(const XcdBarrier& b, bool leader) {
    asm volatile("s_waitcnt vmcnt(0)" ::: "memory");
    __syncthreads();
    if (leader) {
        unsigned* bar = b.bar;
        __builtin_amdgcn_s_waitcnt(0);
        unsigned nloc = b.st[0], nx = b.st[1];
        if (nloc == 0u) { xcd_barrier_complete(bar, b.x, nloc, nx); b.st[0] = nloc; b.st[1] = nx; }
        const unsigned old = xb_add(&bar[XB_XSUB(b.x)], 1u);
        const unsigned gen = old / nloc;
        if (old + 1u == (gen + 1u) * nloc) {
            __builtin_amdgcn_fence(__ATOMIC_RELEASE, "agent");
            asm volatile("s_waitcnt vmcnt(0)" ::: "memory");
            const unsigned og = xb_add(&bar[XB_TOP], 1u);
            const unsigned tg = og / nx;
            if (og + 1u == (tg + 1u) * nx) xb_add(&bar[XB_TOPGEN], 1u);
            else XB_SPIN(xb_ld(&bar[XB_TOPGEN]) == tg, bar);
            __builtin_amdgcn_fence(__ATOMIC_ACQUIRE, "agent");
            xb_add(&bar[XB_XGEN(b.x)], 1u);
            asm volatile("s_waitcnt vmcnt(0)" ::: "memory");
        } else {
            XB_SPIN(xb_ld(&bar[XB_XGEN(b.x)]) == gen, bar);
            __builtin_amdgcn_fence(__ATOMIC_ACQUIRE, "agent");
            asm volatile("s_waitcnt vmcnt(0)" ::: "memory");
        }
    }
    __syncthreads();
}
typedef short s16x4 __attribute__((ext_vector_type(4)));
typedef unsigned u32x2 __attribute__((ext_vector_type(2)));
typedef unsigned u32x4 __attribute__((ext_vector_type(4)));
typedef LAS unsigned char* lptr;
__device__ __forceinline__ float bflo(unsigned w) { return __uint_as_float(w << 16); }
__device__ __forceinline__ float bfhi(unsigned w) { return __uint_as_float(w & 0xffff0000u); }
__device__ __forceinline__ unsigned pkbf(float lo, float hi) { return pg8::cvt_pk_bf16(lo, hi); }
__device__ __forceinline__ u32x4 pack8(f32x4 a, f32x4 b) { u32x4 w; w.x = pkbf(a[0], a[1]); w.y = pkbf(a[2], a[3]); w.z = pkbf(b[0], b[1]); w.w = pkbf(b[2], b[3]); return w; }
__device__ __forceinline__ float wave_sum(float v) {
#pragma unroll
    for (int o = 1; o < 64; o <<= 1) v += __shfl_xor(v, o);
    return v;
}
__device__ __forceinline__ float shx(float v, int mask, int lane) { return __int_as_float(__builtin_amdgcn_ds_bpermute((lane ^ mask) << 2, __float_as_int(v))); }
__device__ __forceinline__ float siluf(float x) { return x * __builtin_amdgcn_rcpf(1.0f + __expf(-x)); }
__device__ __forceinline__ int sid_of_row(int row) { return row < MP ? (row >> 13) : 4 + ((row - MP) >> 4); }
__device__ __forceinline__ f32x4 mma32(bf16x8 a, bf16x8 b, f32x4 c) { return __builtin_amdgcn_mfma_f32_16x16x32_bf16(a, b, c, 0, 0, 0); }
__device__ __forceinline__ f32x4 mma16(s16x4 a, s16x4 b, f32x4 c) { return __builtin_amdgcn_mfma_f32_16x16x16bf16_1k(a, b, c, 0, 0, 0); }
__device__ __forceinline__ bf16x8 frag_row(lptr base, int pitch, int x0, int k0, int lane) {
    return *(const LAS bf16x8*)(base + (x0 + (lane & 15)) * pitch + (k0 + 8 * (lane >> 4)) * 2);
}
typedef short v4i16_t __attribute__((ext_vector_type(4)));
__device__ __forceinline__ bf16x8 frag_tr(lptr base, int pitch, int k0, int x0, int lane) {
    const int g = lane >> 4, i = lane & 15, q = i >> 2, p = i & 3;
    lptr a = base + (k0 + 8 * g + q) * pitch + (x0 + 4 * p) * 2;
    const s16x4 lo = __builtin_bit_cast(s16x4, __builtin_amdgcn_ds_read_tr16_b64_v4i16((LAS v4i16_t*)a));
    const s16x4 hi = __builtin_bit_cast(s16x4, __builtin_amdgcn_ds_read_tr16_b64_v4i16((LAS v4i16_t*)(a + 4 * pitch)));
    return (bf16x8){lo[0], lo[1], lo[2], lo[3], hi[0], hi[1], hi[2], hi[3]};
}

#define LDS_BARRIER() do { asm volatile("s_waitcnt lgkmcnt(0)" ::: "memory"); __builtin_amdgcn_s_barrier(); asm volatile("" ::: "memory"); } while (0)
struct Ctx { int tid, lane, wave, vcu, G, gw, NGW; lptr lds; };

__device__ __forceinline__ Ctx mk_ctx(lptr lds, int wave_sgpr) {
    Ctx C; C.lds = lds; C.tid = fresh_tid(wave_sgpr); C.lane = C.tid & 63; C.wave = __builtin_amdgcn_readfirstlane(C.tid >> 6);
    int G = gridDim.x, bx = blockIdx.x; asm volatile("" : "+s"(G), "+s"(bx));
    C.G = G; C.vcu = (G % 8 == 0) ? (bx % 8) * (G / 8) + bx / 8 : bx; C.gw = C.vcu * NWAVES + C.wave; C.NGW = G * NWAVES; return C;
}
__device__ __forceinline__ void p0_transpose_item(const float* W, int K, int N, bf16* WT, int mode, LAS float* scr, int item, int lane) {
    const int nblk = N / 32, kb = item / nblk, nb = item % nblk, k0 = 64 * kb, n0 = 32 * nb;
    int d0 = n0;
    if (mode == 1) { d0 = (n0 < FFH) ? ((n0 >> 7) * 256 + (n0 & 127)) : (((n0 - FFH) >> 7) * 256 + 128 + ((n0 - FFH) & 127)); }
    if (mode == 2) { d0 = (n0 < 1024) ? ((n0 >> 7) * 256 + (n0 & 127)) : (n0 < 2048 ? (((n0 - 1024) >> 7) * 256 + 128 + (n0 & 127)) : n0); }
#pragma unroll 8
    for (int i = 0; i < 32; ++i) { const int kk = 2 * i + (lane >> 5); scr[kk * 33 + (lane & 31)] = W[(size_t)(k0 + kk) * N + n0 + (lane & 31)]; }
    LDS_WAIT(); asm volatile("" ::: "memory");
    const int c = lane & 7;
#pragma unroll
    for (int j = 0; j < 4; ++j) { const int n = (lane >> 3) + 8 * j; const LAS float* s = scr + (8 * c) * 33 + n;
        v4u o; o.x = pk2(s[0 * 33], s[1 * 33]); o.y = pk2(s[2 * 33], s[3 * 33]); o.z = pk2(s[4 * 33], s[5 * 33]); o.w = pk2(s[6 * 33], s[7 * 33]);
        *(GAS v4u*)(WT + (size_t)(d0 + n) * K + k0 + 8 * c) = o; }
    LDS_WAIT(); asm volatile("" ::: "memory");
}
__device__ __forceinline__ void p0_transpose(const Ctx& C, const float* W, int K, int N, bf16* WT, int mode) {
    LAS float* scr = (LAS float*)(C.lds + C.wave * 16384);
    const int nitems = (K / 64) * (N / 32);
    for (int it = C.gw; it < nitems; it += C.NGW) p0_transpose_item(W, K, N, WT, mode, scr, it, C.lane);
}
__device__ __forceinline__ void bg_transpose(const Ctx& C, int nbusy, const float* W, int K, int N, bf16* WT, int mode) {
    const int bx = (int)blockIdx.x; if (bx < nbusy) return;
    LAS float* scr = (LAS float*)(C.lds + C.wave * 16384);
    const int nitems = (K / 64) * (N / 32), stride = (C.G - nbusy) * NWAVES;
    for (int it = (bx - nbusy) * NWAVES + C.wave; it < nitems; it += stride) p0_transpose_item(W, K, N, WT, mode, scr, it, C.lane);
}
__device__ __forceinline__ void p0_adaln(const Ctx& C, const float* cp, const float* cs, const float* w_ada, const float* b_ada, float* mod) {
    LAS float* sl = (LAS float*)C.lds;
    LAS float* red = (LAS float*)(C.lds + 81920);
    for (int u = C.vcu; u < 768; u += C.G) {
        const int half = u & 1, cb = (u >> 1) % 96, l = (u >> 1) / 96, sid0 = half * 18;
        __syncthreads();
        for (int idx = C.tid; idx < 18 * 1024; idx += 512) { const int i = idx >> 10, k = idx & 1023, sid = sid0 + i;
            const float cv = sid < 4 ? cp[sid * 1024 + k] : cs[(sid - 4) * 1024 + k]; sl[k * 20 + i] = siluf(cv); }
        __syncthreads();
        const int c = C.tid & 63, kg = C.wave, col = cb * 64 + c;
        float acc[18];
#pragma unroll
        for (int i = 0; i < 18; ++i) acc[i] = 0.f;
        const float* wp = w_ada + ((size_t)l * 1024 + kg * 128) * 6144 + col;
#pragma unroll 4
        for (int kk = 0; kk < 128; ++kk) { const float w = wp[(size_t)kk * 6144]; const LAS float* s = sl + (kg * 128 + kk) * 20;
            const f32x4 a = *(const LAS f32x4*)s, b = *(const LAS f32x4*)(s + 4), cc = *(const LAS f32x4*)(s + 8), d = *(const LAS f32x4*)(s + 12); const float e0 = s[16], e1 = s[17];
            acc[0] += a[0] * w; acc[1] += a[1] * w; acc[2] += a[2] * w; acc[3] += a[3] * w; acc[4] += b[0] * w; acc[5] += b[1] * w; acc[6] += b[2] * w; acc[7] += b[3] * w;
            acc[8] += cc[0] * w; acc[9] += cc[1] * w; acc[10] += cc[2] * w; acc[11] += cc[3] * w; acc[12] += d[0] * w; acc[13] += d[1] * w; acc[14] += d[2] * w; acc[15] += d[3] * w;
            acc[16] += e0 * w; acc[17] += e1 * w; }
#pragma unroll
        for (int i = 0; i < 18; ++i) red[(kg * 18 + i) * 64 + c] = acc[i];
        __syncthreads();
        for (int idx = C.tid; idx < 18 * 64; idx += 512) { const int i = idx >> 6, cc = idx & 63; float s = 0.f;
#pragma unroll
            for (int g = 0; g < 8; ++g) s += red[(g * 18 + i) * 64 + cc];
            const int colo = cb * 64 + cc; mod[((size_t)l * 36 + sid0 + i) * 6144 + colo] = s + b_ada[l * 6144 + colo]; }
    }
    __syncthreads();
}
__device__ __forceinline__ void p0_tables(const Ctx& C, float* tab, float* lb, const float* hlb) {
    const int gt = C.vcu * 512 + C.tid, NT = C.G * 512;
    for (int idx = gt; idx < 8192 * 128; idx += NT) { const int pos = idx >> 7, i = idx & 127;
        const double inv = exp(-9.210340371976184 * ((double)i / 127.0)); const double ang = (double)pos * inv;
        double sn, cs; sincos(ang, &sn, &cs); tab[2 * (size_t)idx] = (float)cs; tab[2 * (size_t)idx + 1] = (float)sn; }
    for (int c = gt; c < 1024; c += NT) { const float a0 = hlb[c], a1 = hlb[1024 + c], a2 = hlb[2048 + c], a3 = hlb[3072 + c];
        const float mx = fmaxf(fmaxf(a0, a1), fmaxf(a2, a3)); const float e0 = expf(a0 - mx), e1 = expf(a1 - mx), e2 = expf(a2 - mx), e3 = expf(a3 - mx);
        lb[c] = (e1 + e2 + e3) / (e0 + e1 + e2 + e3); }
}

template <bool HAS_F, bool HAS_H, bool XIN32, bool XOUT32>
__device__ __forceinline__ void resnorm_phase(const Ctx& C, const float* xp, const float* xs, const bf16* Xb, const bf16* Fb, float* xout, bf16* Xo, const float* mod,
                                              const float* gpost, int mgate, bf16* Hb, const float* gpre, int mshift, int mscale, const float* part = nullptr, int nslab = 0) {
    const int MROWS = (HAS_F && part) ? MP : MT;
    if (HAS_F && part) { const int wrev = C.NGW - 1 - C.gw;
        for (int m = MP + wrev; m < MT; m += C.NGW) { const int sid = sid_of_row(m); const float* mrow = mod + (size_t)sid * 6144;
            f32x4 v[4], f[4];
            if (XIN32) { const GAS f32x4* xr = (const GAS f32x4*)(xs + (size_t)(m - MP) * DM_) + C.lane;
#pragma unroll
                for (int j = 0; j < 4; ++j) v[j] = xr[64 * j]; }
            else { const GAS u32x2* xr = (const GAS u32x2*)(Xb + (size_t)m * DM_) + C.lane;
#pragma unroll
                for (int j = 0; j < 4; ++j) { const u32x2 w = xr[64 * j]; v[j] = (f32x4){bflo(w.x), bfhi(w.x), bflo(w.y), bfhi(w.y)}; } }
#pragma unroll
            for (int j = 0; j < 4; ++j) f[j] = (f32x4){0.f, 0.f, 0.f, 0.f};
            for (int s = 0; s < nslab; ++s) { const GAS f32x4* pr = (const GAS f32x4*)(part + ((size_t)s * 512 + (m - MP)) * DM_) + C.lane;
#pragma unroll
                for (int j = 0; j < 4; ++j) f[j] = f[j] + pr[64 * j]; }
            float ss = 0.f;
#pragma unroll
            for (int j = 0; j < 4; ++j) ss += (f[j].x * f[j].x + f[j].y * f[j].y) + (f[j].z * f[j].z + f[j].w * f[j].w);
            float rstd = 1.0f / sqrtf(wave_sum(ss) * (1.0f / DM_) + EPS_);
#pragma unroll
            for (int j = 0; j < 4; ++j) { const f32x4 g = *((const GAS f32x4*)gpost + C.lane + 64 * j), gt = *((const GAS f32x4*)(mrow + mgate) + C.lane + 64 * j);
                v[j] = v[j] + gt * (f[j] * rstd * g);
                if (XOUT32) ((GAS f32x4*)(xout + (size_t)m * DM_) + C.lane)[64 * j] = v[j];
                else { u32x2 w; w.x = pkbf(v[j].x, v[j].y); w.y = pkbf(v[j].z, v[j].w); ((GAS u32x2*)(Xo + (size_t)m * DM_) + C.lane)[64 * j] = w; } }
            if (HAS_H) { ss = 0.f;
#pragma unroll
                for (int j = 0; j < 4; ++j) ss += (v[j].x * v[j].x + v[j].y * v[j].y) + (v[j].z * v[j].z + v[j].w * v[j].w);
                rstd = 1.0f / sqrtf(wave_sum(ss) * (1.0f / DM_) + EPS_);
                GAS u32x2* ho = (GAS u32x2*)(Hb + (size_t)m * DM_) + C.lane;
#pragma unroll
                for (int j = 0; j < 4; ++j) { const f32x4 g = *((const GAS f32x4*)gpre + C.lane + 64 * j), sc = *((const GAS f32x4*)(mrow + mscale) + C.lane + 64 * j), sh = *((const GAS f32x4*)(mrow + mshift) + C.lane + 64 * j);
                    const f32x4 h = v[j] * rstd * g * (sc + 1.0f) + sh; u32x2 w; w.x = pkbf(h.x, h.y); w.y = pkbf(h.z, h.w); ho[64 * j] = w; } } } }
    f32x4 vnA[4], vnB[4]; u32x4 xnA[2], xnB[2], fnA[2], fnB[2];
#define RN_LOAD(mm, vn, xn, fn) do { \
        if (XIN32) { const GAS f32x4* xr_ = (const GAS f32x4*)((mm) < MP ? xp + (size_t)(mm) * DM_ : xs + (size_t)((mm) - MP) * DM_) + 2 * C.lane; vn[0] = xr_[0]; vn[1] = xr_[1]; vn[2] = xr_[128]; vn[3] = xr_[129]; } \
        else { const GAS u32x4* xr_ = (const GAS u32x4*)(Xb + (size_t)(mm) * DM_) + C.lane; xn[0] = xr_[0]; xn[1] = xr_[64]; } \
        if (HAS_F) { const GAS u32x4* fr_ = (const GAS u32x4*)(Fb + (size_t)(mm) * DM_) + C.lane; fn[0] = fr_[0]; fn[1] = fr_[64]; } } while (0)
    const int RPW = (MROWS + C.NGW - 1) / C.NGW; int m = C.gw * RPW; const int mend = (m + RPW < MROWS) ? m + RPW : MROWS;
    int cur_sid = -1; f32x4 gg[4], aa[4], shv[4];
#define RN_VEC(ptr, q) (*((const GAS f32x4*)(ptr) + 2 * C.lane + ((q) >> 1) * 128 + ((q) & 1)))
#define RN_UNPK(src_, lo, hi) do { const u32x4 t_ = (src_); lo = (f32x4){bflo(t_.x), bfhi(t_.x), bflo(t_.y), bfhi(t_.y)}; hi = (f32x4){bflo(t_.z), bfhi(t_.z), bflo(t_.w), bfhi(t_.w)}; } while (0)
#define RN_ROW(mm, vn, xn, fn) do { \
        const int sid = sid_of_row(mm); \
        if (sid != cur_sid) { cur_sid = sid; const float* mrow = mod + (size_t)sid * 6144; \
            _Pragma("unroll") for (int q = 0; q < 4; ++q) { \
                if (HAS_F) gg[q] = RN_VEC(gpost, q) * RN_VEC(mrow + mgate, q); \
                if (HAS_H) { aa[q] = RN_VEC(gpre, q) * (RN_VEC(mrow + mscale, q) + 1.0f); shv[q] = RN_VEC(mrow + mshift, q); } } } \
        f32x4 v[4]; u32x4 fw[2]; \
        if (XIN32) { _Pragma("unroll") for (int q = 0; q < 4; ++q) v[q] = vn[q]; } else { RN_UNPK(xn[0], v[0], v[1]); RN_UNPK(xn[1], v[2], v[3]); } \
        fw[0] = fn[0]; fw[1] = fn[1]; \
        if ((mm) + 2 < mend) RN_LOAD((mm) + 2, vn, xn, fn); \
        if (HAS_F) { \
            f32x4 f[4]; float ss = 0.f; RN_UNPK(fw[0], f[0], f[1]); RN_UNPK(fw[1], f[2], f[3]); \
            _Pragma("unroll") for (int q = 0; q < 4; ++q) ss += (f[q].x * f[q].x + f[q].y * f[q].y) + (f[q].z * f[q].z + f[q].w * f[q].w); \
            const float rstd = 1.0f / sqrtf(wave_sum(ss) * (1.0f / DM_) + EPS_); \
            _Pragma("unroll") for (int q = 0; q < 4; ++q) v[q] = v[q] + gg[q] * (f[q] * rstd); \
            if (XOUT32) { GAS f32x4* xo_ = (GAS f32x4*)(xout + (size_t)(mm) * DM_) + 2 * C.lane; xo_[0] = v[0]; xo_[1] = v[1]; xo_[128] = v[2]; xo_[129] = v[3]; } \
            else { GAS u32x4* xo_ = (GAS u32x4*)(Xo + (size_t)(mm) * DM_) + C.lane; xo_[0] = pack8(v[0], v[1]); xo_[64] = pack8(v[2], v[3]); } \
        } \
        if (HAS_H) { \
            float ss = 0.f; \
            _Pragma("unroll") for (int q = 0; q < 4; ++q) ss += (v[q].x * v[q].x + v[q].y * v[q].y) + (v[q].z * v[q].z + v[q].w * v[q].w); \
            const float rstd = 1.0f / sqrtf(wave_sum(ss) * (1.0f / DM_) + EPS_); \
            GAS u32x4* ho = (GAS u32x4*)(Hb + (size_t)(mm) * DM_) + C.lane; \
            ho[0] = pack8(v[0] * rstd * aa[0] + shv[0], v[1] * rstd * aa[1] + shv[1]); ho[64] = pack8(v[2] * rstd * aa[2] + shv[2], v[3] * rstd * aa[3] + shv[3]); \
        } } while (0)
    if (m < mend) RN_LOAD(m, vnA, xnA, fnA);
    if (m + 1 < mend) RN_LOAD(m + 1, vnB, xnB, fnB);
    for (; m < mend; m += 2) {
        RN_ROW(m, vnA, xnA, fnA);
        if (m + 1 < mend) RN_ROW(m + 1, vnB, xnB, fnB);
    }
#undef RN_ROW
#undef RN_VEC
#undef RN_UNPK
#undef RN_LOAD
}
#define EPI_LOOP_ROWS for (int ai = 0; ai < 2; ++ai) _Pragma("unroll") for (int m = 0; m < 4; ++m)
typedef pg8::f32x2 f32x2;
__device__ __forceinline__ f32x4 gelu4(f32x4 v) { const f32x2 a = pg8::gelu_pk((f32x2){v[0], v[1]}), b = pg8::gelu_pk((f32x2){v[2], v[3]}); return (f32x4){a.x, a.y, b.x, b.y}; }
__device__ __forceinline__ f32x4 silu4(f32x4 v) { return (f32x4){siluf(v[0]), siluf(v[1]), siluf(v[2]), siluf(v[3])}; }

struct EpiPlain {
    static constexpr bool PERM = true, AFTER_DRAIN = false;
    bf16* O; int ldc;
    __device__ __forceinline__ void operator()(const f32x4 (&acc)[2][2][4][2], const pg8::Unit& u, int wr, int wc, int fr, int fq) const {
        const int row0 = u.pm * 256 + wr * 64 + fr, col0 = u.pn * 256 + wc * 32 + 8 * fq;
#pragma unroll
        EPI_LOOP_ROWS { bf16* rowp = O + (size_t)(row0 + ai * 128 + m * 16) * ldc + col0;
#pragma unroll
            for (int bj = 0; bj < 2; ++bj) *(u32x4*)(rowp + bj * 128) = pack8(acc[ai][bj][m][0], acc[ai][bj][m][1]); }
    }
};
struct EpiGelu {
    static constexpr bool PERM = true, AFTER_DRAIN = false;
    bf16* Z; float* stats;
    __device__ __forceinline__ void operator()(const f32x4 (&acc)[2][2][4][2], const pg8::Unit& u, int wr, int wc, int fr, int fq) const {
        const int row0 = u.pm * 256 + wr * 64 + fr, col0 = u.pn * 256 + wc * 32 + 8 * fq; const bool isv = u.pn >= 12;
#pragma unroll
        EPI_LOOP_ROWS { const int row = row0 + ai * 128 + m * 16; bf16* rowp = Z + ((size_t)(2 * u.pn) * MT + row) * 128 + wc * 32 + 8 * fq; float s = 0.f, q = 0.f;
#pragma unroll
            for (int bj = 0; bj < 2; ++bj) { const f32x4 a = gelu4(acc[ai][bj][m][0]), b = gelu4(acc[ai][bj][m][1]); *(u32x4*)(rowp + (size_t)bj * ((size_t)MT * 128)) = pack8(a, b);
                s += (a[0] + a[1]) + (a[2] + a[3]) + (b[0] + b[1]) + (b[2] + b[3]);
                q += (a[0] * a[0] + a[1] * a[1]) + (a[2] * a[2] + a[3] * a[3]) + (b[0] * b[0] + b[1] * b[1]) + (b[2] * b[2] + b[3] * b[3]); }
            if (isv) { s += __shfl_xor(s, 16); s += __shfl_xor(s, 32); q += __shfl_xor(q, 16); q += __shfl_xor(q, 32);
                if (fq == 0) { typedef float f32x2s __attribute__((ext_vector_type(2))); *(f32x2s*)(stats + ((size_t)row * 48 + (u.pn - 12) * 4 + wc) * 2) = (f32x2s){s, q}; } } }
    }
};
struct EpiSwiglu {
    static constexpr bool PERM = true, AFTER_DRAIN = false;
    bf16* O;
    __device__ __forceinline__ void operator()(const f32x4 (&acc)[2][2][4][2], const pg8::Unit& u, int wr, int wc, int fr, int fq) const {
        const int row0 = u.pm * 256 + wr * 64 + fr, col0 = u.pn * 128 + wc * 32 + 8 * fq;
#pragma unroll
        EPI_LOOP_ROWS { bf16* rowp = O + (size_t)(row0 + ai * 128 + m * 16) * FFH + col0;
            *(u32x4*)rowp = pack8(silu4(acc[ai][0][m][0]) * acc[ai][1][m][0], silu4(acc[ai][0][m][1]) * acc[ai][1][m][1]); }
    }
};
struct EpiDiff {
    static constexpr bool PERM = true, AFTER_DRAIN = false;
    bf16* Qb; float* kp; float* ks; float c2;
    __device__ __forceinline__ void operator()(const f32x4 (&acc)[2][2][4][2], const pg8::Unit& u, int wr, int wc, int fr, int fq) const {
        const int row0 = u.pm * 256 + wr * 64 + fr, t = u.pn >> 2, col0 = (u.pn & 3) * 256 + wc * 32 + 8 * fq;
        bf16* ob = Qb + (size_t)t * MT * DM_; const float sc = t == 0 ? c2 : 1.0f;
#pragma unroll
        EPI_LOOP_ROWS { const int row = row0 + ai * 128 + m * 16; bf16* rowp = ob + (size_t)row * DM_ + col0;
            float* fo = row < MP ? kp + (size_t)row * DM_ + (size_t)(t == 2 ? (O_VDP - O_KDP) : 0) : ks + (size_t)(row - MP) * DM_ + (size_t)(t == 2 ? (O_VDS - O_KDS) : 0);
#pragma unroll
            for (int bj = 0; bj < 2; ++bj) { const f32x4 a = acc[ai][bj][m][0] * sc, b = acc[ai][bj][m][1] * sc; *(u32x4*)(rowp + bj * 128) = pack8(a, b);
                if (t != 0) { *(f32x4*)(fo + col0 + bj * 128) = a; *(f32x4*)(fo + col0 + bj * 128 + 4) = b; } } }
    }
};
struct EpiRet {
    static constexpr bool PERM = true, AFTER_DRAIN = false;
    bf16* O; const float* tab;
    __device__ __forceinline__ void operator()(const f32x4 (&acc)[2][2][4][2], const pg8::Unit& u, int wr, int wc, int fr, int fq) const {
        const int row0 = u.pm * 256 + wr * 64 + fr, col0 = u.pn * 256 + wc * 32 + 8 * fq; const int t = u.pn < 4 ? 0 : (u.pn < 8 ? 1 : (u.pn < 16 ? 2 : 3));
        bf16* const QKp = O + (WS_LF - WS_BIG) / 2; bf16* const VVp = O + (WS_QD - WS_BIG) / 2;
#pragma unroll
        EPI_LOOP_ROWS { const int row = row0 + ai * 128 + m * 16; bf16* rowp = O + (size_t)row * 6144 + col0;
            const int pos = row < MP ? (row & 8191) : PAST + ((row - MP) & 15);
#pragma unroll
            for (int bj = 0; bj < 2; ++bj) { f32x4 a = acc[ai][bj][m][0], b = acc[ai][bj][m][1];
                if (t <= 1) { const int cl = (col0 + bj * 128) & 255; const float* tp = tab + ((size_t)pos * 128 + (cl >> 1)) * 2; const f32x4 t0 = *(const f32x4*)tp, t1 = *(const f32x4*)(tp + 4);
                    const int hd = ((col0 + bj * 128) >> 8) & 3; const float fac = exp2f(__log2f(1.0f - exp2f(-5.0f - (float)hd)) * (float)(row < MP ? (row & 63) : ((row - MP) & 15)));
                    const float sc = t == 1 ? 0.0625f * __builtin_amdgcn_rcpf(fac) : fac;
                    a = (f32x4){a[0] * t0[0] - a[1] * t0[1], a[1] * t0[0] + a[0] * t0[1], a[2] * t0[2] - a[3] * t0[3], a[3] * t0[2] + a[2] * t0[3]} * sc;
                    b = (f32x4){b[0] * t1[0] - b[1] * t1[1], b[1] * t1[0] + b[0] * t1[1], b[2] * t1[2] - b[3] * t1[3], b[3] * t1[2] + b[2] * t1[3]} * sc; }
                else if (t == 3) { a = silu4(a); b = silu4(b); }
                const int col = col0 + bj * 128;
                bf16* dst = t == 3 ? rowp + bj * 128 : (t == 2 ? VVp + ((size_t)((col - 2048) >> 5) * MT + row) * 32 + (col & 31) : QKp + ((size_t)((col >> 8) & 3) * MT + row) * 512 + (t == 1 ? 256 : 0) + (col & 255));
                *(u32x4*)dst = pack8(a, b); } }
    }
};
template <int N> __device__ __forceinline__ float dpp_row_shr(float x) { return __int_as_float(__builtin_amdgcn_update_dpp(0, __float_as_int(x), 0x110 + N, 0xf, 0xf, true)); }
struct EpiHgrn {
    static constexpr bool PERM = true, AFTER_DRAIN = false;
    bf16* HB; bf16* QD; bf16* KI; bf16* KE; float* EB; const float* lb;
    __device__ __forceinline__ void operator()(const f32x4 (&acc)[2][2][4][2], const pg8::Unit& u, int wr, int wc, int fr, int fq) const {
        const int row0 = u.pm * 256 + wr * 64 + fr;
        if (u.pn >= 8) { const int col0 = u.pn * 256 + wc * 32 + 8 * fq; const bool isg = u.pn >= 12; bf16* const VHp = HB + (WS_LF - WS_BIG) / 2;
            if (isg) {
#pragma unroll
                EPI_LOOP_ROWS { bf16* rowp = HB + (size_t)(row0 + ai * 128 + m * 16) * 4096 + col0;
#pragma unroll
                    for (int bj = 0; bj < 2; ++bj) { const f32x4 a = silu4(acc[ai][bj][m][0]), b = silu4(acc[ai][bj][m][1]); *(u32x4*)(rowp + bj * 128) = pack8(a, b); } }
            } else {
                const unsigned iv0 = (unsigned)(col0 - 2048), vo0 = (iv0 >> 4) * (unsigned)MT * 16u + (iv0 & 15u);
#pragma unroll
                EPI_LOOP_ROWS { bf16* rowp = VHp + vo0 + (unsigned)(row0 + ai * 128 + m * 16) * 16u;
#pragma unroll
                    for (int bj = 0; bj < 2; ++bj) *(u32x4*)(rowp + (size_t)bj * (8u * MT * 16u)) = pack8(acc[ai][bj][m][0], acc[ai][bj][m][1]); } }
            return; }
        const int d0 = u.pn * 128 + wc * 32 + 8 * fq; const bool smp = u.pm >= 128; const int bsrc = ((fq << 4) | 15) << 2;
#pragma unroll
        for (int n = 0; n < 2; ++n) { const f32x4 lbv = *(const f32x4*)(lb + d0 + 4 * n);
#pragma unroll
            for (int ai = 0; ai < 2; ++ai) { float lf[4][4], kk[4][4], tot[4][4];
#pragma unroll
                for (int m = 0; m < 4; ++m)
#pragma unroll
                    for (int j = 0; j < 4; ++j) { const float k = (1.0f - lbv[j]) * __builtin_amdgcn_rcpf(1.0f + __expf(acc[ai][1][m][n][j])); kk[m][j] = k; float x = log1pf(-k);
                        x += dpp_row_shr<1>(x); x += dpp_row_shr<2>(x); x += dpp_row_shr<4>(x); x += dpp_row_shr<8>(x); lf[m][j] = x;
                        tot[m][j] = __int_as_float(__builtin_amdgcn_ds_bpermute(bsrc, __float_as_int(x))); }
                float bl[4];
                if (!smp) {
#pragma unroll
                    for (int j = 0; j < 4; ++j) { float p = 0.f;
#pragma unroll
                        for (int m = 0; m < 4; ++m) { lf[m][j] += p; p += tot[m][j]; } bl[j] = p; } }
#pragma unroll
                for (int m = 0; m < 4; ++m) { const int row = row0 + ai * 128 + m * 16; float qd[4], ki[4], eb[4];
#pragma unroll
                    for (int j = 0; j < 4; ++j) { const float b = lf[m][j], bL = smp ? tot[m][j] : bl[j]; qd[j] = siluf(acc[ai][0][m][n][j]) * __expf(b); ki[j] = kk[m][j] * __expf(-b); eb[j] = __expf(bL); }
                    const unsigned o = ((unsigned)(d0 >> 7) * (unsigned)MT + (unsigned)row) * 128u + (unsigned)((d0 & 127) + 4 * n);
                    *(u32x2*)(QD + o) = (u32x2){pkbf(qd[0], qd[1]), pkbf(qd[2], qd[3])}; *(u32x2*)(KI + o) = (u32x2){pkbf(ki[0], ki[1]), pkbf(ki[2], ki[3])};
                    if (fr == 15 && (smp || m == 3)) { const int ch = smp ? 512 + ((row - MP) >> 4) : (row >> 6); *(f32x4*)(EB + (size_t)ch * DM_ + d0 + 4 * n) = (f32x4){eb[0], eb[1], eb[2], eb[3]}; } } } }
    }
};
struct FOrder {
    pg8::StaticOrder P; int nsub, G, c;
    __device__ __forceinline__ bool next(int i, pg8::Unit& u) const {
        if (P.next(i, u)) return true;
        const int idx = (i - 2) * G + c; if (idx < 0 || idx >= nsub) return false;
        u.pm = 128 + ((idx & 7) >> 2); u.pn = idx & 3; u.kb = (idx >> 3) * 512; u.nt = 4; return true; }
    __device__ __forceinline__ void a_ready(const pg8::Unit&) const {}
    __device__ __forceinline__ void done(const pg8::Unit&) const {}
};
struct EpiF {
    static constexpr bool PERM = true, AFTER_DRAIN = false;
    bf16* F; float* P;
    __device__ __forceinline__ void operator()(const f32x4 (&acc)[2][2][4][2], const pg8::Unit& u, int wr, int wc, int fr, int fq) const {
        const int row0 = u.pm * 256 + wr * 64 + fr, col0 = u.pn * 256 + wc * 32 + 8 * fq;
        if (u.nt == 0) {
#pragma unroll
            EPI_LOOP_ROWS { bf16* rowp = F + (size_t)(row0 + ai * 128 + m * 16) * DM_ + col0;
#pragma unroll
                for (int bj = 0; bj < 2; ++bj) *(u32x4*)(rowp + bj * 128) = pack8(acc[ai][bj][m][0], acc[ai][bj][m][1]); }
        } else { float* base = P + ((size_t)(u.kb >> 9) * 512 - MP) * 1024;
#pragma unroll
            EPI_LOOP_ROWS { float* rowp = base + (size_t)(row0 + ai * 128 + m * 16) * 1024 + col0;
#pragma unroll
                for (int bj = 0; bj < 2; ++bj) { *(f32x4*)(rowp + bj * 128) = acc[ai][bj][m][0]; *(f32x4*)(rowp + bj * 128 + 4) = acc[ai][bj][m][1]; } }
        }
    }
};
__device__ __forceinline__ void gmlp_gate_phase(const Ctx& C, const bf16* Z, const float* stats, const float* lng, const float* lnb, const float* w_s, const float* b_s, bf16* GO, float* gv_out) {
    constexpr int PW = 288;
    lptr Wl = C.lds, Vl = C.lds + 36864, Ml = C.lds + 73728; LAS float* st = (LAS float*)(C.lds + 110592); LAS float* bl = st + 256;
    const int lane = C.lane, w = C.wave, fq = lane >> 4, ln = lane & 15;
    const int g = C.vcu >> 5, cg = C.vcu & 31;
    int wstate = -1;
    for (int k = cg; k < 260 * 3; k += 32) {
        const int ch = k / 3, cb = 3 * g + (k - ch * 3), c0 = cb * 128, r0 = ch * 128; const bool smp = ch >= 256;
        __syncthreads();
        if (wstate != (smp ? 1 : 0)) { wstate = smp ? 1 : 0;
            for (int idx = C.tid; idx < 2048; idx += 512) { const int t = idx >> 4, s8 = (idx & 15) * 8; f32x4 a = {0.f, 0.f, 0.f, 0.f}, b = a; int lim;
                if (!smp) { const float* wp = w_s + ((size_t)g * 128 + t) * 128 + s8; a = *(const f32x4*)wp; b = *(const f32x4*)(wp + 4); lim = t - s8; }
                else { const int tl = t & 15, sl8 = s8 & 15; lim = -1; if ((t >> 4) == (s8 >> 4)) { const float* wp = w_s + ((size_t)g * 128 + tl) * 128 + sl8; a = *(const f32x4*)wp; b = *(const f32x4*)(wp + 4); lim = tl - sl8; } }
#pragma unroll
                for (int j = 0; j < 4; ++j) { if (j > lim) a[j] = 0.f; if (j + 4 > lim) b[j] = 0.f; }
                *(LAS u32x4*)(Wl + t * PW + s8 * 2) = pack8(a, b); }
            if (C.tid < 128) bl[C.tid] = b_s[g * 128 + (smp ? (C.tid & 15) : C.tid)]; }
        u32x4 zvr[4];
#pragma unroll
        for (int q4 = 0; q4 < 4; ++q4) { const int idx = C.tid + 512 * q4; zvr[q4] = *(const u32x4*)(Z + ((size_t)(24 + cb) * MT + r0 + (idx >> 4)) * 128 + (idx & 15) * 8); }
        { const int r = C.tid >> 2, part = C.tid & 3; const f32x4* sp = (const f32x4*)(stats + (size_t)(r0 + r) * 96) + part * 6; float s = 0.f, q = 0.f;
#pragma unroll
            for (int i = 0; i < 6; ++i) { const f32x4 x = sp[i]; s += x[0]; q += x[1]; s += x[2]; q += x[3]; }
            s += __shfl_xor(s, 1); q += __shfl_xor(q, 1); s += __shfl_xor(s, 2); q += __shfl_xor(q, 2);
            const float mu = s * (1.0f / GH), var = q * (1.0f / GH) - mu * mu;
            if (part == 0) { st[2 * r] = mu; st[2 * r + 1] = 1.0f / sqrtf(fmaxf(var, 0.f) + EPS_); } }
        __syncthreads();
#pragma unroll
        for (int q4 = 0; q4 < 4; ++q4) { const int idx = C.tid + 512 * q4; const int s = idx >> 4, c8 = (idx & 15) * 8; const u32x4 zv = zvr[q4];
            const f32x4 g0 = *(const f32x4*)(lng + c0 + c8), g1 = *(const f32x4*)(lng + c0 + c8 + 4), b0 = *(const f32x4*)(lnb + c0 + c8), b1 = *(const f32x4*)(lnb + c0 + c8 + 4);
            const float mu = st[2 * s], rs = st[2 * s + 1];
            f32x4 a = {bflo(zv.x), bfhi(zv.x), bflo(zv.y), bfhi(zv.y)}, b = {bflo(zv.z), bfhi(zv.z), bflo(zv.w), bfhi(zv.w)};
            a = (a - mu) * rs * g0 + b0; b = (b - mu) * rs * g1 + b1;
            *(LAS u32x4*)(Vl + s * PW + c8 * 2) = pack8(a, b);
            if (smp) { float* go = gv_out + (size_t)(r0 + s - MP) * GH + c0 + c8; *(f32x4*)go = a; *(f32x4*)(go + 4) = b; } }
        u32x4 uvr[4];
#pragma unroll
        for (int q4 = 0; q4 < 4; ++q4) { const int idx = C.tid + 512 * q4; uvr[q4] = *(const u32x4*)(Z + ((size_t)cb * MT + r0 + (idx >> 4)) * 128 + (idx & 15) * 8); }
        __syncthreads();
        f32x4 acc[8];
#pragma unroll
        for (int nt = 0; nt < 8; ++nt) acc[nt] = (f32x4){0.f, 0.f, 0.f, 0.f};
#pragma unroll
        for (int ks = 0; ks < 4; ++ks) if (32 * ks <= 16 * w + 15) { const bf16x8 A = frag_row(Wl, PW, 16 * w, 32 * ks, lane);
#pragma unroll
            for (int nt = 0; nt < 8; ++nt) { const bf16x8 B = frag_tr(Vl, PW, 32 * ks, 16 * nt, lane); acc[nt] = mma32(A, B, acc[nt]); } }
#pragma unroll
        for (int nt = 0; nt < 8; ++nt)
#pragma unroll
            for (int i = 0; i < 4; ++i) { const int t = 16 * w + 4 * fq + i; *(LAS bf16*)(Ml + t * PW + (16 * nt + ln) * 2) = (bf16)f2bf(acc[nt][i] + bl[t]); }
        __syncthreads();
#pragma unroll
        for (int q4 = 0; q4 < 4; ++q4) { const int idx = C.tid + 512 * q4; const int t = idx >> 4, c8 = (idx & 15) * 8; const u32x4 uv = uvr[q4], mv = *(const LAS u32x4*)(Ml + t * PW + c8 * 2);
            u32x4 o; o.x = pkbf(bflo(uv.x) * bflo(mv.x), bfhi(uv.x) * bfhi(mv.x)); o.y = pkbf(bflo(uv.y) * bflo(mv.y), bfhi(uv.y) * bfhi(mv.y));
            o.z = pkbf(bflo(uv.z) * bflo(mv.z), bfhi(uv.z) * bfhi(mv.z)); o.w = pkbf(bflo(uv.w) * bflo(mv.w), bfhi(uv.w) * bfhi(mv.w));
            *(u32x4*)(GO + (size_t)(r0 + t) * GH + c0 + c8) = o; }
    }
    __syncthreads();
}

__device__ __forceinline__ float diff_lambda(const float* lamp, int lane) {
    const float p1 = lamp[lane] * lamp[64 + lane], p2 = lamp[128 + lane] * lamp[192 + lane];
    return expf(wave_sum(p1)) - expf(wave_sum(p2)) + LAM_INIT;
}
__device__ __forceinline__ void diff_combine_phase(const Ctx& C, const bf16* O4, const float* lamp, const float* subln, bf16* A2) {
    const float lam = diff_lambda(lamp, C.lane); const int lane = C.lane, h = lane >> 3, sub = lane & 7, dv0 = sub * 16;
    float gsc[16];
#pragma unroll
    for (int j = 0; j < 16; ++j) gsc[j] = subln[dv0 + j] * (1.0f - LAM_INIT);
    u32x4 a0n, a1n, b0n, b1n;
#define DC_LOAD(mm) do { const bf16* p0_ = O4 + (size_t)(mm) * 2048 + h * 256 + dv0; a0n = *(const u32x4*)p0_; a1n = *(const u32x4*)(p0_ + 8); b0n = *(const u32x4*)(p0_ + 128); b1n = *(const u32x4*)(p0_ + 136); } while (0)
    if (C.gw < MP) DC_LOAD(C.gw);
    for (int m = C.gw; m < MP; m += C.NGW) {
        const u32x4 a0 = a0n, a1 = a1n, b0 = b0n, b1 = b1n;
        if (m + C.NGW < MP) DC_LOAD(m + C.NGW);
        float o[16]; const unsigned aw[8] = {a0.x, a0.y, a0.z, a0.w, a1.x, a1.y, a1.z, a1.w}, bw[8] = {b0.x, b0.y, b0.z, b0.w, b1.x, b1.y, b1.z, b1.w}; float ss = 0.f;
#pragma unroll
        for (int j = 0; j < 8; ++j) { o[2 * j] = bflo(aw[j]) - lam * bflo(bw[j]); o[2 * j + 1] = bfhi(aw[j]) - lam * bfhi(bw[j]); ss += o[2 * j] * o[2 * j] + o[2 * j + 1] * o[2 * j + 1]; }
        ss += __shfl_xor(ss, 1); ss += __shfl_xor(ss, 2); ss += __shfl_xor(ss, 4);
        const float rstd = 1.0f / sqrtf(ss * (1.0f / 128.0f) + EPS_);
        u32x4 w0, w1; w0.x = pkbf(o[0] * rstd * gsc[0], o[1] * rstd * gsc[1]); w0.y = pkbf(o[2] * rstd * gsc[2], o[3] * rstd * gsc[3]); w0.z = pkbf(o[4] * rstd * gsc[4], o[5] * rstd * gsc[5]); w0.w = pkbf(o[6] * rstd * gsc[6], o[7] * rstd * gsc[7]);
        w1.x = pkbf(o[8] * rstd * gsc[8], o[9] * rstd * gsc[9]); w1.y = pkbf(o[10] * rstd * gsc[10], o[11] * rstd * gsc[11]); w1.z = pkbf(o[12] * rstd * gsc[12], o[13] * rstd * gsc[13]); w1.w = pkbf(o[14] * rstd * gsc[14], o[15] * rstd * gsc[15]);
        bf16* op = A2 + (size_t)m * DM_ + h * 128 + dv0; *(u32x4*)op = w0; *(u32x4*)(op + 8) = w1;
    }
}

__device__ __forceinline__ void diff_sample_phase(const Ctx& C, const bf16* Qb, const float* ck, const float* cv, const float* kds, const float* vds, const float lam, const float* subln, bf16* A2) {
    constexpr int PK = 288, PV = 136, KBUF = 64 * PK, VBUF = 128 * PV;
    lptr Kl0 = C.lds, Vt0 = C.lds + 2 * KBUF;
    LAS float* Om = (LAS float*)C.lds; LAS float* ml = (LAS float*)(C.lds + 65536);
    const int lane = C.lane, fq = lane >> 4, ln = lane & 15, s = C.wave & 1, kt = C.wave >> 1, key = C.tid >> 3, part = C.tid & 7;
    for (int u = C.vcu; u < 256; u += C.G) {
        const int sb = u >> 3, h = u & 7;
        const bf16* qp = Qb + (size_t)(MP + 16 * sb + ln) * DM_ + (2 * h + s) * 64 + 8 * fq;
        const bf16x8 qf0 = *(const bf16x8*)qp, qf1 = *(const bf16x8*)(qp + 32);
        float mrun = -INFINITY, lrun = 0.f; f32x4 o[8];
#pragma unroll
        for (int dt = 0; dt < 8; ++dt) o[dt] = (f32x4){0.f, 0.f, 0.f, 0.f};
        f32x4 kr[4], vr[4];
#define DS_LOAD(T) do { const float* kp_; const float* vp_; bool ok_ = true; \
            if ((T) < 64) { kp_ = ck + ((size_t)(sb * PAST + 64 * (T) + key) * 16 + 2 * h) * 64 + 16 * part; vp_ = cv + ((size_t)(sb * PAST + 64 * (T) + key) * 8 + h) * 128 + 16 * part; } \
            else { ok_ = key < 16; kp_ = kds + ((size_t)(sb * 16 + (key & 15)) * 16 + 2 * h) * 64 + 16 * part; vp_ = vds + ((size_t)(sb * 16 + (key & 15)) * 8 + h) * 128 + 16 * part; } \
            _Pragma("unroll") for (int i_ = 0; i_ < 4; ++i_) { kr[i_] = ok_ ? *(const f32x4*)(kp_ + 4 * i_) : (f32x4){0.f, 0.f, 0.f, 0.f}; vr[i_] = ok_ ? *(const f32x4*)(vp_ + 4 * i_) : (f32x4){0.f, 0.f, 0.f, 0.f}; } } while (0)
        DS_LOAD(0);
        __syncthreads();
        for (int T = 0; T <= 64; ++T) {
            lptr Kl = Kl0 + (T & 1) * KBUF, Vt = Vt0 + (T & 1) * VBUF;
            *(LAS u32x4*)(Kl + key * PK + part * 32) = pack8(kr[0], kr[1]); *(LAS u32x4*)(Kl + key * PK + part * 32 + 16) = pack8(kr[2], kr[3]);
#pragma unroll
            for (int i = 0; i < 4; ++i)
#pragma unroll
                for (int j = 0; j < 4; ++j) *(LAS bf16*)(Vt + (16 * part + 4 * i + j) * PV + key * 2) = (bf16)f2bf(vr[i][j]);
            __syncthreads();
            if (T < 64) DS_LOAD(T + 1);
            if (T < 64 || kt == 0) {
                f32x4 sc = {0.f, 0.f, 0.f, 0.f};
                sc = mma32(frag_row(Kl, PK, 16 * kt, s * 64, lane), qf0, sc); sc = mma32(frag_row(Kl, PK, 16 * kt, s * 64 + 32, lane), qf1, sc);
                float mx = fmaxf(fmaxf(sc[0], sc[1]), fmaxf(sc[2], sc[3])); mx = fmaxf(mx, shx(mx, 16, lane)); mx = fmaxf(mx, shx(mx, 32, lane));
                const float mn = fmaxf(mrun, mx), alpha = exp2f(mrun - mn); mrun = mn;
                const float p0 = exp2f(sc[0] - mn), p1 = exp2f(sc[1] - mn), p2 = exp2f(sc[2] - mn), p3 = exp2f(sc[3] - mn);
                lrun = lrun * alpha + ((p0 + p1) + (p2 + p3));
                const u32x2 pw = {pkbf(p0, p1), pkbf(p2, p3)}; const s16x4 P = __builtin_bit_cast(s16x4, pw);
#pragma unroll
                for (int dt = 0; dt < 8; ++dt) { const s16x4 A = *(const LAS s16x4*)(Vt + (16 * dt + ln) * PV + (16 * kt + 4 * fq) * 2); o[dt] = mma16(A, P, o[dt] * alpha); }
            }
        }
#undef DS_LOAD
        lrun += shx(lrun, 16, lane); lrun += shx(lrun, 32, lane);
        __syncthreads();
        if (fq == 0) { ml[C.wave * 16 + ln] = mrun; ml[128 + C.wave * 16 + ln] = lrun; }
#pragma unroll
        for (int dt = 0; dt < 8; ++dt) *(LAS f32x4*)(Om + (C.wave * 16 + ln) * 128 + 16 * dt + 4 * fq) = o[dt];
        __syncthreads();
        { const int q = C.tid >> 5, dv4 = (C.tid & 31) * 4; f32x4 os[2];
#pragma unroll
            for (int ss = 0; ss < 2; ++ss) { float M = -INFINITY;
#pragma unroll
                for (int k = 0; k < 4; ++k) M = fmaxf(M, ml[(2 * k + ss) * 16 + q]);
                float Ls = 0.f; f32x4 a = {0.f, 0.f, 0.f, 0.f};
#pragma unroll
                for (int k = 0; k < 4; ++k) { const int wv = 2 * k + ss; const float e = exp2f(ml[wv * 16 + q] - M); Ls += ml[128 + wv * 16 + q] * e; a = a + *(const LAS f32x4*)(Om + (wv * 16 + q) * 128 + dv4) * e; }
                os[ss] = a * (1.0f / Ls); }
            const f32x4 od = os[0] - os[1] * lam; float ssq = (od[0] * od[0] + od[1] * od[1]) + (od[2] * od[2] + od[3] * od[3]);
#pragma unroll
            for (int x = 1; x < 32; x <<= 1) ssq += shx(ssq, x, lane);
            const float rstd = 1.0f / sqrtf(ssq * (1.0f / 128.0f) + EPS_) * (1.0f - LAM_INIT); const f32x4 g = *(const f32x4*)(subln + dv4);
            u32x2 wv2; wv2.x = pkbf(od[0] * rstd * g[0], od[1] * rstd * g[1]); wv2.y = pkbf(od[2] * rstd * g[2], od[3] * rstd * g[3]);
            *(u32x2*)(A2 + (size_t)(MP + 16 * sb + q) * DM_ + h * 128 + dv4) = wv2; }
        __syncthreads();
    }
}
__device__ __forceinline__ void dma16(const void* gsrc, lptr dst) { unsigned keep; const unsigned d = __builtin_amdgcn_readfirstlane((unsigned)(__SIZE_TYPE__)dst);
    asm volatile("s_mov_b32 %0, m0\n\ts_mov_b32 m0, %2\n\ts_nop 0\n\tglobal_load_lds_dwordx4 %1, off\n\ts_mov_b32 m0, %0" : "=&s"(keep) : "v"(gsrc), "s"(d) : "memory"); }
__device__ __forceinline__ int swz512(int r, int c) { return r * 512 + (((c & 16) | ((c ^ r) & 15)) << 4); }
__device__ __forceinline__ bf16x8 frag_row_s(lptr base, int x0, int k0, int lane) { const int r = x0 + (lane & 15), c = (k0 >> 3) + (lane >> 4); return *(const LAS bf16x8*)(base + swz512(r, c)); }
__device__ __forceinline__ bf16x8 frag_tr_s(lptr base, int k0, int x0, int lane) {
    const int g = lane >> 4, i = lane & 15, q = i >> 2, pq = i & 3; const int r0 = k0 + 8 * g + q, c = (x0 + 4 * pq) >> 3, off = (pq & 1) * 8;
    const s16x4 lo = __builtin_bit_cast(s16x4, __builtin_amdgcn_ds_read_tr16_b64_v4i16((LAS v4i16_t*)(base + swz512(r0, c) + off)));
    const s16x4 hi = __builtin_bit_cast(s16x4, __builtin_amdgcn_ds_read_tr16_b64_v4i16((LAS v4i16_t*)(base + swz512(r0 + 4, c) + off)));
    return (bf16x8){lo[0], lo[1], lo[2], lo[3], hi[0], hi[1], hi[2], hi[3]};
}
#ifndef RETPROBE
#define RETPROBE 0
#endif
__device__ __forceinline__ f32x4 keep3(bf16x8 a, bf16x8 b, f32x4 c) { asm volatile("" :: "v"(a), "v"(b)); return c; }
__device__ __forceinline__ void ret_scan_phase(const Ctx& C, const bf16* BIG, const float* st_in, bf16* Or, float* st_out_p, float* st_out_s, const bool crip = false) {
    const bf16* const QK = BIG + (WS_LF - WS_BIG) / 2; const bf16* const VV = BIG + (WS_QD - WS_BIG) / 2;
    const bool c_nodma = crip && (RETPROBE == 2 || RETPROBE >= 7), c_nobar = crip && (RETPROBE == 3 || RETPROBE == 8), c_one = crip && RETPROBE == 1, c_nolds = crip && (RETPROBE == 4 || RETPROBE == 7), c_nomma = crip && (RETPROBE == 5 || RETPROBE == 9);
#define RMMA(a_, b_, c_) (c_nomma ? keep3(a_, b_, c_) : mma32(a_, b_, c_))
    constexpr int PP = 160, PS = 544;
    lptr Ql = C.lds, Kl0 = Ql + 32768, Vl0 = Kl0 + 65536, Pl = Vl0 + 8192, Sl = Pl + 64 * PP;
    const int lane = C.lane, w = C.wave, fq = lane >> 4, ln = lane & 15, tid = C.tid;
    for (int u = C.vcu; u < 256 + 2048; u += C.G) {
        int h, j, row0, nsteps, L; const float* sin_ = nullptr; float* sout;
        if (u < 256) { const int b = u >> 6; h = (u >> 4) & 3; j = u & 15; row0 = b * SEQ_; nsteps = c_one ? 1 : 128; L = 64; sout = st_out_p + ((size_t)(b * 4 + h) * 256) * 512 + 32 * j; }
        else { const int su = u - 256, sb = su >> 6; h = (su >> 4) & 3; j = su & 15; row0 = MP + 16 * sb; nsteps = 1; L = 16; sin_ = st_in + ((size_t)(sb * 4 + h) * 256) * 512 + 32 * j; sout = st_out_s + ((size_t)(sb * 4 + h) * 256) * 512 + 32 * j; }
        const float lg2 = __log2f(1.0f - exp2f(-5.0f - (float)h)), gam = exp2f(lg2), gLm1 = exp2f(lg2 * (float)(L - 1));
        f32x4 st[2][2];
#pragma unroll
        for (int dt = 0; dt < 2; ++dt)
#pragma unroll
            for (int vt = 0; vt < 2; ++vt)
#pragma unroll
                for (int i = 0; i < 4; ++i) st[dt][vt][i] = sin_ ? sin_[(size_t)(16 * (2 * w + dt) + 4 * fq + i) * 512 + 16 * vt + ln] : 0.f;
        float mk[2][4];
        { const int t = 16 * (w >> 1) + ln;
#pragma unroll
            for (int x = 0; x < 2; ++x)
#pragma unroll
                for (int i = 0; i < 4; ++i) { const int s = 16 * (2 * (w & 1) + x) + 4 * fq + i; mk[x][i] = (s <= t && s < L) ? 1.f : 0.f; } }
        size_t qoff[4];
#pragma unroll
        for (int i = 0; i < 4; ++i) { const int pi = 4 * w + i, r = 2 * pi + (lane >> 5), pc = lane & 31, c = (pc & 16) | ((pc ^ r) & 15), rc = r < L ? r : L - 1; qoff[i] = ((size_t)h * MT + rc) * 512 + c * 8; }
        const int vrow = 16 * (w & 3) + (lane >> 2); const size_t voff = ((size_t)(h * 16 + j) * MT + vrow) * 32 + (lane & 3) * 8; const bool vdo = w < 4 && 16 * w < L;
        __builtin_amdgcn_s_waitcnt(0); __builtin_amdgcn_s_barrier();
        if (L < 64) { const u32x4 z4 = {0u, 0u, 0u, 0u}; if (((tid & 255) >> 2) >= L) *(LAS u32x4*)(Vl0 + tid * 16) = z4; }
#define RET_DMA_Q(n) do { const bf16* qb_ = QK + (size_t)(row0 + 64 * (n)) * 512; _Pragma("unroll") for (int i_ = 0; i_ < 4; ++i_) \
            dma16(qb_ + qoff[i_], Ql + (4 * w + i_) * 1024); } while (0)
#define RET_DMA_KV(n) do { const bf16* kb_ = QK + (size_t)(row0 + 64 * (n)) * 512; lptr kd_ = Kl0 + ((n) & 1) * 32768; _Pragma("unroll") for (int i_ = 0; i_ < 4; ++i_) \
            dma16(kb_ + qoff[i_] + 256, kd_ + (4 * w + i_) * 1024); \
            if (vdo) dma16(VV + (size_t)(row0 + 64 * (n)) * 32 + voff, Vl0 + ((n) & 1) * 4096 + (w & 3) * 1024); } while (0)
        RET_DMA_KV(0); RET_DMA_Q(0);
        u32x2 ow = {0u, 0u}; bf16* const orow = Or + (size_t)(row0 + 16 * (w >> 1) + ln) * 2048 + h * 512 + 32 * j + 16 * (w & 1) + 4 * fq; const bool odo = 16 * (w >> 1) + ln < L;
        for (int n = 0; n < nsteps; ++n) {
            lptr Kl = Kl0 + (n & 1) * 32768, Vl = Vl0 + (n & 1) * 4096;
            asm volatile("s_waitcnt vmcnt(0) lgkmcnt(0)" ::: "memory"); if (!c_nobar) __builtin_amdgcn_s_barrier(); asm volatile("" ::: "memory");
            if (n > 0 && odo && !c_nodma) *(u32x2*)(orow + (size_t)(n - 1) * (64 * 2048)) = ow;
            if (n + 1 < nsteps && !c_nodma) RET_DMA_KV(n + 1);
            bf16x8 qf[8];
            { const int ti = w >> 1, si0 = 2 * (w & 1); bf16x8 kf0[8], kf1[8];
#pragma unroll
                for (int ks = 0; ks < 8; ++ks) { if (!c_nolds) { qf[ks] = frag_row_s(Ql, 16 * ti, 32 * ks, lane); kf0[ks] = frag_row_s(Kl, 16 * si0, 32 * ks, lane); kf1[ks] = frag_row_s(Kl, 16 * si0 + 16, 32 * ks, lane); } else { qf[ks] = (bf16x8){(short)ks, 1, 2, 3, 4, 5, 6, 7}; kf0[ks] = qf[ks]; kf1[ks] = qf[ks]; } }
                __builtin_amdgcn_sched_barrier(0);
                f32x4 a0 = {0.f, 0.f, 0.f, 0.f}, a1 = a0, a2 = a0, a3 = a0;
#pragma unroll
                for (int ks = 0; ks < 8; ks += 2) { a0 = RMMA(kf0[ks], qf[ks], a0); a1 = RMMA(kf1[ks], qf[ks], a1); a2 = RMMA(kf0[ks + 1], qf[ks + 1], a2); a3 = RMMA(kf1[ks + 1], qf[ks + 1], a3); }
#pragma unroll
                for (int dt = 0; dt < 2; ++dt)
#pragma unroll
                    for (int vt = 0; vt < 2; ++vt) { const u32x2 sw = {pkbf(st[dt][vt][0], st[dt][vt][1]), pkbf(st[dt][vt][2], st[dt][vt][3])}; *(LAS u32x2*)(Sl + (16 * vt + ln) * PS + (16 * (2 * w + dt) + 4 * fq) * 2) = sw; }
                a0 = a0 + a2; a1 = a1 + a3;
                const int t = 16 * ti + ln;
#pragma unroll
                for (int x = 0; x < 2; ++x) { const f32x4 a = x ? a1 : a0; const int sb0 = 16 * (si0 + x) + 4 * fq;
                    const u32x2 pw = {pkbf(a[0] * mk[x][0], a[1] * mk[x][1]), pkbf(a[2] * mk[x][2], a[3] * mk[x][3])}; *(LAS u32x2*)(Pl + t * PP + sb0 * 2) = pw; } }
            asm volatile("s_waitcnt lgkmcnt(0)" ::: "memory"); if (!c_nobar) __builtin_amdgcn_s_barrier(); asm volatile("" ::: "memory");
            if (n + 1 < nsteps && !c_nodma) RET_DMA_Q(n + 1);
            { const int vi = w & 1, ti = w >> 1; bf16x8 sf[8], pf[2], vt_[2], ka[2][2], vb[2][2];
#pragma unroll
                for (int ks = 0; ks < 8; ++ks) sf[ks] = c_nolds ? qf[ks] : frag_row(Sl, PS, 16 * vi, 32 * ks, lane);
#pragma unroll
                for (int ks = 0; ks < 2; ++ks) { if (!c_nolds) { pf[ks] = frag_row(Pl, PP, 16 * ti, 32 * ks, lane); vt_[ks] = frag_tr(Vl, 64, 32 * ks, 16 * vi, lane); } else { pf[ks] = qf[ks]; vt_[ks] = qf[ks + 2]; } }
#pragma unroll
                for (int x = 0; x < 2; ++x)
#pragma unroll
                    for (int ks = 0; ks < 2; ++ks) { if (!c_nolds) { ka[x][ks] = frag_tr_s(Kl, 32 * ks, 16 * (2 * w + x), lane); vb[x][ks] = frag_tr(Vl, 64, 32 * ks, 16 * x, lane); } else { ka[x][ks] = qf[2 * x + ks]; vb[x][ks] = qf[4 + 2 * x + ks]; } }
                __builtin_amdgcn_sched_barrier(0);
                f32x4 oi = {0.f, 0.f, 0.f, 0.f}, oc = oi, oc2 = oi;
#pragma unroll
                for (int ks = 0; ks < 8; ks += 2) { oc = RMMA(sf[ks], qf[ks], oc); oc2 = RMMA(sf[ks + 1], qf[ks + 1], oc2); }
#pragma unroll
                for (int ks = 0; ks < 2; ++ks) if (32 * ks <= 16 * ti + 15) oi = RMMA(vt_[ks], pf[ks], oi);
#pragma unroll
                for (int dt = 0; dt < 2; ++dt)
#pragma unroll
                    for (int vt = 0; vt < 2; ++vt) { f32x4 a = st[dt][vt] * gam;
#pragma unroll
                        for (int ks = 0; ks < 2; ++ks) a = RMMA(ka[dt][ks], vb[vt][ks], a);
                        st[dt][vt] = a * gLm1; }
                oc = (oc + oc2) * gam;
                ow = (u32x2){pkbf(oi[0] + oc[0], oi[1] + oc[1]), pkbf(oi[2] + oc[2], oi[3] + oc[3])}; }
        }
#undef RET_DMA_Q
#undef RET_DMA_KV
        if (odo) *(u32x2*)(orow + (size_t)(nsteps - 1) * (64 * 2048)) = ow;
#pragma unroll
        for (int dt = 0; dt < 2; ++dt)
#pragma unroll
            for (int vt = 0; vt < 2; ++vt)
#pragma unroll
                for (int i = 0; i < 4; ++i) sout[(size_t)(16 * (2 * w + dt) + 4 * fq + i) * 512 + 16 * vt + ln] = st[dt][vt][i];
    }
    asm volatile("s_waitcnt vmcnt(0) lgkmcnt(0)" ::: "memory"); __syncthreads();
}
#undef RMMA
__device__ __forceinline__ void ret_post_phase(const Ctx& C, const bf16* Or, const bf16* BIG, bf16* A3) {
    const int lane = C.lane, h = lane >> 4, c0 = h * 512 + (lane & 15) * 32;
    u32x4 on[4], gn[4];
#define RP_LOAD(mm) do { const u32x4* op_ = (const u32x4*)(Or + (size_t)(mm) * 2048 + c0); const u32x4* gp_ = (const u32x4*)(BIG + (size_t)(mm) * 6144 + 4096 + c0); \
        _Pragma("unroll") for (int i_ = 0; i_ < 4; ++i_) { on[i_] = op_[i_]; gn[i_] = gp_[i_]; } } while (0)
    int m = C.gw;
    if (m < MT) RP_LOAD(m);
    for (; m < MT; m += C.NGW) {
        u32x4 ov[4], gv[4]; float ss = 0.f;
#pragma unroll
        for (int i = 0; i < 4; ++i) { ov[i] = on[i]; gv[i] = gn[i]; }
        if (m + C.NGW < MT) RP_LOAD(m + C.NGW);
#pragma unroll
        for (int i = 0; i < 4; ++i) { const unsigned ww[4] = {ov[i].x, ov[i].y, ov[i].z, ov[i].w};
#pragma unroll
            for (int k = 0; k < 4; ++k) { const float a = bflo(ww[k]), b = bfhi(ww[k]); ss += a * a + b * b; } }
        ss += __shfl_xor(ss, 1); ss += __shfl_xor(ss, 2); ss += __shfl_xor(ss, 4); ss += __shfl_xor(ss, 8);
        const float rstd = 1.0f / sqrtf(ss * (1.0f / 512.0f) + EPS_);
        u32x4* ap = (u32x4*)(A3 + (size_t)m * 2048 + c0);
#pragma unroll
        for (int i = 0; i < 4; ++i) { const unsigned ww[4] = {ov[i].x, ov[i].y, ov[i].z, ov[i].w}, gg[4] = {gv[i].x, gv[i].y, gv[i].z, gv[i].w}; unsigned r[4];
#pragma unroll
            for (int k = 0; k < 4; ++k) r[k] = pkbf(bflo(ww[k]) * rstd * bflo(gg[k]), bfhi(ww[k]) * rstd * bfhi(gg[k]));
            ap[i] = (u32x4){r[0], r[1], r[2], r[3]}; }
    }
#undef RP_LOAD
}

__device__ __forceinline__ void hgrn_prep_phase(const Ctx& C, const bf16* HB, const float* LF, bf16* QD, bf16* KI, bf16* KE, float* EB) {
    LAS float* part = (LAS float*)C.lds;
    const int w = C.wave, lane = C.lane;
    for (int u = C.vcu; u < 544 * 2; u += C.G) {
        const int cidx = u >> 1, col = (u & 1) * 512 + lane * 8; const int r0 = cidx < 512 ? 64 * cidx : MP + 16 * (cidx - 512), R = cidx < 512 ? 8 : 2;
        const int rw = r0 + w * R;
        f32x4 la[8], lb_[8];
#pragma unroll
        for (int t = 0; t < 8; ++t) if (t < R) { const float* lp = LF + (size_t)(rw + t) * DM_ + col; la[t] = *(const f32x4*)lp; lb_[t] = *(const f32x4*)(lp + 4); }
        u32x4 qv[8], kv[8];
#pragma unroll
        for (int t = 0; t < 8; ++t) if (t < R) { const bf16* hp = HB + (size_t)(rw + t) * 4096 + col; qv[t] = *(const u32x4*)hp; kv[t] = *(const u32x4*)(hp + 1024); }
        f32x4 sa = {0.f, 0.f, 0.f, 0.f}, sb = sa;
#pragma unroll
        for (int t = 0; t < 8; ++t) if (t < R) { sa = sa + la[t]; sb = sb + lb_[t]; la[t] = sa; lb_[t] = sb; }
        __syncthreads();
        *(LAS f32x4*)(part + w * 512 + lane * 8) = sa; *(LAS f32x4*)(part + w * 512 + lane * 8 + 4) = sb;
        __syncthreads();
        f32x4 pa = {0.f, 0.f, 0.f, 0.f}, pb = pa, ta = pa, tb = pa;
#pragma unroll
        for (int g = 0; g < 8; ++g) { const f32x4 xa = *(const LAS f32x4*)(part + g * 512 + lane * 8), xb = *(const LAS f32x4*)(part + g * 512 + lane * 8 + 4);
            if (g < w) { pa = pa + xa; pb = pb + xb; } ta = ta + xa; tb = tb + xb; }
        if (w == 0) { float* ep = EB + (size_t)cidx * DM_ + col; *(f32x4*)ep = (f32x4){__expf(ta[0]), __expf(ta[1]), __expf(ta[2]), __expf(ta[3])}; *(f32x4*)(ep + 4) = (f32x4){__expf(tb[0]), __expf(tb[1]), __expf(tb[2]), __expf(tb[3])}; }
#pragma unroll
        for (int t = 0; t < 8; ++t) if (t < R) {
            const f32x4 ba = la[t] + pa, bb = lb_[t] + pb; float b[8] = {ba[0], ba[1], ba[2], ba[3], bb[0], bb[1], bb[2], bb[3]}; const float bl[8] = {ta[0], ta[1], ta[2], ta[3], tb[0], tb[1], tb[2], tb[3]};
            const unsigned qw[4] = {qv[t].x, qv[t].y, qv[t].z, qv[t].w}, kw[4] = {kv[t].x, kv[t].y, kv[t].z, kv[t].w}; unsigned oq[4], oi[4], oe[4];
#pragma unroll
            for (int k = 0; k < 4; ++k) { const float e0 = __expf(b[2 * k]), e1 = __expf(b[2 * k + 1]), k0 = bflo(kw[k]), k1 = bfhi(kw[k]);
                oq[k] = pkbf(bflo(qw[k]) * e0, bfhi(qw[k]) * e1); oi[k] = pkbf(k0 * __expf(-b[2 * k]), k1 * __expf(-b[2 * k + 1])); oe[k] = pkbf(k0 * __expf(bl[2 * k] - b[2 * k]), k1 * __expf(bl[2 * k + 1] - b[2 * k + 1])); }
            const size_t o = (size_t)(rw + t) * DM_ + col;
            *(u32x4*)(QD + o) = (u32x4){oq[0], oq[1], oq[2], oq[3]}; *(u32x4*)(KI + o) = (u32x4){oi[0], oi[1], oi[2], oi[3]}; *(u32x4*)(KE + o) = (u32x4){oe[0], oe[1], oe[2], oe[3]}; }
    }
    __syncthreads();
}
__device__ __forceinline__ int swz256(int r, int c) { return r * 256 + (((c ^ r) & 15) << 4); }
__device__ __forceinline__ bf16x8 frag_row_h(lptr base, int x0, int k0, int lane) { const int r = x0 + (lane & 15), c = (k0 >> 3) + (lane >> 4); return *(const LAS bf16x8*)(base + swz256(r, c)); }
__device__ __forceinline__ bf16x8 frag_tr_h(lptr base, int k0, int x0, int lane) {
    const int g = lane >> 4, i = lane & 15, q = i >> 2, pq = i & 3; const int r0 = k0 + 8 * g + q, c = (x0 + 4 * pq) >> 3, off = (pq & 1) * 8;
    const s16x4 lo = __builtin_bit_cast(s16x4, __builtin_amdgcn_ds_read_tr16_b64_v4i16((LAS v4i16_t*)(base + swz256(r0, c) + off)));
    const s16x4 hi = __builtin_bit_cast(s16x4, __builtin_amdgcn_ds_read_tr16_b64_v4i16((LAS v4i16_t*)(base + swz256(r0 + 4, c) + off)));
    return (bf16x8){lo[0], lo[1], lo[2], lo[3], hi[0], hi[1], hi[2], hi[3]};
}
__device__ __forceinline__ void hgrn_scan_phase(const Ctx& C, const bf16* QD, const bf16* KI, const bf16* KE, const bf16* HB, const float* EB, const float* st_in, bf16* Oh, float* st_out_p, float* st_out_s) {
    constexpr int PP = 160, PS = 288;
    lptr Ql0 = C.lds, KIl0 = Ql0 + 32768, KEl0 = KIl0 + 32768, Vl0 = KEl0 + 32768, Pl = Vl0 + 4096, Sl = Pl + 64 * PP;
    const bf16* const VH = HB + (WS_LF - WS_BIG) / 2;
    const int lane = C.lane, w = __builtin_amdgcn_readfirstlane(C.wave), fq = lane >> 4, ln = lane & 15, tid = C.tid;
    const int ti = w >> 1, si0 = 2 * (w & 1);
    for (int u = C.vcu; u < 256 + 2048; u += C.G) {
        int h, j, row0, nsteps, L, ch0; const float* sin_ = nullptr; float* sout;
        if (u < 256) { const int b = u >> 6; h = (u >> 3) & 7; j = u & 7; row0 = b * SEQ_; nsteps = 128; L = 64; ch0 = b * 128; sout = st_out_p + ((size_t)(b * 8 + h) * 128) * 128 + 16 * j; }
        else { const int su = u - 256, sb = su >> 6; h = (su >> 3) & 7; j = su & 7; row0 = MP + 16 * sb; nsteps = 1; L = 16; ch0 = 512 + sb; sin_ = st_in + ((size_t)(sb * 8 + h) * 128) * 128 + 16 * j; sout = st_out_s + ((size_t)(sb * 8 + h) * 128) * 128 + 16 * j; }
        f32x4 st;
#pragma unroll
        for (int i = 0; i < 4; ++i) st[i] = sin_ ? sin_[(size_t)(16 * w + 4 * fq + i) * 128 + ln] : 0.f;
        float mk[2][4];
        { const int t = 16 * ti + ln;
#pragma unroll
            for (int x = 0; x < 2; ++x)
#pragma unroll
                for (int i = 0; i < 4; ++i) { const int s = 16 * (si0 + x) + 4 * fq + i; mk[x][i] = (s <= t && s < L) ? 1.f : 0.f; } }
        size_t toff[2];
#pragma unroll
        for (int i = 0; i < 2; ++i) { const int pi = 2 * w + i, r = 4 * pi + (lane >> 4), pc = lane & 15, c = (pc ^ r) & 15, rc = r < L ? r : L - 1; toff[i] = ((size_t)h * MT + row0 + rc) * 128 + c * 8; }
        const size_t voff = ((size_t)(h * 8 + j) * MT + row0 + 32 * (w & 1) + (lane >> 1)) * 16 + (lane & 1) * 8; const bool vdo = w < 2 && L == 64;
        const float* const ebp = EB + (size_t)ch0 * DM_ + h * 128 + 16 * w + 4 * fq;
        __builtin_amdgcn_s_waitcnt(0); __builtin_amdgcn_s_barrier();
        if (L < 64) {
            if (tid < 128) { const int row = tid >> 1; u32x4 vv = {0u, 0u, 0u, 0u}; if (row < L) vv = *(const u32x4*)(VH + ((size_t)(h * 8 + j) * MT + row0 + row) * 16 + (tid & 1) * 8); *(LAS u32x4*)(Vl0 + tid * 16) = vv; } }
#define HG_DMA(n) do { const size_t o_ = (size_t)(n) * (64 * 128); const int b_ = ((n) & 1) * 16384; _Pragma("unroll") for (int i_ = 0; i_ < 2; ++i_) { \
                dma16(QD + o_ + toff[i_], Ql0 + b_ + (2 * w + i_) * 1024); dma16(KI + o_ + toff[i_], KIl0 + b_ + (2 * w + i_) * 1024); } \
            if (vdo) dma16(VH + (size_t)(n) * (64 * 16) + voff, Vl0 + ((n) & 1) * 2048 + w * 1024); } while (0)
        HG_DMA(0);
        f32x4 e = *(const f32x4*)ebp, en = e;
        u32x2 ow = {0u, 0u}; bf16* const orow = Oh + (size_t)(row0 + 16 * w + ln) * DM_ + h * 128 + 16 * j + 4 * fq; const bool odo = w < 4 && 16 * w + ln < L;
        for (int n = 0; n < nsteps; ++n) {
            lptr Ql = Ql0 + (n & 1) * 16384, KIl = KIl0 + (n & 1) * 16384, Vl = Vl0 + (n & 1) * 2048;
            asm volatile("s_waitcnt vmcnt(0) lgkmcnt(0)" ::: "memory"); __builtin_amdgcn_s_barrier(); asm volatile("" ::: "memory");
            if (n > 0 && odo) *(u32x2*)(orow + (size_t)(n - 1) * (64 * DM_)) = ow;
            if (n + 1 < nsteps) { HG_DMA(n + 1); en = *(const f32x4*)(ebp + (size_t)(n + 1) * DM_); }
            { bf16x8 qf[4], kf0[4], kf1[4];
#pragma unroll
                for (int ks = 0; ks < 4; ++ks) { qf[ks] = frag_row_h(Ql, 16 * ti, 32 * ks, lane); kf0[ks] = frag_row_h(KIl, 16 * si0, 32 * ks, lane); kf1[ks] = frag_row_h(KIl, 16 * si0 + 16, 32 * ks, lane); }
                __builtin_amdgcn_sched_barrier(0);
                f32x4 a0 = {0.f, 0.f, 0.f, 0.f}, a1 = a0, a2 = a0, a3 = a0;
#pragma unroll
                for (int ks = 0; ks < 4; ks += 2) { a0 = mma32(kf0[ks], qf[ks], a0); a1 = mma32(kf1[ks], qf[ks], a1); a2 = mma32(kf0[ks + 1], qf[ks + 1], a2); a3 = mma32(kf1[ks + 1], qf[ks + 1], a3); }
                { const u32x2 sw = {pkbf(st[0], st[1]), pkbf(st[2], st[3])}; *(LAS u32x2*)(Sl + ln * PS + (16 * w + 4 * fq) * 2) = sw; }
                a0 = a0 + a2; a1 = a1 + a3;
                const int t = 16 * ti + ln;
#pragma unroll
                for (int x = 0; x < 2; ++x) { const f32x4 a = x ? a1 : a0; const int sb0 = 16 * (si0 + x) + 4 * fq;
                    const u32x2 pw = {pkbf(a[0] * mk[x][0], a[1] * mk[x][1]), pkbf(a[2] * mk[x][2], a[3] * mk[x][3])}; *(LAS u32x2*)(Pl + t * PP + sb0 * 2) = pw; } }
            asm volatile("s_waitcnt lgkmcnt(0)" ::: "memory"); __builtin_amdgcn_s_barrier(); asm volatile("" ::: "memory");
            { bf16x8 ka[2], vb[2];
#pragma unroll
                for (int ks = 0; ks < 2; ++ks) { ka[ks] = frag_tr_h(KIl, 32 * ks, 16 * w, lane); vb[ks] = frag_tr(Vl, 32, 32 * ks, 0, lane); }
                if (w < 4) { bf16x8 sf[4], q2[4], pf[2];
#pragma unroll
                    for (int ks = 0; ks < 4; ++ks) { sf[ks] = frag_row(Sl, PS, 0, 32 * ks, lane); q2[ks] = frag_row_h(Ql, 16 * w, 32 * ks, lane); }
#pragma unroll
                    for (int ks = 0; ks < 2; ++ks) pf[ks] = frag_row(Pl, PP, 16 * w, 32 * ks, lane);
                    __builtin_amdgcn_sched_barrier(0);
                    f32x4 o = {0.f, 0.f, 0.f, 0.f}, o2 = o, o3 = o;
#pragma unroll
                    for (int ks = 0; ks < 2; ++ks) o = mma32(vb[ks], pf[ks], o);
#pragma unroll
                    for (int ks = 0; ks < 4; ks += 2) { o2 = mma32(sf[ks], q2[ks], o2); o3 = mma32(sf[ks + 1], q2[ks + 1], o3); }
                    o = o + o2 + o3;
                    ow = (u32x2){pkbf(o[0], o[1]), pkbf(o[2], o[3])}; }
                f32x4 a = st;
#pragma unroll
                for (int ks = 0; ks < 2; ++ks) a = mma32(ka[ks], vb[ks], a);
                st = a * e; e = en; }
        }
#undef HG_DMA
        if (odo) *(u32x2*)(orow + (size_t)(nsteps - 1) * (64 * DM_)) = ow;
#pragma unroll
        for (int i = 0; i < 4; ++i) sout[(size_t)(16 * w + 4 * fq + i) * 128 + ln] = st[i];
    }
    asm volatile("s_waitcnt vmcnt(0) lgkmcnt(0)" ::: "memory"); __syncthreads();
}
__device__ __forceinline__ void hgrn_post_phase(const Ctx& C, const bf16* Oh, const bf16* HB, const float* ng, bf16* A4) {
    const int lane = C.lane, c0 = lane * 16; float g[16];
#pragma unroll
    for (int j = 0; j < 16; ++j) g[j] = ng[c0 + j];
    u32x4 o0n, o1n, g0n, g1n;
#define HP_LOAD(mm) do { const u32x4* op_ = (const u32x4*)(Oh + (size_t)(mm) * DM_ + c0); const u32x4* gp_ = (const u32x4*)(HB + (size_t)(mm) * 4096 + 3072 + c0); o0n = op_[0]; o1n = op_[1]; g0n = gp_[0]; g1n = gp_[1]; } while (0)
    int m = C.gw;
    if (m < MT) HP_LOAD(m);
    for (; m < MT; m += C.NGW) {
        const u32x4 o0 = o0n, o1 = o1n, g0 = g0n, g1 = g1n;
        if (m + C.NGW < MT) HP_LOAD(m + C.NGW);
        const unsigned ow[8] = {o0.x, o0.y, o0.z, o0.w, o1.x, o1.y, o1.z, o1.w}, gw8[8] = {g0.x, g0.y, g0.z, g0.w, g1.x, g1.y, g1.z, g1.w};
        float ss = 0.f;
#pragma unroll
        for (int k = 0; k < 8; ++k) { const float a = bflo(ow[k]), b = bfhi(ow[k]); ss += a * a + b * b; }
        ss += __shfl_xor(ss, 1); ss += __shfl_xor(ss, 2); ss += __shfl_xor(ss, 4);
        const float rstd = 1.0f / sqrtf(ss * (1.0f / 128.0f) + EPS_); unsigned r[8];
#pragma unroll
        for (int k = 0; k < 8; ++k) r[k] = pkbf(bflo(ow[k]) * rstd * g[2 * k] * bflo(gw8[k]), bfhi(ow[k]) * rstd * g[2 * k + 1] * bfhi(gw8[k]));
        u32x4* ap = (u32x4*)(A4 + (size_t)m * DM_ + c0); ap[0] = (u32x4){r[0], r[1], r[2], r[3]}; ap[1] = (u32x4){r[4], r[5], r[6], r[7]};
    }
#undef HP_LOAD
}
constexpr int N_PHASES = 32;
struct Args { const float* in[29]; float* outp; unsigned char* wsp; int ph_lo, ph_hi, li, pad; };
typedef __attribute__((address_space(4))) const Args* kargs_t;
__device__ __forceinline__ kargs_t KA() { kargs_t p = (kargs_t)__builtin_amdgcn_kernarg_segment_ptr(); asm volatile("" : "+s"(p)); return p; }
__global__ void __launch_bounds__(NWAVES * 64, 2) hybrid_fwd(Args args) {
    extern __shared__ __attribute__((aligned(16))) unsigned char lds[];
    const int wave0 = __builtin_amdgcn_readfirstlane((int)threadIdx.x >> 6);
    Ctx C = mk_ctx((lptr)lds, wave0);
    gu32* ctl = (gu32*)(KA()->wsp + WS_CTL);
    for (int u = threadIdx.x; u < (LDS_BYTES - LDSCTL_OFF) / 4; u += NWAVES * 64) ((LAS unsigned*)(C.lds + LDSCTL_OFF))[u] = 0u;
    __syncthreads();
    const int lo = KA()->ph_lo, hi = KA()->ph_hi;
    XcdBarrier bar; bar.bar = (unsigned*)(ctl + CW_BAR) + KA()->li * XCD_BAR_WORDS; bar.x = 0; bar.st = nullptr;
    if (hi - lo > 1) bar = xcd_barrier_post((unsigned*)(ctl + CW_BAR) + KA()->li * XCD_BAR_WORDS, (volatile LAS unsigned*)(C.lds + MISC_OFF) + 8, C.tid == 0);
#define IN_(i) (KA()->in[i])
#define OUT_ (KA()->outp)
#define WS_ (KA()->wsp)
#define x_p IN_(0)
#define x_s IN_(1)
#define cache_k IN_(2)
#define cache_v IN_(3)
#define st_ret IN_(4)
#define st_hg IN_(5)
#define ngain IN_(10)
#define out OUT_
#define ws WS_
#define stats ((float*)(WS_ + WS_STATP))
#define mod ((float*)(WS_ + WS_MOD))
#define tab ((float*)(WS_ + WS_TAB))
#define lbw ((float*)(WS_ + WS_LB))
#define Hb ((bf16*)(WS_ + WS_H))
#define Xbf ((bf16*)(WS_ + WS_XB))
#define Fb ((bf16*)(WS_ + WS_F))
#define BIG ((bf16*)(WS_ + WS_BIG))
#define B2 ((bf16*)(WS_ + WS_B2))
#define B3 ((bf16*)(WS_ + WS_B3))
#define LF ((float*)(WS_ + WS_LF))
#define QD ((bf16*)(WS_ + WS_QD))
#define KI ((bf16*)(WS_ + WS_KI))
#define KE ((bf16*)(WS_ + WS_KE))
#define EB ((float*)(WS_ + WS_EB))
#define Qb BIG
#define Kb (BIG + (size_t)MT * DM_)
#define Vb (BIG + (size_t)2 * MT * DM_)
    int pid = 0;
#ifndef REPP
#define REPP (-1)
#endif
#define PH_ACTIVE (lo <= pid && pid < hi)
#define PH_ON PH_ACTIVE) for (int rep_ = (pid == REPP ? 2 : 1); rep_ > 0; --rep_) if (((C = mk_ctx((lptr)lds, wave0)), true)
#define GEMM_F_PHASE(Aptr, Wptr, KK) do { pg8::Gemm g_{(const pg8::bf16_t*)(Aptr), (const pg8::bf16_t*)(Wptr), MT, 1024, (KK), (KK) / 64}; FOrder S_; S_.P.init(MP, 1024, C.G, (int)blockIdx.x); S_.nsub = 8 * ((KK) / 256); S_.G = C.G; S_.c = (int)blockIdx.x; \
        EpiF E_{Fb, (float*)(WS_ + WS_PART)}; pg8::gemm_phase<EpiF, FOrder, true, true>(C.lds, g_, S_, E_, C.tid); } while (0)
#define BG_FFN(nb, lay) do { const Ctx Cq_ = mk_ctx((lptr)lds, wave0); bg_transpose(Cq_, (nb), IN_(27) + (size_t)(lay) * 1024 * 5632, 1024, 5632, (bf16*)(ws + W_FIN + (lay) * FIN_STRIDE), 1); \
        bg_transpose(Cq_, (nb), IN_(28) + (size_t)(lay) * 2816 * 1024, 2816, 1024, (bf16*)(ws + W_FOUT + (lay) * FOUT_STRIDE), 0); } while (0)
#define BG_MIX(nb, wi, Ki, Ni, di, wo_, Ko, No, do_, md) do { const Ctx Cq_ = mk_ctx((lptr)lds, wave0); bg_transpose(Cq_, (nb), IN_(wi), Ki, Ni, (bf16*)(ws + (di)), (md)); bg_transpose(Cq_, (nb), IN_(wo_), Ko, No, (bf16*)(ws + (do_)), 0); } while (0)
#define PH_DONE do { if (lo <= pid && pid + 1 < hi) { const Ctx Cb_ = mk_ctx((lptr)lds, wave0); xcd_barrier(bar, Cb_.tid == 0); } ++pid; } while (0)
#define GEMM_PHASE(EPI, Aptr, Wptr, NN, KK, Eobj) do { pg8::Gemm g_{(const pg8::bf16_t*)(Aptr), (const pg8::bf16_t*)(Wptr), MT, (NN), (KK), (KK) / 64}; pg8::StaticOrder S_; S_.init(MT, (NN), C.G, (int)blockIdx.x); \
        pg8::gemm_phase<EPI, pg8::StaticOrder, true, true>(C.lds, g_, S_, Eobj, C.tid); } while (0)

    if (PH_ON) {
        p0_adaln(C, IN_(6), IN_(7), IN_(8), IN_(9), mod);
        p0_tables(C, tab, lbw, IN_(26));
        p0_transpose(C, IN_(11), 1024, 6144, (bf16*)(ws + W_GIN), 0);
        p0_transpose(C, IN_(16), 3072, 1024, (bf16*)(ws + W_GOUT), 0);
    }
    PH_DONE;
    if (PH_ON) resnorm_phase<false, true, true, false>(C, x_p, x_s, nullptr, nullptr, nullptr, nullptr, mod, nullptr, 0, Hb, ngain, 0, 1024);
    PH_DONE;

    { constexpr int l = 0;
        const int ngo = l * 4096; const int mbase = l * 36 * 6144;
        if (l == 0) {
            if (PH_ON) { EpiGelu E{BIG, stats}; GEMM_PHASE(EpiGelu, Hb, ws + W_GIN, 6144, 1024, E); BG_FFN(48, 0); BG_MIX(48, 17, 1024, 3072, W_DIN, 20, 1024, 1024, W_DOUT, 0); }
            PH_DONE;
            if (PH_ON) gmlp_gate_phase(C, BIG, stats, IN_(12), IN_(13), IN_(14), IN_(15), B2, out + O_GV);
            PH_DONE;
        } else if (l == 1) {
            if (PH_ON) { EpiDiff E{Qb, out + O_KDP, out + O_KDS, attn_body::C2}; GEMM_PHASE(EpiDiff, Hb, ws + W_DIN, 3072, 1024, E); BG_FFN(24, 1); BG_MIX(24, 21, 1024, 6144, W_RIN, 22, 2048, 1024, W_ROUT, 0); }
            PH_DONE;
            if (PH_ON) {
                const attn_body::AttnTensors AT{(const attn_body::bf16*)Qb, (const attn_body::bf16*)Kb, (const attn_body::bf16*)Vb, (attn_body::bf16*)B2};
                const attn_body::StaticOrder S((int)C.G, (int)blockIdx.x);
                const float lam_ = __uint_as_float((unsigned)__builtin_amdgcn_readfirstlane((int)__float_as_uint(diff_lambda(IN_(18), C.lane))));
                const attn_body::AttnFuse FU{(attn_body::bf16*)B3, lam_, IN_(19)};
                attn_body::attn_phase<attn_body::StaticOrder>((char*)lds, AT, S, C.tid, FU);
                __syncthreads();
                { const Ctx Cs = mk_ctx((lptr)lds, wave0); diff_sample_phase(Cs, Qb, cache_k, cache_v, out + O_KDS, out + O_VDS, lam_, IN_(19), B3); }
            }
            PH_DONE;
        } else if (l == 2) {
            if (PH_ON) { EpiRet E{BIG, tab}; GEMM_PHASE(EpiRet, Hb, ws + W_RIN, 6144, 1024, E); BG_FFN(48, 2); BG_MIX(48, 23, 1024, 4096, W_HIN, 25, 1024, 1024, W_HOUT, 2); }
            PH_DONE;
            if (PH_ON) ret_scan_phase(C, BIG, st_ret, B2, out + O_RSP, out + O_RSS, RETPROBE != 0 && rep_ == 2);
            PH_DONE;
            if (PH_ON) ret_post_phase(C, B2, BIG, B3);
            PH_DONE;
        } else {
            if (PH_ON) { EpiHgrn E{BIG, QD, KI, KE, EB, lbw}; GEMM_PHASE(EpiHgrn, Hb, ws + W_HIN, 4096, 1024, E); BG_FFN(32, 3); }
            PH_DONE;
            if (PH_ON) hgrn_scan_phase(C, QD, KI, KE, BIG, EB, st_hg, B2, out + O_HSP, out + O_HSS);
            PH_DONE;
            if (PH_ON) hgrn_post_phase(C, B2, BIG, IN_(24), B3);
            PH_DONE;
        }
        if (PH_ON) { const bf16* Am = l == 0 ? B2 : B3; const size_t wo = l == 0 ? W_GOUT : (l == 1 ? W_DOUT : (l == 2 ? W_ROUT : W_HOUT)); const int Km = l == 0 ? 3072 : (l == 2 ? 2048 : 1024);
            GEMM_F_PHASE(Am, ws + wo, Km); }
        PH_DONE;
        if (l == 0) { if (PH_ON) resnorm_phase<true, true, true, false>(C, x_p, x_s, nullptr, Fb, nullptr, Xbf, mod, ngain + ngo + 1024, mbase + 2 * 1024, Hb, ngain + ngo + 2048, mbase + 3 * 1024, mbase + 4 * 1024, (const float*)(WS_ + WS_PART), 3072 / 256); }
        else { if (PH_ON) resnorm_phase<true, true, false, false>(C, nullptr, nullptr, Xbf, Fb, nullptr, Xbf, mod, ngain + ngo + 1024, mbase + 2 * 1024, Hb, ngain + ngo + 2048, mbase + 3 * 1024, mbase + 4 * 1024, (const float*)(WS_ + WS_PART), (l == 2 ? 2048 : 1024) / 256); }
        PH_DONE;
        if (PH_ON) { EpiSwiglu E{B2}; GEMM_PHASE(EpiSwiglu, Hb, ws + W_FIN + l * FIN_STRIDE, 5632, 1024, E); }
        PH_DONE;
        if (PH_ON) { GEMM_F_PHASE(B2, ws + W_FOUT + l * FOUT_STRIDE, FFH); }
        PH_DONE;
        if (l < 3) { if (PH_ON) resnorm_phase<true, true, false, false>(C, nullptr, nullptr, Xbf, Fb, nullptr, Xbf, mod, ngain + ngo + 3072, mbase + 5 * 1024, Hb, ngain + ngo + 4096, mbase + 36 * 6144, mbase + 36 * 6144 + 1024, (const float*)(WS_ + WS_PART), FFH / 256); }
        else { if (PH_ON) resnorm_phase<true, false, false, true>(C, nullptr, nullptr, Xbf, Fb, out, nullptr, mod, ngain + ngo + 3072, mbase + 5 * 1024, nullptr, nullptr, 0, 0, (const float*)(WS_ + WS_PART), FFH / 256); }
        PH_DONE;
    }
    { constexpr int l = 1;
        const int ngo = l * 4096; const int mbase = l * 36 * 6144;
        if (l == 0) {
            if (PH_ON) { EpiGelu E{BIG, stats}; GEMM_PHASE(EpiGelu, Hb, ws + W_GIN, 6144, 1024, E); BG_FFN(48, 0); BG_MIX(48, 17, 1024, 3072, W_DIN, 20, 1024, 1024, W_DOUT, 0); }
            PH_DONE;
            if (PH_ON) gmlp_gate_phase(C, BIG, stats, IN_(12), IN_(13), IN_(14), IN_(15), B2, out + O_GV);
            PH_DONE;
        } else if (l == 1) {
            if (PH_ON) { EpiDiff E{Qb, out + O_KDP, out + O_KDS, attn_body::C2}; GEMM_PHASE(EpiDiff, Hb, ws + W_DIN, 3072, 1024, E); BG_FFN(24, 1); BG_MIX(24, 21, 1024, 6144, W_RIN, 22, 2048, 1024, W_ROUT, 0); }
            PH_DONE;
            if (PH_ON) {
                const attn_body::AttnTensors AT{(const attn_body::bf16*)Qb, (const attn_body::bf16*)Kb, (const attn_body::bf16*)Vb, (attn_body::bf16*)B2};
                const attn_body::StaticOrder S((int)C.G, (int)blockIdx.x);
                const float lam_ = __uint_as_float((unsigned)__builtin_amdgcn_readfirstlane((int)__float_as_uint(diff_lambda(IN_(18), C.lane))));
                const attn_body::AttnFuse FU{(attn_body::bf16*)B3, lam_, IN_(19)};
                attn_body::attn_phase<attn_body::StaticOrder>((char*)lds, AT, S, C.tid, FU);
                __syncthreads();
                { const Ctx Cs = mk_ctx((lptr)lds, wave0); diff_sample_phase(Cs, Qb, cache_k, cache_v, out + O_KDS, out + O_VDS, lam_, IN_(19), B3); }
            }
            PH_DONE;
        } else if (l == 2) {
            if (PH_ON) { EpiRet E{BIG, tab}; GEMM_PHASE(EpiRet, Hb, ws + W_RIN, 6144, 1024, E); BG_FFN(48, 2); BG_MIX(48, 23, 1024, 4096, W_HIN, 25, 1024, 1024, W_HOUT, 2); }
            PH_DONE;
            if (PH_ON) ret_scan_phase(C, BIG, st_ret, B2, out + O_RSP, out + O_RSS, RETPROBE != 0 && rep_ == 2);
            PH_DONE;
            if (PH_ON) ret_post_phase(C, B2, BIG, B3);
            PH_DONE;
        } else {
            if (PH_ON) { EpiHgrn E{BIG, QD, KI, KE, EB, lbw}; GEMM_PHASE(EpiHgrn, Hb, ws + W_HIN, 4096, 1024, E); BG_FFN(32, 3); }
            PH_DONE;
            if (PH_ON) hgrn_scan_phase(C, QD, KI, KE, BIG, EB, st_hg, B2, out + O_HSP, out + O_HSS);
            PH_DONE;
            if (PH_ON) hgrn_post_phase(C, B2, BIG, IN_(24), B3);
            PH_DONE;
        }
        if (PH_ON) { const bf16* Am = l == 0 ? B2 : B3; const size_t wo = l == 0 ? W_GOUT : (l == 1 ? W_DOUT : (l == 2 ? W_ROUT : W_HOUT)); const int Km = l == 0 ? 3072 : (l == 2 ? 2048 : 1024);
            GEMM_F_PHASE(Am, ws + wo, Km); }
        PH_DONE;
        if (l == 0) { if (PH_ON) resnorm_phase<true, true, true, false>(C, x_p, x_s, nullptr, Fb, nullptr, Xbf, mod, ngain + ngo + 1024, mbase + 2 * 1024, Hb, ngain + ngo + 2048, mbase + 3 * 1024, mbase + 4 * 1024, (const float*)(WS_ + WS_PART), 3072 / 256); }
        else { if (PH_ON) resnorm_phase<true, true, false, false>(C, nullptr, nullptr, Xbf, Fb, nullptr, Xbf, mod, ngain + ngo + 1024, mbase + 2 * 1024, Hb, ngain + ngo + 2048, mbase + 3 * 1024, mbase + 4 * 1024, (const float*)(WS_ + WS_PART), (l == 2 ? 2048 : 1024) / 256); }
        PH_DONE;
        if (PH_ON) { EpiSwiglu E{B2}; GEMM_PHASE(EpiSwiglu, Hb, ws + W_FIN + l * FIN_STRIDE, 5632, 1024, E); }
        PH_DONE;
        if (PH_ON) { GEMM_F_PHASE(B2, ws + W_FOUT + l * FOUT_STRIDE, FFH); }
        PH_DONE;
        if (l < 3) { if (PH_ON) resnorm_phase<true, true, false, false>(C, nullptr, nullptr, Xbf, Fb, nullptr, Xbf, mod, ngain + ngo + 3072, mbase + 5 * 1024, Hb, ngain + ngo + 4096, mbase + 36 * 6144, mbase + 36 * 6144 + 1024, (const float*)(WS_ + WS_PART), FFH / 256); }
        else { if (PH_ON) resnorm_phase<true, false, false, true>(C, nullptr, nullptr, Xbf, Fb, out, nullptr, mod, ngain + ngo + 3072, mbase + 5 * 1024, nullptr, nullptr, 0, 0, (const float*)(WS_ + WS_PART), FFH / 256); }
        PH_DONE;
    }
    { constexpr int l = 2;
        const int ngo = l * 4096; const int mbase = l * 36 * 6144;
        if (l == 0) {
            if (PH_ON) { EpiGelu E{BIG, stats}; GEMM_PHASE(EpiGelu, Hb, ws + W_GIN, 6144, 1024, E); BG_FFN(48, 0); BG_MIX(48, 17, 1024, 3072, W_DIN, 20, 1024, 1024, W_DOUT, 0); }
            PH_DONE;
            if (PH_ON) gmlp_gate_phase(C, BIG, stats, IN_(12), IN_(13), IN_(14), IN_(15), B2, out + O_GV);
            PH_DONE;
        } else if (l == 1) {
            if (PH_ON) { EpiDiff E{Qb, out + O_KDP, out + O_KDS, attn_body::C2}; GEMM_PHASE(EpiDiff, Hb, ws + W_DIN, 3072, 1024, E); BG_FFN(24, 1); BG_MIX(24, 21, 1024, 6144, W_RIN, 22, 2048, 1024, W_ROUT, 0); }
            PH_DONE;
            if (PH_ON) {
                const attn_body::AttnTensors AT{(const attn_body::bf16*)Qb, (const attn_body::bf16*)Kb, (const attn_body::bf16*)Vb, (attn_body::bf16*)B2};
                const attn_body::StaticOrder S((int)C.G, (int)blockIdx.x);
                const float lam_ = __uint_as_float((unsigned)__builtin_amdgcn_readfirstlane((int)__float_as_uint(diff_lambda(IN_(18), C.lane))));
                const attn_body::AttnFuse FU{(attn_body::bf16*)B3, lam_, IN_(19)};
                attn_body::attn_phase<attn_body::StaticOrder>((char*)lds, AT, S, C.tid, FU);
                __syncthreads();
                { const Ctx Cs = mk_ctx((lptr)lds, wave0); diff_sample_phase(Cs, Qb, cache_k, cache_v, out + O_KDS, out + O_VDS, lam_, IN_(19), B3); }
            }
            PH_DONE;
        } else if (l == 2) {
            if (PH_ON) { EpiRet E{BIG, tab}; GEMM_PHASE(EpiRet, Hb, ws + W_RIN, 6144, 1024, E); BG_FFN(48, 2); BG_MIX(48, 23, 1024, 4096, W_HIN, 25, 1024, 1024, W_HOUT, 2); }
            PH_DONE;
            if (PH_ON) ret_scan_phase(C, BIG, st_ret, B2, out + O_RSP, out + O_RSS, RETPROBE != 0 && rep_ == 2);
            PH_DONE;
            if (PH_ON) ret_post_phase(C, B2, BIG, B3);
            PH_DONE;
        } else {
            if (PH_ON) { EpiHgrn E{BIG, QD, KI, KE, EB, lbw}; GEMM_PHASE(EpiHgrn, Hb, ws + W_HIN, 4096, 1024, E); BG_FFN(32, 3); }
            PH_DONE;
            if (PH_ON) hgrn_scan_phase(C, QD, KI, KE, BIG, EB, st_hg, B2, out + O_HSP, out + O_HSS);
            PH_DONE;
            if (PH_ON) hgrn_post_phase(C, B2, BIG, IN_(24), B3);
            PH_DONE;
        }
        if (PH_ON) { const bf16* Am = l == 0 ? B2 : B3; const size_t wo = l == 0 ? W_GOUT : (l == 1 ? W_DOUT : (l == 2 ? W_ROUT : W_HOUT)); const int Km = l == 0 ? 3072 : (l == 2 ? 2048 : 1024);
            GEMM_F_PHASE(Am, ws + wo, Km); }
        PH_DONE;
        if (l == 0) { if (PH_ON) resnorm_phase<true, true, true, false>(C, x_p, x_s, nullptr, Fb, nullptr, Xbf, mod, ngain + ngo + 1024, mbase + 2 * 1024, Hb, ngain + ngo + 2048, mbase + 3 * 1024, mbase + 4 * 1024, (const float*)(WS_ + WS_PART), 3072 / 256); }
        else { if (PH_ON) resnorm_phase<true, true, false, false>(C, nullptr, nullptr, Xbf, Fb, nullptr, Xbf, mod, ngain + ngo + 1024, mbase + 2 * 1024, Hb, ngain + ngo + 2048, mbase + 3 * 1024, mbase + 4 * 1024, (const float*)(WS_ + WS_PART), (l == 2 ? 2048 : 1024) / 256); }
        PH_DONE;
        if (PH_ON) { EpiSwiglu E{B2}; GEMM_PHASE(EpiSwiglu, Hb, ws + W_FIN + l * FIN_STRIDE, 5632, 1024, E); }
        PH_DONE;
        if (PH_ON) { GEMM_F_PHASE(B2, ws + W_FOUT + l * FOUT_STRIDE, FFH); }
        PH_DONE;
        if (l < 3) { if (PH_ON) resnorm_phase<true, true, false, false>(C, nullptr, nullptr, Xbf, Fb, nullptr, Xbf, mod, ngain + ngo + 3072, mbase + 5 * 1024, Hb, ngain + ngo + 4096, mbase + 36 * 6144, mbase + 36 * 6144 + 1024, (const float*)(WS_ + WS_PART), FFH / 256); }
        else { if (PH_ON) resnorm_phase<true, false, false, true>(C, nullptr, nullptr, Xbf, Fb, out, nullptr, mod, ngain + ngo + 3072, mbase + 5 * 1024, nullptr, nullptr, 0, 0, (const float*)(WS_ + WS_PART), FFH / 256); }
        PH_DONE;
    }
    { constexpr int l = 3;
        const int ngo = l * 4096; const int mbase = l * 36 * 6144;
        if (l == 0) {
            if (PH_ON) { EpiGelu E{BIG, stats}; GEMM_PHASE(EpiGelu, Hb, ws + W_GIN, 6144, 1024, E); BG_FFN(48, 0); BG_MIX(48, 17, 1024, 3072, W_DIN, 20, 1024, 1024, W_DOUT, 0); }
            PH_DONE;
            if (PH_ON) gmlp_gate_phase(C, BIG, stats, IN_(12), IN_(13), IN_(14), IN_(15), B2, out + O_GV);
            PH_DONE;
        } else if (l == 1) {
            if (PH_ON) { EpiDiff E{Qb, out + O_KDP, out + O_KDS, attn_body::C2}; GEMM_PHASE(EpiDiff, Hb, ws + W_DIN, 3072, 1024, E); BG_FFN(24, 1); BG_MIX(24, 21, 1024, 6144, W_RIN, 22, 2048, 1024, W_ROUT, 0); }
            PH_DONE;
            if (PH_ON) {
                const attn_body::AttnTensors AT{(const attn_body::bf16*)Qb, (const attn_body::bf16*)Kb, (const attn_body::bf16*)Vb, (attn_body::bf16*)B2};
                const attn_body::StaticOrder S((int)C.G, (int)blockIdx.x);
                const float lam_ = __uint_as_float((unsigned)__builtin_amdgcn_readfirstlane((int)__float_as_uint(diff_lambda(IN_(18), C.lane))));
                const attn_body::AttnFuse FU{(attn_body::bf16*)B3, lam_, IN_(19)};
                attn_body::attn_phase<attn_body::StaticOrder>((char*)lds, AT, S, C.tid, FU);
                __syncthreads();
                { const Ctx Cs = mk_ctx((lptr)lds, wave0); diff_sample_phase(Cs, Qb, cache_k, cache_v, out + O_KDS, out + O_VDS, lam_, IN_(19), B3); }
            }
            PH_DONE;
        } else if (l == 2) {
            if (PH_ON) { EpiRet E{BIG, tab}; GEMM_PHASE(EpiRet, Hb, ws + W_RIN, 6144, 1024, E); BG_FFN(48, 2); BG_MIX(48, 23, 1024, 4096, W_HIN, 25, 1024, 1024, W_HOUT, 2); }
            PH_DONE;
            if (PH_ON) ret_scan_phase(C, BIG, st_ret, B2, out + O_RSP, out + O_RSS, RETPROBE != 0 && rep_ == 2);
            PH_DONE;
            if (PH_ON) ret_post_phase(C, B2, BIG, B3);
            PH_DONE;
        } else {
            if (PH_ON) { EpiHgrn E{BIG, QD, KI, KE, EB, lbw}; GEMM_PHASE(EpiHgrn, Hb, ws + W_HIN, 4096, 1024, E); BG_FFN(32, 3); }
            PH_DONE;
            if (PH_ON) hgrn_scan_phase(C, QD, KI, KE, BIG, EB, st_hg, B2, out + O_HSP, out + O_HSS);
            PH_DONE;
            if (PH_ON) hgrn_post_phase(C, B2, BIG, IN_(24), B3);
            PH_DONE;
        }
        if (PH_ON) { const bf16* Am = l == 0 ? B2 : B3; const size_t wo = l == 0 ? W_GOUT : (l == 1 ? W_DOUT : (l == 2 ? W_ROUT : W_HOUT)); const int Km = l == 0 ? 3072 : (l == 2 ? 2048 : 1024);
            GEMM_F_PHASE(Am, ws + wo, Km); }
        PH_DONE;
        if (l == 0) { if (PH_ON) resnorm_phase<true, true, true, false>(C, x_p, x_s, nullptr, Fb, nullptr, Xbf, mod, ngain + ngo + 1024, mbase + 2 * 1024, Hb, ngain + ngo + 2048, mbase + 3 * 1024, mbase + 4 * 1024, (const float*)(WS_ + WS_PART), 3072 / 256); }
        else { if (PH_ON) resnorm_phase<true, true, false, false>(C, nullptr, nullptr, Xbf, Fb, nullptr, Xbf, mod, ngain + ngo + 1024, mbase + 2 * 1024, Hb, ngain + ngo + 2048, mbase + 3 * 1024, mbase + 4 * 1024, (const float*)(WS_ + WS_PART), (l == 2 ? 2048 : 1024) / 256); }
        PH_DONE;
        if (PH_ON) { EpiSwiglu E{B2}; GEMM_PHASE(EpiSwiglu, Hb, ws + W_FIN + l * FIN_STRIDE, 5632, 1024, E); }
        PH_DONE;
        if (PH_ON) { GEMM_F_PHASE(B2, ws + W_FOUT + l * FOUT_STRIDE, FFH); }
        PH_DONE;
        if (l < 3) { if (PH_ON) resnorm_phase<true, true, false, false>(C, nullptr, nullptr, Xbf, Fb, nullptr, Xbf, mod, ngain + ngo + 3072, mbase + 5 * 1024, Hb, ngain + ngo + 4096, mbase + 36 * 6144, mbase + 36 * 6144 + 1024, (const float*)(WS_ + WS_PART), FFH / 256); }
        else { if (PH_ON) resnorm_phase<true, false, false, true>(C, nullptr, nullptr, Xbf, Fb, out, nullptr, mod, ngain + ngo + 3072, mbase + 5 * 1024, nullptr, nullptr, 0, 0, (const float*)(WS_ + WS_PART), FFH / 256); }
        PH_DONE;
    }
#undef PH_ON
#undef PH_DONE
#undef GEMM_PHASE
#undef BG_FFN
#undef BG_MIX
#undef GEMM_F_PHASE
#undef x_p
#undef x_s
#undef cache_k
#undef cache_v
#undef st_ret
#undef st_hg
#undef ngain
#undef out
#undef ws
#undef stats
#undef mod
#undef tab
#undef lbw
#undef Hb
#undef Xbf
#undef Fb
#undef BIG
#undef B2
#undef B3
#undef LF
#undef QD
#undef KI
#undef KE
#undef EB
#undef Qb
#undef Kb
#undef Vb
}

#ifndef MK_SPLIT
#define MK_SPLIT 0
#endif
extern "C" void kernel_launch(void* const* d_in, const int* in_sizes, int n_in, void* d_out, int out_size, void* d_ws, size_t ws_size, hipStream_t stream) {
    static int grid = 0;
    if (grid == 0) {
        if (n_in != 29 || (size_t)out_size != O_END || ws_size < WS_END) { fprintf(stderr, "kernel_launch: unexpected shapes (n_in %d out %d ws %zu); nothing launched\n", n_in, out_size, ws_size); grid = -1; return; }
        int dev = 0, cus = 0, per_cu = 0;
        if (hipGetDevice(&dev) != hipSuccess || hipDeviceGetAttribute(&cus, hipDeviceAttributeMultiprocessorCount, dev) != hipSuccess) { grid = -1; return; }
        if (hipFuncSetAttribute((const void*)hybrid_fwd, hipFuncAttributeMaxDynamicSharedMemorySize, LDS_BYTES) != hipSuccess) { fprintf(stderr, "kernel_launch: hipFuncSetAttribute failed\n"); grid = -1; return; }
        if (hipOccupancyMaxActiveBlocksPerMultiprocessor(&per_cu, (const void*)hybrid_fwd, NWAVES * 64, LDS_BYTES) != hipSuccess || per_cu < 1) { fprintf(stderr, "kernel_launch: occupancy query reports %d blocks per CU\n", per_cu); }
        (void)hipGetLastError();
        grid = cus;
        if (grid != 256) { fprintf(stderr, "kernel_launch: built for 256 CUs, device has %d; nothing launched\n", cus); grid = -1; return; }
    }
    if (grid < 0) return;
    if (hipMemsetAsync((char*)d_ws + WS_CTL, 0, CTL_ZERO_BYTES, stream) != hipSuccess) return;
    Args a{};
    for (int i = 0; i < 29; ++i) a.in[i] = (const float*)d_in[i];
    a.outp = (float*)d_out; a.wsp = (unsigned char*)d_ws; a.pad = 0;
#if MK_SPLIT
    for (int p = 0; p < N_PHASES; ++p) { a.ph_lo = p; a.ph_hi = p + 1; a.li = 0; hipLaunchKernelGGL(hybrid_fwd, dim3(grid), dim3(NWAVES * 64), LDS_BYTES, stream, a); }
#else
    a.ph_lo = 0; a.ph_hi = N_PHASES; a.li = 0;
    hipLaunchKernelGGL(hybrid_fwd, dim3(grid), dim3(NWAVES * 64), LDS_BYTES, stream, a);
#endif
}
```
